# Optimizing an MI355X kernel written in HIP

```python
import jax, jax.numpy as jnp
from jax import lax
import numpy as np

D_MODEL = 1024
BATCH = 4
SEQ = 8192
DEPTH = 1
DEC_BATCH = 4
DEC_SEQ = 4096
PAST_LEN = 128

N_META = 16
GRID_W = 64
NA_HEADS = 8
NA_HEAD_DIM = 64
NA_WIDTH = NA_HEADS * NA_HEAD_DIM
NA_WIN_ROWS = 8
NA_WIN_COLS = 16
FN_GROUPS = 4
FN_GROUP_DIM = 128
FN_WIDTH = FN_GROUPS * FN_GROUP_DIM
D_FF = 4 * D_MODEL
RMS_EPS = 1e-6
IN_WIDTH = 3 * NA_WIDTH + FN_WIDTH + 2 * D_MODEL

kernel_name = 'hybrid_natten_fnet_encoder'


def rmsnorm(x, g):
    xf = x.astype(jnp.float32)
    y = xf * lax.rsqrt(jnp.mean(xf * xf, axis=-1, keepdims=True) + RMS_EPS)
    return (y * g.astype(jnp.float32)).astype(x.dtype)


def neighbourhood_attention(q, k, v, rel_bias, meta_bias):
    B, N, H, Dh = q.shape
    T = N - N_META
    rows = T // GRID_W
    wr = min(NA_WIN_ROWS, rows)
    scale = Dh ** -0.5
    qm, km, vm = q[:, :N_META], k[:, :N_META], v[:, :N_META]
    qg = q[:, N_META:].reshape(B, rows, GRID_W, H, Dh)
    kg = k[:, N_META:].reshape(B, rows, GRID_W, H, Dh)
    vg = v[:, N_META:].reshape(B, rows, GRID_W, H, Dh)

    s_mm = jnp.einsum('bqhd,bkhd->bhqk', qm, km) * scale + meta_bias[None, :, None, :]
    p_mm = jax.nn.softmax(s_mm.astype(jnp.float32), axis=-1).astype(v.dtype)
    o_meta = jnp.einsum('bhqk,bkhd->bqhd', p_mm, vm)

    cols = jnp.arange(GRID_W)
    col_start = jnp.clip(cols - NA_WIN_COLS // 2, 0, GRID_W - NA_WIN_COLS)
    col_idx = col_start[:, None] + jnp.arange(NA_WIN_COLS)[None, :]
    col_off = col_idx - cols[:, None]
    col_bias = rel_bias[:, :, col_off + NA_WIN_COLS - 1]

    def row_block(r):
        rs = jnp.clip(r - wr // 2, 0, rows - wr)
        q_r = lax.dynamic_index_in_dim(qg, r, axis=1, keepdims=False)
        k_rows = lax.dynamic_slice_in_dim(kg, rs, wr, axis=1)
        v_rows = lax.dynamic_slice_in_dim(vg, rs, wr, axis=1)
        k_win = k_rows[:, :, col_idx]
        v_win = v_rows[:, :, col_idx]
        row_off = rs + jnp.arange(wr) - r
        bias = col_bias[:, row_off + NA_WIN_ROWS - 1]
        s_loc = jnp.einsum('bchd,bwcjhd->bhcwj', q_r, k_win) * scale + jnp.transpose(bias, (0, 2, 1, 3))[None]
        s_loc = s_loc.reshape(B, H, GRID_W, wr * NA_WIN_COLS)
        s_met = jnp.einsum('bchd,bmhd->bhcm', q_r, km) * scale + meta_bias[None, :, None, :]
        s = jnp.concatenate([s_loc, s_met], axis=-1).astype(jnp.float32)
        p = jax.nn.softmax(s, axis=-1).astype(v.dtype)
        p_loc = p[..., :wr * NA_WIN_COLS].reshape(B, H, GRID_W, wr, NA_WIN_COLS)
        p_met = p[..., wr * NA_WIN_COLS:]
        return (jnp.einsum('bhcwj,bwcjhd->bchd', p_loc, v_win)
                + jnp.einsum('bhcm,bmhd->bchd', p_met, vm))

    o_grid = lax.map(row_block, jnp.arange(rows))
    o_grid = jnp.transpose(o_grid, (1, 0, 2, 3, 4)).reshape(B, T, H, Dh)
    return jnp.concatenate([o_meta, o_grid], axis=1)


def fourier_mix(u):
    B, N, _ = u.shape
    ug = u.reshape(B, N, FN_GROUPS, FN_GROUP_DIM).astype(jnp.float32)
    f = jnp.fft.fft2(ug, axes=(1, 3), norm='ortho').real
    return f.reshape(B, N, FN_WIDTH).astype(u.dtype)


def encoder_layer(x, w_in, rel_bias, meta_bias, w_branch_na, w_branch_fn, w_out, g_mix, g_mlp, w_up, w_down):
    B, N, _ = x.shape
    h = rmsnorm(x, g_mix)
    z = h @ w_in
    q, k, v, u, gate_na, gate_fn = jnp.split(
        z, [NA_WIDTH, 2 * NA_WIDTH, 3 * NA_WIDTH, 3 * NA_WIDTH + FN_WIDTH,
            3 * NA_WIDTH + FN_WIDTH + D_MODEL], axis=-1)
    q = q.reshape(B, N, NA_HEADS, NA_HEAD_DIM)
    k = k.reshape(B, N, NA_HEADS, NA_HEAD_DIM)
    v = v.reshape(B, N, NA_HEADS, NA_HEAD_DIM)
    y_na = neighbourhood_attention(q, k, v, rel_bias, meta_bias).reshape(B, N, NA_WIDTH) @ w_branch_na
    y_fn = fourier_mix(u) @ w_branch_fn
    mixed = jax.nn.sigmoid(gate_na) * y_na + jax.nn.sigmoid(gate_fn) * y_fn
    x = x + mixed @ w_out
    a = jax.nn.relu(rmsnorm(x, g_mlp) @ w_up)
    return x + (a * a) @ w_down


def run_trunk(x, meta_tokens, w_in, rel_bias, meta_bias, w_branch_na, w_branch_fn, w_out,
              g_mix, g_mlp, w_up, w_down, g_final):
    B = x.shape[0]
    meta = jnp.broadcast_to(meta_tokens.astype(x.dtype)[None], (B, N_META, D_MODEL))
    h = jnp.concatenate([meta, x], axis=1)
    for l in range(DEPTH):
        h = encoder_layer(h, w_in[l], rel_bias[l], meta_bias[l], w_branch_na[l], w_branch_fn[l],
                          w_out[l], g_mix[l], g_mlp[l], w_up[l], w_down[l])
    return rmsnorm(h, g_final)[:, N_META:]


def setup_inputs(seed: int = 0) -> dict:
    key = jax.random.key(seed)
    ks = jax.random.split(key, 16)
    L, D = DEPTH, D_MODEL

    def nrm(k, shape, scale):
        return jax.random.normal(k, shape, jnp.float32) * scale

    return {
        'x_prompt': nrm(ks[0], (BATCH, SEQ, D), 1.0),
        'x_sample': nrm(ks[1], (DEC_BATCH, DEC_SEQ, D), 1.0),
        'meta_tokens': nrm(ks[2], (N_META, D), 1.0),
        'w_in': nrm(ks[3], (L, D, IN_WIDTH), D ** -0.5),
        'rel_bias': nrm(ks[4], (L, NA_HEADS, 2 * NA_WIN_ROWS - 1, 2 * NA_WIN_COLS - 1), 0.1),
        'meta_bias': nrm(ks[5], (L, NA_HEADS, N_META), 0.1),
        'w_branch_na': nrm(ks[6], (L, NA_WIDTH, D), NA_WIDTH ** -0.5),
        'w_branch_fn': nrm(ks[7], (L, FN_WIDTH, D), FN_WIDTH ** -0.5),
        'w_out': nrm(ks[8], (L, D, D), D ** -0.5),
        'g_mix': 1.0 + nrm(ks[9], (L, D), 0.02),
        'g_mlp': 1.0 + nrm(ks[10], (L, D), 0.02),
        'w_up': nrm(ks[11], (L, D, D_FF), D ** -0.5),
        'w_down': nrm(ks[12], (L, D_FF, D), D_FF ** -0.5),
        'g_final': 1.0 + nrm(ks[13], (D,), 0.02),
    }


def reference(x_prompt, x_sample, meta_tokens, w_in, rel_bias, meta_bias, w_branch_na, w_branch_fn,
              w_out, g_mix, g_mlp, w_up, w_down, g_final):
    y_prompt = run_trunk(x_prompt, meta_tokens, w_in, rel_bias, meta_bias, w_branch_na, w_branch_fn,
                         w_out, g_mix, g_mlp, w_up, w_down, g_final)
    y_sample = run_trunk(x_sample, meta_tokens, w_in, rel_bias, meta_bias, w_branch_na, w_branch_fn,
                         w_out, g_mix, g_mlp, w_up, w_down, g_final)
    return (y_prompt, y_sample)
```

```cpp
#include <hip/hip_runtime.h>
#include <hip/hip_cooperative_groups.h>
#include <cstdio>
#include <cstdint>
namespace cg = cooperative_groups;

#ifndef MK_PER_PHASE
#define MK_PER_PHASE 0
#endif

#define LAS __attribute__((address_space(3)))
typedef unsigned short bf16_t;
typedef short bf16x8 __attribute__((ext_vector_type(8)));
typedef float f32x4 __attribute__((ext_vector_type(4)));
typedef float f32x2 __attribute__((ext_vector_type(2)));
typedef unsigned u32x4 __attribute__((ext_vector_type(4)));
typedef unsigned u32x2 __attribute__((ext_vector_type(2)));

constexpr int D = 1024, TP = 8192, TS = 4096, MT = 4 * TP + 4 * TS;
constexpr int NP = TP + 16, NS = TS + 16;
constexpr int KPP = 4224, KPS = 2176;
constexpr int MRP = 4352, MRS = 2304;
constexpr float RMS_EPS = 1e-6f;
constexpr size_t MiB = 1u << 20;
constexpr size_t SS1_OFF = 64 * 1024, SS2_OFF = 256 * 1024, KMETA_OFF = 512 * 1024, VMETAT_OFF = 528 * 1024;
constexpr size_t WINA_OFF = 1 * MiB, WINB_OFF = 7 * MiB, WUP_OFF = 9 * MiB, WDN_OFF = 17 * MiB, WOUT_OFF = 25 * MiB, WNA_OFF = 27 * MiB, WFN_OFF = 28 * MiB;
constexpr size_t XB_OFF = 30 * MiB;
constexpr size_t CP_OFF = 126 * MiB, SP_OFF = CP_OFF + (size_t)MRP * KPP * 2, CS_OFF = SP_OFF + (size_t)MRP * KPP * 2, SSM_OFF = CS_OFF + (size_t)MRS * KPS * 2;
constexpr size_t Q_OFF = 234 * MiB, K_OFF = 282 * MiB, VT_OFF = 330 * MiB, UT_OFF = 378 * MiB;
constexpr size_t ATT_OFF = 30 * MiB, UE_OFF = 427 * MiB, UO_OFF = 452 * MiB;
constexpr size_t PQ_OFF = 234 * MiB, MIX_OFF = 78 * MiB, X1B_OFF = 414 * MiB, H_OFF = 30 * MiB;
constexpr size_t WS_NEED = 510 * MiB;
static_assert(SSM_OFF + (size_t)MRS * KPS * 2 <= 234 * MiB, "dft matrices");
static_assert(UT_OFF + (size_t)512 * 2 * (4 * NP + 4 * NS) <= UE_OFF, "ut");
constexpr int LDS_BYTES = 160 * 1024;

__device__ __forceinline__ unsigned cvt_pk_bf16(float lo, float hi) { unsigned r; asm volatile("v_cvt_pk_bf16_f32 %0, %1, %2" : "=v"(r) : "v"(lo), "v"(hi)); return r; }
__device__ __forceinline__ float bf_lo(unsigned w) { return __uint_as_float(w << 16); }
__device__ __forceinline__ float bf_hi(unsigned w) { return __uint_as_float(w & 0xffff0000u); }
__device__ __forceinline__ float wave_sum(float v) {
#pragma unroll
    for (int o = 1; o < 64; o <<= 1) v += __shfl_xor(v, o);
    return v;
}
__device__ __forceinline__ int batch_base(int b) { return b < 4 ? b * TP : 4 * TP + (b - 4) * TS; }

struct Params {
    const float* xp; const float* xs; const float* meta; const float* w_in; const float* rel_bias; const float* meta_bias;
    const float* w_na; const float* w_fn; const float* w_out; const float* g_mix; const float* g_mlp; const float* w_up; const float* w_down; const float* g_final;
    float* out; unsigned char* ws; int ph_lo, ph_hi;
};

namespace pg8 {
constexpr int BM = 256, BK = 64, HALF = 128, HTB = HALF * BK * 2, STAGE_BYTES = 8 * HTB;
__device__ __forceinline__ int lds_byte(int r, int c) { const int st = (r >> 4) * 2 + (c >> 5), rr = r & 15, cc = c & 31, ob = rr * 64 + cc * 2; return st * 1024 + (ob ^ (((ob >> 9) & 1) << 5)); }
__device__ __forceinline__ void stage_rc(int b, int& R, int& C) { const int st = b / 1024, sb = b % 1024, swz = sb ^ (((sb >> 9) & 1) << 5); R = (st >> 1) * 16 + swz / 64; C = (st & 1) * 32 + (swz % 64) / 2; }
__device__ __forceinline__ int perm32(int rho) { const int n = rho >> 4, i = rho & 15; return 8 * (i >> 2) + 4 * n + (i & 3); }

struct Unit { const char* A; const char* B; int pa, pb, nt, pm, pn, aux; };

__device__ __forceinline__ bool rect_tile(long L, int nM, int nN, int& pm, int& pn) {
    const int nwg = nM * nN; if (L >= nwg) return false;
    int wgid = (int)L; { const int q = nwg / 8, r = nwg % 8, xcd = wgid % 8, off = wgid / 8; wgid = (xcd < r ? xcd * (q + 1) : r * (q + 1) + (xcd - r) * q) + off; }
    const int nig = 8 * nN, gid = wgid / nig, fm = gid * 8, gsz = (nM - fm) < 8 ? (nM - fm) : 8;
    pm = fm + ((wgid % nig) % gsz); pn = (wgid % nig) / gsz; return true;
}

template <bool TRANS, class Epi, class Sched>
__device__ __forceinline__ void gemm_phase(LAS unsigned char* lds, const Sched& S, const Epi& E) {
    const int tid = threadIdx.x, wid = __builtin_amdgcn_readfirstlane(tid >> 6), lane = tid & 63, wr = wid >> 2, wc = wid & 3, fr = lane & 15, fq = lane >> 4;
    int RA[2], RB[2], CB[2];
#pragma unroll
    for (int i = 0; i < 2; ++i) { int R, C; stage_rc(tid * 16 + i * 8192, R, C); RA[i] = R; RB[i] = Epi::PERM ? ((R & ~31) + perm32(R & 31)) : R; CB[i] = C * 2; }
    const unsigned ldsw = (unsigned)wid * 1024u;
    const int aoff = lds_byte(wr * 64 + fr, fq * 8), boff = lds_byte(wc * 32 + fr, fq * 8);
#define PG8_SA(b, h) (((b) * 2 + (h)) * HTB)
#define PG8_SB(b, h) ((4 + (b) * 2 + (h)) * HTB)
#define PG8_STAGE(bufoff, gbase, pitch, RR) do { _Pragma("unroll") for (int _i = 0; _i < 2; ++_i) \
        __builtin_amdgcn_global_load_lds((const unsigned*)((const char*)(gbase) + (unsigned)((RR)[_i] * (pitch) + CB[_i])), (LAS unsigned*)(lds + (bufoff) + ldsw + _i * 8192), 16, 0, 0); } while (0)
#define PG8_LDA(dst, b, h) do { _Pragma("unroll") for (int m = 0; m < 4; ++m) _Pragma("unroll") for (int k = 0; k < 2; ++k) dst[m][k] = *(const LAS bf16x8*)(lds + PG8_SA(b, h) + aoff + m * 2048 + k * 1024); } while (0)
#define PG8_LDB(dst, b, h) do { _Pragma("unroll") for (int n = 0; n < 2; ++n) _Pragma("unroll") for (int k = 0; k < 2; ++k) dst[n][k] = *(const LAS bf16x8*)(lds + PG8_SB(b, h) + boff + n * 2048 + k * 1024); } while (0)
#define PG8_MMA(ai, bj, At, Bt) do { __builtin_amdgcn_s_setprio(1); _Pragma("unroll") for (int m = 0; m < 4; ++m) _Pragma("unroll") for (int n = 0; n < 2; ++n) _Pragma("unroll") for (int k = 0; k < 2; ++k) \
        acc[ai][bj][m][n] = TRANS ? __builtin_amdgcn_mfma_f32_16x16x32_bf16(At[m][k], Bt[n][k], acc[ai][bj][m][n], 0, 0, 0) \
                                  : __builtin_amdgcn_mfma_f32_16x16x32_bf16(Bt[n][k], At[m][k], acc[ai][bj][m][n], 0, 0, 0); __builtin_amdgcn_s_setprio(0); } while (0)
#define PG8_WAIT_V(n) asm volatile("s_waitcnt vmcnt(" #n ")" ::: "memory")
#define PG8_WAIT_L(n) asm volatile("s_waitcnt lgkmcnt(" #n ")" ::: "memory")
#define PG8_BAR __builtin_amdgcn_s_barrier()
#define PG8_SCHED __builtin_amdgcn_sched_barrier(0)
    Unit cur, nxt; int ui = 0;
    if (!S.next(0, cur)) return;
    f32x4 acc[2][2][4][2];
#pragma unroll
    for (int a = 0; a < 2; ++a)
#pragma unroll
        for (int b = 0; b < 2; ++b)
#pragma unroll
            for (int m = 0; m < 4; ++m)
#pragma unroll
                for (int n = 0; n < 2; ++n) acc[a][b][m][n] = (f32x4){0.f, 0.f, 0.f, 0.f};
    bf16x8 At[4][2], B0[2][2], B1[2][2];
    const char* cA = cur.A; const char* cB = cur.B; int cpa = cur.pa, cpb = cur.pb;
    {
        const size_t hA = (size_t)HALF * cpa, hB = (size_t)HALF * cpb;
        PG8_STAGE(PG8_SB(0, 0), cB, cpb, RB); PG8_STAGE(PG8_SB(0, 1), cB + hB, cpb, RB); PG8_STAGE(PG8_SA(0, 0), cA, cpa, RA); PG8_STAGE(PG8_SA(0, 1), cA + hA, cpa, RA);
        if (wr == 1) PG8_BAR;
        PG8_WAIT_V(2); PG8_BAR;
        PG8_STAGE(PG8_SB(1, 0), cB + 128, cpb, RB); PG8_STAGE(PG8_SA(1, 0), cA + 128, cpa, RA); PG8_STAGE(PG8_SB(1, 1), cB + hB + 128, cpb, RB);
        PG8_WAIT_V(6); PG8_BAR;
    }
    for (;;) {
        const bool has_next = S.next(ui + 1, nxt);
        const char* nA = has_next ? nxt.A : cA; const char* nB = has_next ? nxt.B : cB; const int npa = has_next ? nxt.pa : cpa, npb = has_next ? nxt.pb : cpb;
        const int nt = cur.nt; const size_t hA = (size_t)HALF * cpa;
        for (int t = 0; t < nt; t += 2) {
            const bool last = (t == nt - 2);
            const char* a1 = cA + (size_t)(t + 1) * 128;
            const char* a2 = last ? nA : cA + (size_t)(t + 2) * 128; const char* b2 = last ? nB : cB + (size_t)(t + 2) * 128;
            const int pa2 = last ? npa : cpa, pb2 = last ? npb : cpb; const size_t hA2 = (size_t)HALF * pa2, hB2 = (size_t)HALF * pb2;
            const char* a3 = a2 + 128; const char* b3 = b2 + 128;
            PG8_LDB(B0, 0, 0); PG8_LDB(B1, 0, 1); PG8_SCHED; PG8_LDA(At, 0, 0); PG8_STAGE(PG8_SA(1, 1), a1 + hA, cpa, RA);
            PG8_WAIT_V(8); PG8_WAIT_L(0); PG8_BAR; PG8_MMA(0, 0, At, B0); PG8_MMA(0, 1, At, B1); PG8_BAR; PG8_SCHED;
            PG8_LDA(At, 0, 1); PG8_STAGE(PG8_SB(0, 0), b2, pb2, RB); PG8_STAGE(PG8_SB(0, 1), b2 + hB2, pb2, RB); PG8_STAGE(PG8_SA(0, 0), a2, pa2, RA);
            PG8_WAIT_V(8); PG8_WAIT_L(0); PG8_BAR; PG8_MMA(1, 0, At, B0); PG8_MMA(1, 1, At, B1); PG8_BAR; PG8_SCHED;
            PG8_LDB(B0, 1, 0); PG8_LDB(B1, 1, 1); PG8_SCHED; PG8_LDA(At, 1, 0); PG8_STAGE(PG8_SA(0, 1), a2 + hA2, pa2, RA);
            PG8_WAIT_V(8); PG8_WAIT_L(0); PG8_BAR; PG8_MMA(0, 0, At, B0); PG8_MMA(0, 1, At, B1); PG8_BAR; PG8_SCHED;
            PG8_LDA(At, 1, 1); PG8_STAGE(PG8_SB(1, 0), b3, pb2, RB); PG8_STAGE(PG8_SB(1, 1), b3 + hB2, pb2, RB); PG8_STAGE(PG8_SA(1, 0), a3, pa2, RA);
            PG8_WAIT_V(8); PG8_WAIT_L(0); PG8_BAR; PG8_MMA(1, 0, At, B0); PG8_MMA(1, 1, At, B1); PG8_BAR; PG8_SCHED;
        }
        if (wr == 0) PG8_BAR;
        const bool keep = E(acc, cur, wr, wc, fr, fq);
        if (!has_next) break;
        if (!keep) {
#pragma unroll
            for (int a = 0; a < 2; ++a)
#pragma unroll
                for (int b = 0; b < 2; ++b)
#pragma unroll
                    for (int m = 0; m < 4; ++m)
#pragma unroll
                        for (int n = 0; n < 2; ++n) acc[a][b][m][n] = (f32x4){0.f, 0.f, 0.f, 0.f};
        }
        cur = nxt; cA = nA; cB = nB; cpa = npa; cpb = npb; ++ui;
        if (wr == 1) PG8_BAR;
    }
    PG8_WAIT_V(0);
    PG8_BAR;
#undef PG8_SA
#undef PG8_SB
#undef PG8_STAGE
#undef PG8_LDA
#undef PG8_LDB
#undef PG8_MMA
#undef PG8_WAIT_V
#undef PG8_WAIT_L
#undef PG8_BAR
#undef PG8_SCHED
}
}
using pg8::Unit;

template <int NSUB> struct SchedRect {
    const char* A0; const char* B0; const char* A1; const char* B1; int pa0, nt0, pa1, nt1; int nM, nN, G, c;
    __device__ __forceinline__ bool next(int i, Unit& u) const {
        const int ti = i / NSUB, s = i % NSUB; int pm, pn;
        if (!pg8::rect_tile((long)ti * G + c, nM, nN, pm, pn)) return false;
        const int pa = (NSUB > 1 && s) ? pa1 : pa0;
        u.pa = pa; u.pb = pa; u.nt = (NSUB > 1 && s) ? nt1 : nt0; u.pm = pm; u.pn = pn; u.aux = s;
        u.A = ((NSUB > 1 && s) ? A1 : A0) + (size_t)pm * 256 * pa; u.B = ((NSUB > 1 && s) ? B1 : B0) + (size_t)pn * 256 * pa; return true;
    }
};

struct SchedDft {
    const char* ws; int G, c;
    __device__ __forceinline__ bool next(int i, Unit& u) const {
        const long L = (long)i * G + c; if (L >= 416) return false;
        int pm, b, pn;
        if (L < 272) {
            if (L < 256) { const int x = (int)L & 7, s = (int)L >> 3; pm = 8 * (x >> 2) + (s & 7); b = s >> 3; pn = x & 3; }
            else { const int e = (int)L - 256; pm = 16; b = e >> 2; pn = e & 3; }
            u.pa = KPP * 2; u.pb = KPP * 2; u.nt = KPP / 64;
            u.A = ws + (pn < 2 ? CP_OFF : SP_OFF) + (size_t)pm * 256 * KPP * 2;
            u.B = ws + (pn < 2 ? UE_OFF : UO_OFF) + ((size_t)b * 512 + (pn & 1) * 256) * KPP * 2;
        } else {
            const int l = (int)L - 272, x = l & 7, s = l >> 3; pn = x & 3; pm = s % 9; b = 4 + 2 * (s / 9) + (x >> 2);
            u.pa = KPS * 2; u.pb = KPS * 2; u.nt = KPS / 64;
            u.A = ws + (pn < 2 ? CS_OFF : SSM_OFF) + (size_t)pm * 256 * KPS * 2;
            u.B = ws + (pn < 2 ? UE_OFF : UO_OFF) + (size_t)4 * 512 * KPP * 2 + ((size_t)(b - 4) * 512 + (pn & 1) * 256) * KPS * 2;
        }
        u.pm = pm; u.pn = pn; u.aux = b; return true;
    }
};

__device__ __forceinline__ float sigmoidf_(float v) { return __builtin_amdgcn_rcpf(1.0f + __builtin_amdgcn_exp2f(-1.44269504f * v)); }
typedef f32x4 Acc[2][2][4][2];

struct EpiP1a {
    static constexpr bool PERM = true;
    unsigned char* ws; float* gates;
    __device__ __forceinline__ bool operator()(Acc& acc, const Unit& u, int wr, int wc, int fr, int fq) const {
        asm volatile("" : "+v"(fr), "+v"(fq));
        bf16_t* base; int ldc, colt; bool sig = false;
        if (u.pn < 2) { base = (bf16_t*)(ws + Q_OFF); ldc = 512; colt = u.pn * 256; }
        else if (u.pn < 4) { base = (bf16_t*)(ws + K_OFF); ldc = 512; colt = (u.pn - 2) * 256; }
        else if (u.pn < 8) { base = (bf16_t*)gates; ldc = 1024; colt = (u.pn - 4) * 256; sig = true; }
        else { base = (bf16_t*)gates + (size_t)MT * 1024; ldc = 1024; colt = (u.pn - 8) * 256; sig = true; }
        const int row0 = u.pm * 256 + wr * 64 + fr, col0 = colt + wc * 32 + 8 * fq;
#pragma unroll
        for (int ai = 0; ai < 2; ++ai)
#pragma unroll
            for (int m = 0; m < 4; ++m) { bf16_t* rowp = base + (size_t)(row0 + ai * 128 + m * 16) * ldc + col0;
#pragma unroll
                for (int bj = 0; bj < 2; ++bj) { f32x4 v0 = acc[ai][bj][m][0], v1 = acc[ai][bj][m][1];
                    if (sig) {
#pragma unroll
                        for (int e = 0; e < 4; ++e) { v0[e] = sigmoidf_(v0[e]); v1[e] = sigmoidf_(v1[e]); } }
                    u32x4 w; w.x = cvt_pk_bf16(v0[0], v0[1]); w.y = cvt_pk_bf16(v0[2], v0[3]); w.z = cvt_pk_bf16(v1[0], v1[1]); w.w = cvt_pk_bf16(v1[2], v1[3]);
                    *(u32x4*)(rowp + bj * 128) = w; } }
        return false;
    }
};
struct EpiP1b {
    static constexpr bool PERM = false;
    unsigned char* ws;
    __device__ __forceinline__ bool operator()(Acc& acc, const Unit& u, int wr, int wc, int fr, int fq) const {
        asm volatile("" : "+v"(fr), "+v"(fq));
        const int g0 = u.pm * 256; const int b = g0 < 4 * TP ? g0 / TP : 4 + (g0 - 4 * TP) / TS; const int gb = batch_base(b), T = b < 4 ? TP : TS, N = T + 16;
        bf16_t* base; size_t pitch; int coff;
        if (u.pn < 2) { base = (bf16_t*)(ws + VT_OFF) + (size_t)512 * gb; pitch = T; coff = u.pn * 256; }
        else { base = (bf16_t*)(ws + UT_OFF) + (b < 4 ? (size_t)b * 512 * NP : (size_t)4 * 512 * NP + (size_t)(b - 4) * 512 * NS) + 16; pitch = N; coff = (u.pn - 2) * 256; }
        const int t0 = g0 - gb + wr * 64 + 4 * fq, c0 = coff + wc * 32 + fr;
#pragma unroll
        for (int ai = 0; ai < 2; ++ai)
#pragma unroll
            for (int bj = 0; bj < 2; ++bj)
#pragma unroll
                for (int m = 0; m < 4; ++m)
#pragma unroll
                    for (int n = 0; n < 2; ++n) { const f32x4 v = acc[ai][bj][m][n]; u32x2 w; w.x = cvt_pk_bf16(v[0], v[1]); w.y = cvt_pk_bf16(v[2], v[3]);
                        *(u32x2*)(base + (size_t)(c0 + bj * 128 + n * 16) * pitch + t0 + ai * 128 + m * 16) = w; }
        return false;
    }
};
struct EpiDft {
    static constexpr bool PERM = true;
    unsigned char* ws;
    __device__ __forceinline__ bool operator()(Acc& acc, const Unit& u, int wr, int wc, int fr, int fq) const {
        asm volatile("" : "+v"(fr), "+v"(fq));
        const int b = u.aux, gb = batch_base(b), N = (b < 4 ? TP : TS) + 16, HN = N / 2;
        bf16_t* base = (bf16_t*)(ws + PQ_OFF) + (size_t)gb * 1024 + u.pn * 256 + wc * 32 + 8 * fq;
        const float sg = u.pn >= 2 ? -1.f : 1.f;
#pragma unroll
        for (int ai = 0; ai < 2; ++ai)
#pragma unroll
            for (int m = 0; m < 4; ++m) { const int np = u.pm * 256 + ai * 128 + wr * 64 + m * 16 + fr + 1;
                if (np <= HN) {
#pragma unroll
                    for (int bj = 0; bj < 2; ++bj) { const f32x4 v0 = acc[ai][bj][m][0], v1 = acc[ai][bj][m][1];
                        if (np >= 16) { u32x4 w; w.x = cvt_pk_bf16(v0[0], v0[1]); w.y = cvt_pk_bf16(v0[2], v0[3]); w.z = cvt_pk_bf16(v1[0], v1[1]); w.w = cvt_pk_bf16(v1[2], v1[3]);
                            *(u32x4*)(base + (size_t)(np - 16) * 1024 + bj * 128) = w; }
                        if (np != HN) { u32x4 w; w.x = cvt_pk_bf16(sg * v0[0], sg * v0[1]); w.y = cvt_pk_bf16(sg * v0[2], sg * v0[3]); w.z = cvt_pk_bf16(sg * v1[0], sg * v1[1]); w.w = cvt_pk_bf16(sg * v1[2], sg * v1[3]);
                            *(u32x4*)(base + (size_t)(N - np - 16) * 1024 + bj * 128) = w; } } } }
        return false;
    }
};
struct EpiMerge {
    static constexpr bool PERM = true;
    unsigned char* ws; const float* gates;
    __device__ __forceinline__ bool operator()(Acc& acc, const Unit& u, int wr, int wc, int fr, int fq) const {
        asm volatile("" : "+v"(fr), "+v"(fq));
        const bf16_t* G1 = (const bf16_t*)gates; const bf16_t* G2 = G1 + (size_t)MT * 1024;
        const int row0 = u.pm * 256 + wr * 64 + fr, col0 = u.pn * 256 + wc * 32 + 8 * fq;
        bf16_t* mix = (bf16_t*)(ws + MIX_OFF);
#pragma unroll
        for (int ai = 0; ai < 2; ++ai)
#pragma unroll
            for (int m = 0; m < 4; ++m) { const size_t off = (size_t)(row0 + ai * 128 + m * 16) * 1024 + col0;
#pragma unroll
                for (int bj = 0; bj < 2; ++bj) { const u32x4 w2 = *(const u32x4*)(G2 + off + bj * 128);
                    float s2[8] = {bf_lo(w2.x), bf_hi(w2.x), bf_lo(w2.y), bf_hi(w2.y), bf_lo(w2.z), bf_hi(w2.z), bf_lo(w2.w), bf_hi(w2.w)};
#pragma unroll
                    for (int e = 0; e < 8; ++e) s2[e] = fmaxf(s2[e], 1e-20f);
                    if (u.aux == 0) { const u32x4 w1 = *(const u32x4*)(G1 + off + bj * 128);
                        const float s1[8] = {bf_lo(w1.x), bf_hi(w1.x), bf_lo(w1.y), bf_hi(w1.y), bf_lo(w1.z), bf_hi(w1.z), bf_lo(w1.w), bf_hi(w1.w)};
#pragma unroll
                        for (int e = 0; e < 4; ++e) { acc[ai][bj][m][0][e] *= s1[e] * __builtin_amdgcn_rcpf(s2[e]); acc[ai][bj][m][1][e] *= s1[4 + e] * __builtin_amdgcn_rcpf(s2[4 + e]); }
                    } else { const f32x4 v0 = acc[ai][bj][m][0], v1 = acc[ai][bj][m][1]; u32x4 w;
                        w.x = cvt_pk_bf16(v0[0] * s2[0], v0[1] * s2[1]); w.y = cvt_pk_bf16(v0[2] * s2[2], v0[3] * s2[3]); w.z = cvt_pk_bf16(v1[0] * s2[4], v1[1] * s2[5]); w.w = cvt_pk_bf16(v1[2] * s2[6], v1[3] * s2[7]);
                        *(u32x4*)(mix + off + bj * 128) = w; } } }
        return u.aux == 0;
    }
};
template <bool WITH_BF16> struct EpiRes {
    static constexpr bool PERM = false;
    const float* bp; const float* bs; float* out; bf16_t* ob; float* ss;
    __device__ __forceinline__ bool operator()(Acc& acc, const Unit& u, int wr, int wc, int fr, int fq) const {
        asm volatile("" : "+v"(fr), "+v"(fq));
        const int g0 = u.pm * 256; const float* base = g0 < 4 * TP ? bp + (size_t)g0 * 1024 : bs + (size_t)(g0 - 4 * TP) * 1024;
        const int lr0 = wr * 64 + fr, col0 = u.pn * 256 + wc * 32 + 4 * fq;
#pragma unroll
        for (int ai = 0; ai < 2; ++ai)
#pragma unroll
            for (int m = 0; m < 4; ++m) { const int lr = lr0 + ai * 128 + m * 16; float s = 0.f;
#pragma unroll
                for (int bj = 0; bj < 2; ++bj)
#pragma unroll
                    for (int n = 0; n < 2; ++n) { const int c = col0 + bj * 128 + n * 16; const f32x4 o = *(const f32x4*)(base + (size_t)lr * 1024 + c) + acc[ai][bj][m][n];
                        *(f32x4*)(out + (size_t)(g0 + lr) * 1024 + c) = o; s += (o[0] * o[0] + o[1] * o[1]) + (o[2] * o[2] + o[3] * o[3]);
                        if (WITH_BF16) { u32x2 w; w.x = cvt_pk_bf16(o[0], o[1]); w.y = cvt_pk_bf16(o[2], o[3]); *(u32x2*)(ob + (size_t)(g0 + lr) * 1024 + c) = w; } }
                s += __shfl_xor(s, 16); s += __shfl_xor(s, 32);
                if (fq == 0) atomicAdd(ss + g0 + lr, s); }
        return false;
    }
};
struct EpiUp {
    static constexpr bool PERM = true;
    bf16_t* H; const float* ss;
    __device__ __forceinline__ bool operator()(Acc& acc, const Unit& u, int wr, int wc, int fr, int fq) const {
        asm volatile("" : "+v"(fr), "+v"(fq));
        const int row0 = u.pm * 256 + wr * 64 + fr, col0 = u.pn * 256 + wc * 32 + 8 * fq;
#pragma unroll
        for (int ai = 0; ai < 2; ++ai)
#pragma unroll
            for (int m = 0; m < 4; ++m) { const int row = row0 + ai * 128 + m * 16; const float rinv = rsqrtf(ss[row] * (1.0f / 1024.0f) + RMS_EPS);
#pragma unroll
                for (int bj = 0; bj < 2; ++bj) { f32x4 v0 = acc[ai][bj][m][0], v1 = acc[ai][bj][m][1];
#pragma unroll
                    for (int e = 0; e < 4; ++e) { const float a = fmaxf(v0[e] * rinv, 0.f), b = fmaxf(v1[e] * rinv, 0.f); v0[e] = a * a; v1[e] = b * b; }
                    u32x4 w; w.x = cvt_pk_bf16(v0[0], v0[1]); w.y = cvt_pk_bf16(v0[2], v0[3]); w.z = cvt_pk_bf16(v1[0], v1[1]); w.w = cvt_pk_bf16(v1[2], v1[3]);
                    *(u32x4*)(H + (size_t)row * 4096 + col0 + bj * 128) = w; } }
        return false;
    }
};

__device__ __forceinline__ void p0_transpose_item(const float* W, int K, int N, bf16_t* WT, int out_row0, int n0, int k0, const float* sc, float mul, LAS float* scr, int lane) {
#pragma unroll 8
    for (int i = 0; i < 32; ++i) { const int kk = 2 * i + (lane >> 5); const float s = sc ? sc[k0 + kk] * mul : mul; scr[kk * 33 + (lane & 31)] = W[(size_t)(k0 + kk) * N + n0 + (lane & 31)] * s; }
    asm volatile("s_waitcnt lgkmcnt(0)" ::: "memory");
    const int c = lane & 7;
#pragma unroll
    for (int j = 0; j < 4; ++j) { const int n = (lane >> 3) + 8 * j; const LAS float* s = scr + (8 * c) * 33 + n;
        u32x4 o; o.x = cvt_pk_bf16(s[0 * 33], s[1 * 33]); o.y = cvt_pk_bf16(s[2 * 33], s[3 * 33]); o.z = cvt_pk_bf16(s[4 * 33], s[5 * 33]); o.w = cvt_pk_bf16(s[6 * 33], s[7 * 33]);
        *(u32x4*)(WT + (size_t)(out_row0 + n) * K + k0 + 8 * c) = o; }
    asm volatile("s_waitcnt lgkmcnt(0)" ::: "memory");
}

__device__ __forceinline__ void p0_prologue(const Params& p, LAS unsigned char* lds) {
    const int tid = threadIdx.x, lane = tid & 63, wid = tid >> 6, G = gridDim.x, bx = blockIdx.x;
    const int gw = bx * 8 + wid, NGW = G * 8, gt = bx * 512 + tid, NGT = G * 512;
    unsigned char* ws = p.ws;
    for (int i = gt; i < MT; i += NGT) { ((float*)(ws + SS1_OFF))[i] = 0.f; ((float*)(ws + SS2_OFF))[i] = 0.f; }
    if (bx < 24) {
        LAS float* hm = (LAS float*)lds;
        LAS float* red = (LAS float*)(lds + 65536);
        for (int r = wid * 2; r < wid * 2 + 2; ++r) { float v[16]; float s = 0.f;
#pragma unroll
            for (int j = 0; j < 16; ++j) { v[j] = p.meta[r * 1024 + lane + 64 * j]; s += v[j] * v[j]; }
            const float rinv = rsqrtf(wave_sum(s) * (1.0f / 1024.0f) + RMS_EPS);
#pragma unroll
            for (int j = 0; j < 16; ++j) hm[r * 1024 + lane + 64 * j] = v[j] * rinv * p.g_mix[lane + 64 * j]; }
        __syncthreads();
        const int n = 512 + bx * 64 + lane; float a[16];
#pragma unroll
        for (int r = 0; r < 16; ++r) a[r] = 0.f;
        for (int k = wid * 128; k < wid * 128 + 128; ++k) { const float w = p.w_in[(size_t)k * 4096 + n];
#pragma unroll
            for (int r = 0; r < 16; ++r) a[r] += hm[r * 1024 + k] * w; }
#pragma unroll
        for (int r = 0; r < 16; ++r) red[(wid * 16 + r) * 64 + lane] = a[r];
        __syncthreads();
        for (int o = tid; o < 1024; o += 512) { const int r = o >> 6, l = o & 63; float s = 0.f;
#pragma unroll
            for (int w = 0; w < 8; ++w) s += red[(w * 16 + r) * 64 + l];
            const int nn = 512 + bx * 64 + l; const bf16_t hv = (bf16_t)(cvt_pk_bf16(s, 0.f) & 0xffffu);
            if (nn < 1024) ((bf16_t*)(ws + KMETA_OFF))[r * 512 + nn - 512] = hv;
            else if (nn < 1536) ((bf16_t*)(ws + VMETAT_OFF))[(nn - 1024) * 16 + r] = hv;
            else { const int ch = nn - 1536;
                for (int b = 0; b < 8; ++b) { bf16_t* ut = (bf16_t*)(ws + UT_OFF) + (b < 4 ? (size_t)b * 512 * NP + (size_t)ch * NP : (size_t)4 * 512 * NP + (size_t)(b - 4) * 512 * NS + (size_t)ch * NS); ut[r] = hv; } } }
        __syncthreads();
    }
    {
        LAS float* scr = (LAS float*)(lds + wid * 8448);
        constexpr int I_IN = 16 * 128, I_UP = 16 * 128, I_DN = 64 * 32, I_OUT = 16 * 32, I_NA = 8 * 32, NIT = I_IN + I_UP + I_DN + I_OUT + I_NA;
        for (int it = gw; it < NIT; it += NGW) {
            int r = it;
            if (r < I_IN) { const int kb = r / 128, nb = r % 128, n0 = nb * 32; bf16_t* dst; int orow; float mul = 1.f;
                if (n0 < 512) { dst = (bf16_t*)(ws + WINA_OFF); orow = n0; mul = 0.125f; } else if (n0 < 1024) { dst = (bf16_t*)(ws + WINA_OFF); orow = n0; }
                else if (n0 < 2048) { dst = (bf16_t*)(ws + WINB_OFF); orow = n0 - 1024; } else { dst = (bf16_t*)(ws + WINA_OFF); orow = n0 - 1024; }
                p0_transpose_item(p.w_in, 1024, 4096, dst, orow, n0, kb * 64, p.g_mix, mul, scr, lane); continue; } r -= I_IN;
            if (r < I_UP) { const int kb = r / 128, nb = r % 128; p0_transpose_item(p.w_up, 1024, 4096, (bf16_t*)(ws + WUP_OFF), nb * 32, nb * 32, kb * 64, p.g_mlp, 1.f, scr, lane); continue; } r -= I_UP;
            if (r < I_DN) { const int kb = r / 32, nb = r % 32; p0_transpose_item(p.w_down, 4096, 1024, (bf16_t*)(ws + WDN_OFF), nb * 32, nb * 32, kb * 64, nullptr, 1.f, scr, lane); continue; } r -= I_DN;
            if (r < I_OUT) { const int kb = r / 32, nb = r % 32; p0_transpose_item(p.w_out, 1024, 1024, (bf16_t*)(ws + WOUT_OFF), nb * 32, nb * 32, kb * 64, nullptr, 1.f, scr, lane); continue; } r -= I_OUT;
            { const int kb = r / 32, nb = r % 32; p0_transpose_item(p.w_na, 512, 1024, (bf16_t*)(ws + WNA_OFF), nb * 32, nb * 32, kb * 64, nullptr, 1.f, scr, lane); }
        }
    }
    for (int o = gt; o < 1024 * 1024; o += NGT) { const int d = o >> 10, kk = o & 1023, c = kk & 127, g = (kk & 511) >> 7; const bool isS = kk >= 512;
        const float* wf = p.w_fn + (size_t)g * 128 * 1024 + d; float s = 0.f;
        for (int cp = 0; cp < 128; ++cp) { const float tr = (float)((c * cp) & 127) * (1.0f / 128.0f); const float t = isS ? -__builtin_amdgcn_sinf(tr) : __builtin_amdgcn_cosf(tr); s += t * wf[(size_t)cp * 1024]; }
        ((bf16_t*)(ws + WFN_OFF))[o] = (bf16_t)(cvt_pk_bf16(s, 0.f) & 0xffffu); }
    {
        constexpr int IP = MRP * (KPP / 8), IS = MRS * (KPS / 8);
        for (int it = gt; it < IP + IS; it += NGT) {
            int i, j, N, KP; bf16_t* cm; bf16_t* sm;
            if (it < IP) { i = it / (KPP / 8); j = it % (KPP / 8); N = NP; KP = KPP; cm = (bf16_t*)(ws + CP_OFF); sm = (bf16_t*)(ws + SP_OFF); }
            else { const int q = it - IP; i = q / (KPS / 8); j = q % (KPS / 8); N = NS; KP = KPS; cm = (bf16_t*)(ws + CS_OFF); sm = (bf16_t*)(ws + SSM_OFF); }
            const int np = i + 1, HN = N / 2; const float norm = rsqrtf(128.0f * (float)N), invN = 1.0f / (float)N;
            float cv[8], sv[8]; int mm = (int)(((long)np * (8 * j)) % N);
#pragma unroll
            for (int e = 0; e < 8; ++e) { const int k = 8 * j + e; const bool ok = (np <= HN) && (k <= HN); const float tr = (float)mm * invN;
                cv[e] = ok ? __builtin_amdgcn_cosf(tr) * norm : 0.f; sv[e] = ok ? __builtin_amdgcn_sinf(tr) * norm : 0.f; mm += np; if (mm >= N) mm -= N; }
            u32x4 wc_, ws_; wc_.x = cvt_pk_bf16(cv[0], cv[1]); wc_.y = cvt_pk_bf16(cv[2], cv[3]); wc_.z = cvt_pk_bf16(cv[4], cv[5]); wc_.w = cvt_pk_bf16(cv[6], cv[7]);
            ws_.x = cvt_pk_bf16(sv[0], sv[1]); ws_.y = cvt_pk_bf16(sv[2], sv[3]); ws_.z = cvt_pk_bf16(sv[4], sv[5]); ws_.w = cvt_pk_bf16(sv[6], sv[7]);
            *(u32x4*)(cm + (size_t)i * KP + 8 * j) = wc_; *(u32x4*)(sm + (size_t)i * KP + 8 * j) = ws_;
        }
    }
    for (int g = gw; g < MT; g += NGW) { const float* xr = g < 4 * TP ? p.xp + (size_t)g * 1024 : p.xs + (size_t)(g - 4 * TP) * 1024;
        f32x4 v[4]; float s = 0.f;
#pragma unroll
        for (int j = 0; j < 4; ++j) { v[j] = ((const f32x4*)xr)[lane + 64 * j]; s += (v[j][0] * v[j][0] + v[j][1] * v[j][1]) + (v[j][2] * v[j][2] + v[j][3] * v[j][3]); }
        const float rinv = rsqrtf(wave_sum(s) * (1.0f / 1024.0f) + RMS_EPS);
        u32x2* o = (u32x2*)((bf16_t*)(ws + XB_OFF) + (size_t)g * 1024);
#pragma unroll
        for (int j = 0; j < 4; ++j) { u32x2 w; w.x = cvt_pk_bf16(v[j][0] * rinv, v[j][1] * rinv); w.y = cvt_pk_bf16(v[j][2] * rinv, v[j][3] * rinv); o[lane + 64 * j] = w; } }
}

constexpr int A_KS = 0, A_VS = 73728, A_KM = 147456, A_VM = 149504, A_BS = 151552, A_MB = 155392;
__device__ __forceinline__ void attn_phase(const Params& p, LAS unsigned char* lds) {
    const int tid = threadIdx.x, lane = tid & 63, wid = __builtin_amdgcn_readfirstlane(tid >> 6), G = gridDim.x, bx = blockIdx.x;
    const int li = lane & 15, g = lane >> 4;
    unsigned char* ws = p.ws;
    const bf16_t* Qb = (const bf16_t*)(ws + Q_OFF); const bf16_t* Kb = (const bf16_t*)(ws + K_OFF); const bf16_t* VT = (const bf16_t*)(ws + VT_OFF);
    bf16_t* att = (bf16_t*)(ws + ATT_OFF);
    for (int un = bx; un < 3072; un += G) {
        int b, h, rp, rows;
        if (un < 2048) { b = un >> 9; h = (un >> 6) & 7; rp = un & 63; rows = 128; } else { const int v = un - 2048; b = 4 + (v >> 8); h = (v >> 5) & 7; rp = v & 31; rows = 64; }
        const int gb = batch_base(b), T = rows * 64, r0 = 2 * rp;
        const int rsA = min(max(r0 - 4, 0), rows - 8);
        __syncthreads();
#pragma unroll 3
        for (int it = 0; it < 9; ++it) { const int idx = tid + it * 512, w = idx >> 9, r = (idx >> 3) & 63, ch = idx & 7; const int rw = min(rsA + w, rows - 1);
            const u32x4 kv = *(const u32x4*)(Kb + (size_t)(gb + rw * 64 + r) * 512 + h * 64 + ch * 8);
            const u32x4 vv = *(const u32x4*)(VT + (size_t)512 * gb + (size_t)(h * 64 + r) * T + rw * 64 + ch * 8);
            *(LAS u32x4*)(lds + A_KS + w * 8192 + r * 128 + ((ch ^ (r & 7)) * 16)) = kv;
            *(LAS u32x4*)(lds + A_VS + w * 8192 + r * 128 + ((ch ^ ((r >> 1) & 7)) * 16)) = vv; }
        if (tid < 128) { const int r = tid >> 3, ch = tid & 7; *(LAS u32x4*)(lds + A_KM + r * 128 + ((ch ^ (r & 7)) * 16)) = *(const u32x4*)((const bf16_t*)(ws + KMETA_OFF) + r * 512 + h * 64 + ch * 8); }
        else if (tid < 256) { const int q = tid - 128; *(LAS u32x4*)(lds + A_VM + q * 16) = *(const u32x4*)((const bf16_t*)(ws + VMETAT_OFF) + h * 64 * 16 + q * 8); }
        for (int i = tid; i < 15 * 64; i += 512) { const int ro = i >> 6, x = (i & 63) - 16; ((LAS float*)(lds + A_BS))[i] = (x >= 0 && x <= 30) ? p.rel_bias[(h * 15 + ro) * 31 + x] : 0.f; }
        if (tid < 16) ((LAS float*)(lds + A_MB))[tid] = p.meta_bias[h * 16 + tid];
        __syncthreads();
        const int r = r0 + (wid >> 2), c0 = 16 * (wid & 3), kc0 = min(max(c0 - 8, 0), 32);
        const int rs = min(max(r - 4, 0), rows - 8), lw0 = rs - rsA;
        const int c = c0 + li, cs = min(max(c - 8, 0), 48);
        const size_t qrow = (size_t)(gb + r * 64 + c);
        bf16x8 qf[2];
        qf[0] = *(const bf16x8*)(Qb + qrow * 512 + h * 64 + 8 * g); qf[1] = *(const bf16x8*)(Qb + qrow * 512 + h * 64 + 32 + 8 * g);
        f32x4 sa[8][2]; f32x4 sm_;
        {
            const int kr0 = kc0 + li;
#pragma unroll
            for (int w = 0; w < 8; ++w)
#pragma unroll
                for (int j = 0; j < 2; ++j) { const int kr = kr0 + 16 * j; const LAS unsigned char* rowp = lds + A_KS + (lw0 + w) * 8192 + kr * 128;
                    const bf16x8 a0 = *(const LAS bf16x8*)(rowp + ((g ^ (kr & 7)) * 16)), a1 = *(const LAS bf16x8*)(rowp + (((g + 4) ^ (kr & 7)) * 16));
                    f32x4 z = (f32x4){0.f, 0.f, 0.f, 0.f};
                    z = __builtin_amdgcn_mfma_f32_16x16x32_bf16(a0, qf[0], z, 0, 0, 0); sa[w][j] = __builtin_amdgcn_mfma_f32_16x16x32_bf16(a1, qf[1], z, 0, 0, 0); }
            const LAS unsigned char* rowp = lds + A_KM + li * 128;
            const bf16x8 a0 = *(const LAS bf16x8*)(rowp + ((g ^ (li & 7)) * 16)), a1 = *(const LAS bf16x8*)(rowp + (((g + 4) ^ (li & 7)) * 16));
            f32x4 z = (f32x4){0.f, 0.f, 0.f, 0.f};
            z = __builtin_amdgcn_mfma_f32_16x16x32_bf16(a0, qf[0], z, 0, 0, 0); sm_ = __builtin_amdgcn_mfma_f32_16x16x32_bf16(a1, qf[1], z, 0, 0, 0);
        }
        const int dl = kc0 + 4 * g - cs;
        const LAS float* bsp = (const LAS float*)(lds + A_BS) + (rs - r + 7) * 64 + (kc0 + 4 * g - c + 31);
        float mx = -1e30f;
#pragma unroll
        for (int w = 0; w < 8; ++w)
#pragma unroll
            for (int j = 0; j < 2; ++j)
#pragma unroll
                for (int e = 0; e < 4; ++e) { const bool ok = (unsigned)(dl + 16 * j + e) < 16u; const float s = ok ? sa[w][j][e] + bsp[w * 64 + 16 * j + e] : -1e30f; sa[w][j][e] = s; mx = fmaxf(mx, s); }
#pragma unroll
        for (int e = 0; e < 4; ++e) { sm_[e] += ((const LAS float*)(lds + A_MB))[4 * g + e]; mx = fmaxf(mx, sm_[e]); }
        mx = fmaxf(mx, __shfl_xor(mx, 16)); mx = fmaxf(mx, __shfl_xor(mx, 32));
        const float mxl = mx * 1.44269504f; float sum = 0.f;
#pragma unroll
        for (int w = 0; w < 8; ++w)
#pragma unroll
            for (int j = 0; j < 2; ++j)
#pragma unroll
                for (int e = 0; e < 4; ++e) { const float pe = __builtin_amdgcn_exp2f(sa[w][j][e] * 1.44269504f - mxl); sa[w][j][e] = pe; sum += pe; }
#pragma unroll
        for (int e = 0; e < 4; ++e) { const float pe = __builtin_amdgcn_exp2f(sm_[e] * 1.44269504f - mxl); sm_[e] = pe; sum += pe; }
        sum += __shfl_xor(sum, 16); sum += __shfl_xor(sum, 32);
        const float rsum = 1.0f / sum;
        f32x4 o[4];
#pragma unroll
        for (int dt = 0; dt < 4; ++dt) o[dt] = (f32x4){0.f, 0.f, 0.f, 0.f};
        const int c8 = (kc0 >> 2) + g;
#pragma unroll
        for (int w = 0; w < 8; ++w) { u32x4 pw; pw.x = cvt_pk_bf16(sa[w][0][0], sa[w][0][1]); pw.y = cvt_pk_bf16(sa[w][0][2], sa[w][0][3]); pw.z = cvt_pk_bf16(sa[w][1][0], sa[w][1][1]); pw.w = cvt_pk_bf16(sa[w][1][2], sa[w][1][3]);
            const bf16x8 pb = __builtin_bit_cast(bf16x8, pw);
#pragma unroll
            for (int dt = 0; dt < 4; ++dt) { const int d = 16 * dt + li, sw = 2 * ((d >> 1) & 7); const LAS unsigned char* rowp = lds + A_VS + (lw0 + w) * 8192 + d * 128;
                const u32x2 lo = *(const LAS u32x2*)(rowp + ((c8 ^ sw) * 8)), hi = *(const LAS u32x2*)(rowp + (((c8 + 4) ^ sw) * 8));
                u32x4 av; av.x = lo.x; av.y = lo.y; av.z = hi.x; av.w = hi.y;
                o[dt] = __builtin_amdgcn_mfma_f32_16x16x32_bf16(__builtin_bit_cast(bf16x8, av), pb, o[dt], 0, 0, 0); } }
        { u32x4 pw; pw.x = cvt_pk_bf16(sm_[0], sm_[1]); pw.y = cvt_pk_bf16(sm_[2], sm_[3]); pw.z = 0u; pw.w = 0u; const bf16x8 pb = __builtin_bit_cast(bf16x8, pw);
#pragma unroll
            for (int dt = 0; dt < 4; ++dt) { const int d = 16 * dt + li; const u32x2 lo = *(const LAS u32x2*)(lds + A_VM + d * 32 + g * 8);
                u32x4 av; av.x = lo.x; av.y = lo.y; av.z = 0u; av.w = 0u;
                o[dt] = __builtin_amdgcn_mfma_f32_16x16x32_bf16(__builtin_bit_cast(bf16x8, av), pb, o[dt], 0, 0, 0); } }
#pragma unroll
        for (int dt = 0; dt < 4; ++dt) { u32x2 w; w.x = cvt_pk_bf16(o[dt][0] * rsum, o[dt][1] * rsum); w.y = cvt_pk_bf16(o[dt][2] * rsum, o[dt][3] * rsum);
            *(u32x2*)(att + qrow * 512 + h * 64 + 16 * dt + 4 * g) = w; }
    }
    {
        const int gt = bx * 512 + tid, NGT = G * 512;
        constexpr int IPP = 4 * 512 * (KPP / 8), IPS = 4 * 512 * (KPS / 8);
        for (int it = gt; it < IPP + IPS; it += NGT) {
            int b, ch, j, N, KP; size_t ub, eb;
            if (it < IPP) { b = it / (512 * (KPP / 8)); const int q = it % (512 * (KPP / 8)); ch = q / (KPP / 8); j = q % (KPP / 8); N = NP; KP = KPP; ub = ((size_t)b * 512 + ch) * NP; eb = ((size_t)b * 512 + ch) * KPP; }
            else { const int v = it - IPP; b = v / (512 * (KPS / 8)); const int q = v % (512 * (KPS / 8)); ch = q / (KPS / 8); j = q % (KPS / 8); N = NS; KP = KPS;
                ub = (size_t)4 * 512 * NP + ((size_t)b * 512 + ch) * NS; eb = (size_t)4 * 512 * KPP + ((size_t)b * 512 + ch) * KPS; }
            (void)KP;
            const bf16_t* ut = (const bf16_t*)(ws + UT_OFF) + ub; const int HN = N / 2, k0 = 8 * j;
            float ev[8], ov[8];
            if (k0 < HN) { const u32x4 f = *(const u32x4*)(ut + k0); const u32x4 rv = *(const u32x4*)(ut + N - k0 - 8);
                const float fw[8] = {bf_lo(f.x), bf_hi(f.x), bf_lo(f.y), bf_hi(f.y), bf_lo(f.z), bf_hi(f.z), bf_lo(f.w), bf_hi(f.w)};
                const float rr[8] = {bf_lo(rv.x), bf_hi(rv.x), bf_lo(rv.y), bf_hi(rv.y), bf_lo(rv.z), bf_hi(rv.z), bf_lo(rv.w), bf_hi(rv.w)};
                const float r0v = (k0 > 0) ? __uint_as_float((unsigned)ut[N - k0] << 16) : 0.f;
#pragma unroll
                for (int e = 0; e < 8; ++e) { const float rvv = (e == 0) ? r0v : rr[8 - e]; ev[e] = fw[e] + rvv; ov[e] = fw[e] - rvv; }
                if (k0 == 0) { ev[0] = fw[0]; ov[0] = 0.f; } }
            else {
#pragma unroll
                for (int e = 0; e < 8; ++e) { ev[e] = 0.f; ov[e] = 0.f; }
                if (k0 == HN) ev[0] = __uint_as_float((unsigned)ut[HN] << 16); }
            u32x4 we, wo; we.x = cvt_pk_bf16(ev[0], ev[1]); we.y = cvt_pk_bf16(ev[2], ev[3]); we.z = cvt_pk_bf16(ev[4], ev[5]); we.w = cvt_pk_bf16(ev[6], ev[7]);
            wo.x = cvt_pk_bf16(ov[0], ov[1]); wo.y = cvt_pk_bf16(ov[2], ov[3]); wo.z = cvt_pk_bf16(ov[4], ov[5]); wo.w = cvt_pk_bf16(ov[6], ov[7]);
            *(u32x4*)((bf16_t*)(ws + UE_OFF) + eb + k0) = we; *(u32x4*)((bf16_t*)(ws + UO_OFF) + eb + k0) = wo;
        }
    }
}

__global__ void __launch_bounds__(512, 2) mega_fwd(Params p) {
    extern __shared__ __attribute__((aligned(16))) unsigned char lds_raw[];
    LAS unsigned char* lds = (LAS unsigned char*)lds_raw;
    const int lo = p.ph_lo, hi = p.ph_hi, G = gridDim.x, bx = blockIdx.x;
    unsigned char* ws = p.ws;
#define IN(k) (lo <= (k) && (k) < hi)
#define SEAM(k) do { if (IN(k) && IN((k) + 1)) { cg::this_grid().sync(); } } while (0)
    if (IN(0)) { p0_prologue(p, lds); __syncthreads(); }
    SEAM(0);
    if (IN(1)) {
        { SchedRect<1> S{}; S.A0 = (const char*)(ws + XB_OFF); S.B0 = (const char*)(ws + WINA_OFF); S.pa0 = 2048; S.nt0 = 16; S.nM = MT / 256; S.nN = 12; S.G = G; S.c = bx;
          EpiP1a E{ws, p.out}; pg8::gemm_phase<false>(lds, S, E); }
        { SchedRect<1> S{}; S.A0 = (const char*)(ws + XB_OFF); S.B0 = (const char*)(ws + WINB_OFF); S.pa0 = 2048; S.nt0 = 16; S.nM = MT / 256; S.nN = 4; S.G = G; S.c = bx;
          EpiP1b E{ws}; pg8::gemm_phase<true>(lds, S, E); }
    }
    SEAM(1);
    if (IN(2)) { attn_phase(p, lds); __syncthreads(); }
    SEAM(2);
    if (IN(3)) { SchedDft S{(const char*)ws, G, bx}; EpiDft E{ws}; pg8::gemm_phase<false>(lds, S, E); }
    SEAM(3);
    if (IN(4)) {
        SchedRect<2> S{}; S.A0 = (const char*)(ws + ATT_OFF); S.B0 = (const char*)(ws + WNA_OFF); S.pa0 = 1024; S.nt0 = 8;
        S.A1 = (const char*)(ws + PQ_OFF); S.B1 = (const char*)(ws + WFN_OFF); S.pa1 = 2048; S.nt1 = 16; S.nM = MT / 256; S.nN = 4; S.G = G; S.c = bx;
        EpiMerge E{ws, p.out}; pg8::gemm_phase<false>(lds, S, E);
    }
    SEAM(4);
    if (IN(5)) {
        SchedRect<1> S{}; S.A0 = (const char*)(ws + MIX_OFF); S.B0 = (const char*)(ws + WOUT_OFF); S.pa0 = 2048; S.nt0 = 16; S.nM = MT / 256; S.nN = 4; S.G = G; S.c = bx;
        EpiRes<true> E{p.xp, p.xs, p.out, (bf16_t*)(ws + X1B_OFF), (float*)(ws + SS1_OFF)}; pg8::gemm_phase<false>(lds, S, E);
    }
    SEAM(5);
    if (IN(6)) {
        SchedRect<1> S{}; S.A0 = (const char*)(ws + X1B_OFF); S.B0 = (const char*)(ws + WUP_OFF); S.pa0 = 2048; S.nt0 = 16; S.nM = MT / 256; S.nN = 16; S.G = G; S.c = bx;
        EpiUp E{(bf16_t*)(ws + H_OFF), (const float*)(ws + SS1_OFF)}; pg8::gemm_phase<false>(lds, S, E);
    }
    SEAM(6);
    if (IN(7)) {
        SchedRect<1> S{}; S.A0 = (const char*)(ws + H_OFF); S.B0 = (const char*)(ws + WDN_OFF); S.pa0 = 8192; S.nt0 = 64; S.nM = MT / 256; S.nN = 4; S.G = G; S.c = bx;
        EpiRes<false> E{p.out, p.out + (size_t)4 * TP * 1024, p.out, nullptr, (float*)(ws + SS2_OFF)}; pg8::gemm_phase<false>(lds, S, E);
    }
    SEAM(7);
    if (IN(8)) {
        const int tid = threadIdx.x, lane = tid & 63, wid = tid >> 6; const float* ss2 = (const float*)(ws + SS2_OFF);
        f32x4 gf[4];
#pragma unroll
        for (int j = 0; j < 4; ++j) gf[j] = ((const f32x4*)p.g_final)[lane + 64 * j];
        for (int g = bx * 8 + wid; g < MT; g += G * 8) { f32x4* o = (f32x4*)(p.out + (size_t)g * 1024); const float rinv = rsqrtf(ss2[g] * (1.0f / 1024.0f) + RMS_EPS);
#pragma unroll
            for (int j = 0; j < 4; ++j) { f32x4 v = o[lane + 64 * j]; v = v * rinv * gf[j]; o[lane + 64 * j] = v; } }
    }
#undef IN
#undef SEAM
}

extern "C" void kernel_launch(void* const* d_in, const int* in_sizes, int n_in, void* d_out, int out_size, void* d_ws, size_t ws_size, hipStream_t stream) {
    static int grid = 0;
    if (grid == 0) {
        if (n_in != 14 || out_size != MT * D || ws_size < WS_NEED) { fprintf(stderr, "kernel_launch: unexpected shapes (n_in %d, out %d, ws %zu)\n", n_in, out_size, ws_size); grid = -1; return; }
        int dev = 0, cus = 0, per_cu = 0;
        hipGetDevice(&dev); hipDeviceGetAttribute(&cus, hipDeviceAttributeMultiprocessorCount, dev);
        if (hipFuncSetAttribute((const void*)mega_fwd, hipFuncAttributeMaxDynamicSharedMemorySize, LDS_BYTES) != hipSuccess) { fprintf(stderr, "kernel_launch: hipFuncSetAttribute failed\n"); grid = -1; return; }
        if (hipOccupancyMaxActiveBlocksPerMultiprocessor(&per_cu, (const void*)mega_fwd, 512, LDS_BYTES) != hipSuccess || per_cu < 1) per_cu = 1;
        (void)hipGetLastError();
        grid = cus * per_cu;
    }
    if (grid < 0) return;
    Params p{};
    p.xp = (const float*)d_in[0]; p.xs = (const float*)d_in[1]; p.meta = (const float*)d_in[2]; p.w_in = (const float*)d_in[3]; p.rel_bias = (const float*)d_in[4]; p.meta_bias = (const float*)d_in[5];
    p.w_na = (const float*)d_in[6]; p.w_fn = (const float*)d_in[7]; p.w_out = (const float*)d_in[8]; p.g_mix = (const float*)d_in[9]; p.g_mlp = (const float*)d_in[10]; p.w_up = (const float*)d_in[11];
    p.w_down = (const float*)d_in[12]; p.g_final = (const float*)d_in[13]; p.out = (float*)d_out; p.ws = (unsigned char*)d_ws;
#if MK_PER_PHASE
    for (int ph = 0; ph < 9; ++ph) { p.ph_lo = ph; p.ph_hi = ph + 1; hipLaunchKernelGGL(mega_fwd, dim3(grid), dim3(512), LDS_BYTES, stream, p); }
#else
    p.ph_lo = 0; p.ph_hi = 9;
    void* args[] = {&p};
    hipError_t e = hipLaunchCooperativeKernel((const void*)mega_fwd, dim3(grid), dim3(512), args, LDS_BYTES, stream);
    if (e != hipSuccess) fprintf(stderr, "cooperative launch failed: %s (grid %d)\n", hipGetErrorString(e), grid);
#endif
}
```

```cpp
#include <hip/hip_runtime.h>
#include <hip/hip_cooperative_groups.h>
#include <cstdio>
#include <cstdint>
namespace cg = cooperative_groups;

#ifndef MK_PER_PHASE
#define MK_PER_PHASE 0
#endif

#ifndef TS_PHASE
#define TS_PHASE -1
#endif
#ifndef P0REP
#define P0REP -1
#endif
#ifndef EPI2
#define EPI2 -1
#endif
#ifndef REP_PHASE
#define REP_PHASE -1
#endif
#define LAS __attribute__((address_space(3)))
typedef unsigned short bf16_t;
typedef short bf16x8 __attribute__((ext_vector_type(8)));
typedef float f32x4 __attribute__((ext_vector_type(4)));
typedef float f32x2 __attribute__((ext_vector_type(2)));
typedef unsigned u32x4 __attribute__((ext_vector_type(4)));
typedef unsigned u32x2 __attribute__((ext_vector_type(2)));

constexpr int D = 1024, TP = 8192, TS = 4096, MT = 4 * TP + 4 * TS;
constexpr int NP = TP + 16, NS = TS + 16;
constexpr int KPP = 4224, KPS = 2176;
constexpr int MRP = 4352, MRS = 2304;
constexpr float RMS_EPS = 1e-6f;
constexpr size_t MiB = 1u << 20;
constexpr size_t SS1_OFF = 64 * 1024, SS2_OFF = 256 * 1024, KMETA_OFF = 512 * 1024, VMETAT_OFF = 528 * 1024;
constexpr size_t WINA_OFF = 1 * MiB, WINB_OFF = 7 * MiB, WUP_OFF = 9 * MiB, WDN_OFF = 17 * MiB, WOUT_OFF = 25 * MiB, WNA_OFF = 27 * MiB, WFN_OFF = 28 * MiB;
constexpr size_t XB_OFF = 30 * MiB;
constexpr size_t CP_OFF = 126 * MiB, SP_OFF = CP_OFF + (size_t)MRP * KPP * 2, CS_OFF = SP_OFF + (size_t)MRP * KPP * 2, SSM_OFF = CS_OFF + (size_t)MRS * KPS * 2;
constexpr size_t Q_OFF = 234 * MiB, K_OFF = 282 * MiB, VT_OFF = 330 * MiB, UT_OFF = 378 * MiB;
constexpr size_t ATT_OFF = 30 * MiB, UE_OFF = 427 * MiB, UO_OFF = 452 * MiB;
constexpr size_t PB_OFF = 78 * MiB, QB_OFF = 378 * MiB, MIX_OFF = 126 * MiB, X1B_OFF = 414 * MiB, H_OFF = 30 * MiB;
constexpr size_t WS_NEED = 510 * MiB;
static_assert(SSM_OFF + (size_t)MRS * KPS * 2 <= 234 * MiB, "dft matrices");
static_assert(UT_OFF + (size_t)512 * 2 * (4 * NP + 4 * NS) <= UE_OFF, "ut");
constexpr int LDS_BYTES = 160 * 1024;

__device__ __forceinline__ unsigned cvt_pk_bf16(float lo, float hi) { unsigned r; asm volatile("v_cvt_pk_bf16_f32 %0, %1, %2" : "=v"(r) : "v"(lo), "v"(hi)); return r; }
__device__ __forceinline__ float bf_lo(unsigned w) { return __uint_as_float(w << 16); }
__device__ __forceinline__ float bf_hi(unsigned w) { return __uint_as_float(w & 0xffff0000u); }
__device__ __forceinline__ float wave_sum(float v) {
#pragma unroll
    for (int o = 1; o < 64; o <<= 1) v += __shfl_xor(v, o);
    return v;
}
__device__ __forceinline__ int batch_base(int b) { return b < 4 ? b * TP : 4 * TP + (b - 4) * TS; }

struct Params {
    const float* xp; const float* xs; const float* meta; const float* w_in; const float* rel_bias; const float* meta_bias;
    const float* w_na; const float* w_fn; const float* w_out; const float* g_mix; const float* g_mlp; const float* w_up; const float* w_down; const float* g_final;
    float* out; unsigned char* ws; int ph_lo, ph_hi;
};

namespace pg8 {
constexpr int BM = 256, BK = 64, HALF = 128, HTB = HALF * BK * 2, STAGE_BYTES = 8 * HTB;
__device__ __forceinline__ int lds_byte(int r, int c) { const int st = (r >> 4) * 2 + (c >> 5), rr = r & 15, cc = c & 31, ob = rr * 64 + cc * 2; return st * 1024 + (ob ^ (((ob >> 9) & 1) << 5)); }
__device__ __forceinline__ void stage_rc(int b, int& R, int& C) { const int st = b / 1024, sb = b % 1024, swz = sb ^ (((sb >> 9) & 1) << 5); R = (st >> 1) * 16 + swz / 64; C = (st & 1) * 32 + (swz % 64) / 2; }
__device__ __forceinline__ int perm32(int rho) { const int n = rho >> 4, i = rho & 15; return 8 * (i >> 2) + 4 * n + (i & 3); }

struct Unit { const char* A; const char* B; int pa, pb, nt, pm, pn, aux; };

__device__ __forceinline__ bool rect_tile(long L, int nM, int nN, int& pm, int& pn) {
    const int nwg = nM * nN; if (L >= nwg) return false;
    int wgid = (int)L; { const int q = nwg / 8, r = nwg % 8, xcd = wgid % 8, off = wgid / 8; wgid = (xcd < r ? xcd * (q + 1) : r * (q + 1) + (xcd - r) * q) + off; }
    const int nig = 8 * nN, gid = wgid / nig, fm = gid * 8, gsz = (nM - fm) < 8 ? (nM - fm) : 8;
    pm = fm + ((wgid % nig) % gsz); pn = (wgid % nig) / gsz; return true;
}

template <bool TRANS, class Epi, class Sched>
__device__ __forceinline__ void gemm_phase(LAS unsigned char* lds, const Sched& S, const Epi& E) {
    const int tid = threadIdx.x, wid = __builtin_amdgcn_readfirstlane(tid >> 6), lane = tid & 63, wr = wid >> 2, wc = wid & 3, fr = lane & 15, fq = lane >> 4;
    int RA[2], RB[2], CB[2];
#pragma unroll
    for (int i = 0; i < 2; ++i) { int R, C; stage_rc(tid * 16 + i * 8192, R, C); RA[i] = R; RB[i] = Epi::PERM ? ((R & ~31) + perm32(R & 31)) : R; CB[i] = C * 2; }
    const unsigned ldsw = (unsigned)wid * 1024u;
    const int aoff = lds_byte(wr * 64 + fr, fq * 8), boff = lds_byte(wc * 32 + fr, fq * 8);
#define PG8_SA(b, h) (((b) * 2 + (h)) * HTB)
#define PG8_SB(b, h) ((4 + (b) * 2 + (h)) * HTB)
#define PG8_STAGE(bufoff, gbase, pitch, RR) do { _Pragma("unroll") for (int _i = 0; _i < 2; ++_i) \
        __builtin_amdgcn_global_load_lds((const unsigned*)((const char*)(gbase) + (unsigned)((RR)[_i] * (pitch) + CB[_i])), (LAS unsigned*)(lds + (bufoff) + ldsw + _i * 8192), 16, 0, 0); } while (0)
#define PG8_LDA(dst, b, h) do { _Pragma("unroll") for (int m = 0; m < 4; ++m) _Pragma("unroll") for (int k = 0; k < 2; ++k) dst[m][k] = *(const LAS bf16x8*)(lds + PG8_SA(b, h) + aoff + m * 2048 + k * 1024); } while (0)
#define PG8_LDB(dst, b, h) do { _Pragma("unroll") for (int n = 0; n < 2; ++n) _Pragma("unroll") for (int k = 0; k < 2; ++k) dst[n][k] = *(const LAS bf16x8*)(lds + PG8_SB(b, h) + boff + n * 2048 + k * 1024); } while (0)
#define PG8_MMA(ai, bj, At, Bt) do { __builtin_amdgcn_s_setprio(1); _Pragma("unroll") for (int m = 0; m < 4; ++m) _Pragma("unroll") for (int n = 0; n < 2; ++n) _Pragma("unroll") for (int k = 0; k < 2; ++k) \
        acc[ai][bj][m][n] = TRANS ? __builtin_amdgcn_mfma_f32_16x16x32_bf16(At[m][k], Bt[n][k], acc[ai][bj][m][n], 0, 0, 0) \
                                  : __builtin_amdgcn_mfma_f32_16x16x32_bf16(Bt[n][k], At[m][k], acc[ai][bj][m][n], 0, 0, 0); __builtin_amdgcn_s_setprio(0); } while (0)
#define PG8_WAIT_V(n) asm volatile("s_waitcnt vmcnt(" #n ")" ::: "memory")
#define PG8_WAIT_L(n) asm volatile("s_waitcnt lgkmcnt(" #n ")" ::: "memory")
#define PG8_BAR __builtin_amdgcn_s_barrier()
#define PG8_SCHED __builtin_amdgcn_sched_barrier(0)
    Unit cur, nxt; int ui = 0;
    if (!S.next(0, cur)) return;
    f32x4 acc[2][2][4][2];
#pragma unroll
    for (int a = 0; a < 2; ++a)
#pragma unroll
        for (int b = 0; b < 2; ++b)
#pragma unroll
            for (int m = 0; m < 4; ++m)
#pragma unroll
                for (int n = 0; n < 2; ++n) acc[a][b][m][n] = (f32x4){0.f, 0.f, 0.f, 0.f};
    bf16x8 At[4][2], B0[2][2], B1[2][2];
    const char* cA = cur.A; const char* cB = cur.B; int cpa = cur.pa, cpb = cur.pb;
    {
        const size_t hA = (size_t)HALF * cpa, hB = (size_t)HALF * cpb;
        PG8_STAGE(PG8_SB(0, 0), cB, cpb, RB); PG8_STAGE(PG8_SB(0, 1), cB + hB, cpb, RB); PG8_STAGE(PG8_SA(0, 0), cA, cpa, RA); PG8_STAGE(PG8_SA(0, 1), cA + hA, cpa, RA);
        if (wr == 1) PG8_BAR;
        PG8_WAIT_V(2); PG8_BAR;
        PG8_STAGE(PG8_SB(1, 0), cB + 128, cpb, RB); PG8_STAGE(PG8_SA(1, 0), cA + 128, cpa, RA); PG8_STAGE(PG8_SB(1, 1), cB + hB + 128, cpb, RB);
        PG8_WAIT_V(6); PG8_BAR;
    }
    for (;;) {
        const bool has_next = S.next(ui + 1, nxt);
        const char* nA = has_next ? nxt.A : cA; const char* nB = has_next ? nxt.B : cB; const int npa = has_next ? nxt.pa : cpa, npb = has_next ? nxt.pb : cpb;
        const int nt = cur.nt; const size_t hA = (size_t)HALF * cpa;
        for (int t = 0; t < nt; t += 2) {
            const bool last = (t == nt - 2);
            const char* a1 = cA + (size_t)(t + 1) * 128;
            const char* a2 = last ? nA : cA + (size_t)(t + 2) * 128; const char* b2 = last ? nB : cB + (size_t)(t + 2) * 128;
            const int pa2 = last ? npa : cpa, pb2 = last ? npb : cpb; const size_t hA2 = (size_t)HALF * pa2, hB2 = (size_t)HALF * pb2;
            const char* a3 = a2 + 128; const char* b3 = b2 + 128;
            PG8_LDB(B0, 0, 0); PG8_LDB(B1, 0, 1); PG8_SCHED; PG8_LDA(At, 0, 0); PG8_STAGE(PG8_SA(1, 1), a1 + hA, cpa, RA);
            PG8_WAIT_V(8); PG8_WAIT_L(0); PG8_BAR; PG8_MMA(0, 0, At, B0); PG8_MMA(0, 1, At, B1); PG8_BAR; PG8_SCHED;
            PG8_LDA(At, 0, 1); PG8_STAGE(PG8_SB(0, 0), b2, pb2, RB); PG8_STAGE(PG8_SB(0, 1), b2 + hB2, pb2, RB); PG8_STAGE(PG8_SA(0, 0), a2, pa2, RA);
            PG8_WAIT_V(8); PG8_WAIT_L(0); PG8_BAR; PG8_MMA(1, 0, At, B0); PG8_MMA(1, 1, At, B1); PG8_BAR; PG8_SCHED;
            PG8_LDB(B0, 1, 0); PG8_LDB(B1, 1, 1); PG8_SCHED; PG8_LDA(At, 1, 0); PG8_STAGE(PG8_SA(0, 1), a2 + hA2, pa2, RA);
            PG8_WAIT_V(8); PG8_WAIT_L(0); PG8_BAR; PG8_MMA(0, 0, At, B0); PG8_MMA(0, 1, At, B1); PG8_BAR; PG8_SCHED;
            PG8_LDA(At, 1, 1); PG8_STAGE(PG8_SB(1, 0), b3, pb2, RB); PG8_STAGE(PG8_SB(1, 1), b3 + hB2, pb2, RB); PG8_STAGE(PG8_SA(1, 0), a3, pa2, RA);
            PG8_WAIT_V(8); PG8_WAIT_L(0); PG8_BAR; PG8_MMA(1, 0, At, B0); PG8_MMA(1, 1, At, B1); PG8_BAR; PG8_SCHED;
        }
        if (wr == 0) PG8_BAR;
        if (Epi::TWICE) (void)E(acc, cur, wr, wc, fr, fq);
        const bool keep = E(acc, cur, wr, wc, fr, fq);
        if (!has_next) break;
        if (!keep) {
#pragma unroll
            for (int a = 0; a < 2; ++a)
#pragma unroll
                for (int b = 0; b < 2; ++b)
#pragma unroll
                    for (int m = 0; m < 4; ++m)
#pragma unroll
                        for (int n = 0; n < 2; ++n) acc[a][b][m][n] = (f32x4){0.f, 0.f, 0.f, 0.f};
        }
        cur = nxt; cA = nA; cB = nB; cpa = npa; cpb = npb; ++ui;
        if (wr == 1) PG8_BAR;
    }
    PG8_WAIT_V(0);
    PG8_BAR;
#undef PG8_SA
#undef PG8_SB
#undef PG8_STAGE
#undef PG8_LDA
#undef PG8_LDB
#undef PG8_MMA
#undef PG8_WAIT_V
#undef PG8_WAIT_L
#undef PG8_BAR
#undef PG8_SCHED
}
}
using pg8::Unit;

template <int NSUB> struct SchedRect {
    const char* A0; const char* B0; const char* A1; const char* B1; int pa0, nt0, pa1, nt1; int nM, nN, G, c;
    __device__ __forceinline__ bool next(int i, Unit& u) const {
        const int ti = i / NSUB, s = i % NSUB; int pm, pn;
        if (!pg8::rect_tile((long)ti * G + c, nM, nN, pm, pn)) return false;
        const int pa = (NSUB > 1 && s) ? pa1 : pa0;
        u.pa = pa; u.pb = pa; u.nt = (NSUB > 1 && s) ? nt1 : nt0; u.pm = pm; u.pn = pn; u.aux = s;
        u.A = ((NSUB > 1 && s) ? A1 : A0) + (size_t)pm * 256 * pa; u.B = ((NSUB > 1 && s) ? B1 : B0) + (size_t)pn * 256 * pa; return true;
    }
};

struct SchedMerge {
    const char* ws; int G, c;
    __device__ __forceinline__ bool next(int i, Unit& u) const {
        const int ti = i / 3, s = i % 3; int pm, pn;
        if (!pg8::rect_tile((long)ti * G + c, MT / 256, 4, pm, pn)) return false;
        u.pa = 1024; u.nt = 8; u.pm = pm; u.pn = pn; u.aux = s;
        if (s == 0) { u.A = ws + ATT_OFF + (size_t)pm * 256 * 1024; u.B = ws + WNA_OFF + (size_t)pn * 256 * 1024; u.pb = 1024; }
        else { u.A = ws + (s == 1 ? PB_OFF : QB_OFF) + (size_t)pm * 256 * 1024; u.B = ws + WFN_OFF + (size_t)pn * 256 * 2048 + (s == 2 ? 1024 : 0); u.pb = 2048; }
        return true;
    }
};
struct SchedDft {
    const char* ws; int G, c;
    __device__ __forceinline__ bool next(int i, Unit& u) const {
        const long L = (long)i * G + c; if (L >= 416) return false;
        int pm, b, pn;
        if (L < 272) {
            if (L < 256) { const int x = (int)L & 7, s = (int)L >> 3; pm = 8 * (x >> 2) + (s & 7); b = s >> 3; pn = x & 3; }
            else { const int e = (int)L - 256; pm = 16; b = e >> 2; pn = e & 3; }
            u.pa = KPP * 2; u.pb = KPP * 2; u.nt = KPP / 64;
            u.A = ws + (pn < 2 ? CP_OFF : SP_OFF) + (size_t)pm * 256 * KPP * 2;
            u.B = ws + (pn < 2 ? UE_OFF : UO_OFF) + ((size_t)b * 512 + (pn & 1) * 256) * KPP * 2;
        } else {
            const int l = (int)L - 272, x = l & 7, s = l >> 3; pn = x & 3; pm = s % 9; b = 4 + 2 * (s / 9) + (x >> 2);
            u.pa = KPS * 2; u.pb = KPS * 2; u.nt = KPS / 64;
            u.A = ws + (pn < 2 ? CS_OFF : SSM_OFF) + (size_t)pm * 256 * KPS * 2;
            u.B = ws + (pn < 2 ? UE_OFF : UO_OFF) + (size_t)4 * 512 * KPP * 2 + ((size_t)(b - 4) * 512 + (pn & 1) * 256) * KPS * 2;
        }
        u.pm = pm; u.pn = pn; u.aux = b; return true;
    }
};

__device__ __forceinline__ float sigmoidf_(float v) { return __builtin_amdgcn_rcpf(1.0f + __builtin_amdgcn_exp2f(-1.44269504f * v)); }
typedef f32x4 Acc[2][2][4][2];

struct EpiP1a {
    static constexpr bool PERM = true, TWICE = (EPI2 == 1);
    unsigned char* ws; float* gates;
    __device__ __forceinline__ bool operator()(Acc& acc, const Unit& u, int wr, int wc, int fr, int fq) const {
        asm volatile("" : "+v"(fr), "+v"(fq));
        const int row0 = u.pm * 256 + wr * 64 + fr;
        if (u.pn < 4) {
            bf16_t* base = (bf16_t*)(ws + (u.pn < 2 ? Q_OFF : K_OFF)); const int col0 = (u.pn & 1) * 256 + wc * 32 + 8 * fq;
#pragma unroll
            for (int ai = 0; ai < 2; ++ai)
#pragma unroll
                for (int m = 0; m < 4; ++m) { bf16_t* rowp = base + (size_t)(row0 + ai * 128 + m * 16) * 512 + col0;
#pragma unroll
                    for (int bj = 0; bj < 2; ++bj) { const f32x4 v0 = acc[ai][bj][m][0], v1 = acc[ai][bj][m][1];
                        u32x4 w; w.x = cvt_pk_bf16(v0[0], v0[1]); w.y = cvt_pk_bf16(v0[2], v0[3]); w.z = cvt_pk_bf16(v1[0], v1[1]); w.w = cvt_pk_bf16(v1[2], v1[3]);
                        *(u32x4*)(rowp + bj * 128) = w; } }
        } else {
            bf16_t* Rb = (bf16_t*)gates; bf16_t* Sb = Rb + (size_t)MT * 1024; const int col0 = (u.pn - 4) * 128 + wc * 32 + 8 * fq;
#pragma unroll
            for (int ai = 0; ai < 2; ++ai)
#pragma unroll
                for (int m = 0; m < 4; ++m) { const size_t off = (size_t)(row0 + ai * 128 + m * 16) * 1024 + col0; float rr[8], s2[8];
#pragma unroll
                    for (int n = 0; n < 2; ++n)
#pragma unroll
                        for (int e = 0; e < 4; ++e) { const float e1 = __builtin_amdgcn_exp2f(fminf(-1.44269504f * acc[ai][0][m][n][e], 60.f)), e2 = __builtin_amdgcn_exp2f(fminf(-1.44269504f * acc[ai][1][m][n][e], 60.f));
                            s2[4 * n + e] = __builtin_amdgcn_rcpf(1.0f + e2); rr[4 * n + e] = (1.0f + e2) * __builtin_amdgcn_rcpf(1.0f + e1); }
                    u32x4 w; w.x = cvt_pk_bf16(rr[0], rr[1]); w.y = cvt_pk_bf16(rr[2], rr[3]); w.z = cvt_pk_bf16(rr[4], rr[5]); w.w = cvt_pk_bf16(rr[6], rr[7]);
                    *(u32x4*)(Rb + off) = w;
                    w.x = cvt_pk_bf16(s2[0], s2[1]); w.y = cvt_pk_bf16(s2[2], s2[3]); w.z = cvt_pk_bf16(s2[4], s2[5]); w.w = cvt_pk_bf16(s2[6], s2[7]);
                    *(u32x4*)(Sb + off) = w; }
        }
        return false;
    }
};
struct EpiP1b {
    static constexpr bool PERM = false, TWICE = (EPI2 == 1);
    unsigned char* ws;
    __device__ __forceinline__ bool operator()(Acc& acc, const Unit& u, int wr, int wc, int fr, int fq) const {
        asm volatile("" : "+v"(fr), "+v"(fq));
        const int g0 = u.pm * 256; const int b = g0 < 4 * TP ? g0 / TP : 4 + (g0 - 4 * TP) / TS; const int gb = batch_base(b), T = b < 4 ? TP : TS, N = T + 16;
        bf16_t* base; size_t pitch; int coff;
        if (u.pn < 2) { base = (bf16_t*)(ws + VT_OFF) + (size_t)512 * gb; pitch = T; coff = u.pn * 256; }
        else { base = (bf16_t*)(ws + UT_OFF) + (b < 4 ? (size_t)b * 512 * NP : (size_t)4 * 512 * NP + (size_t)(b - 4) * 512 * NS) + 16; pitch = N; coff = (u.pn - 2) * 256; }
        const int t0 = g0 - gb + wr * 64 + 4 * fq, c0 = coff + wc * 32 + fr;
#pragma unroll
        for (int ai = 0; ai < 2; ++ai)
#pragma unroll
            for (int bj = 0; bj < 2; ++bj)
#pragma unroll
                for (int m = 0; m < 4; ++m)
#pragma unroll
                    for (int n = 0; n < 2; ++n) { const f32x4 v = acc[ai][bj][m][n]; u32x2 w; w.x = cvt_pk_bf16(v[0], v[1]); w.y = cvt_pk_bf16(v[2], v[3]);
                        *(u32x2*)(base + (size_t)(c0 + bj * 128 + n * 16) * pitch + t0 + ai * 128 + m * 16) = w; }
        return false;
    }
};
struct EpiDft {
    static constexpr bool PERM = true, TWICE = (EPI2 == 3);
    unsigned char* ws;
    __device__ __forceinline__ bool operator()(Acc& acc, const Unit& u, int wr, int wc, int fr, int fq) const {
        asm volatile("" : "+v"(fr), "+v"(fq));
        const int b = u.aux, gb = batch_base(b), N = (b < 4 ? TP : TS) + 16, HN = N / 2;
        bf16_t* base = (bf16_t*)(ws + (u.pn < 2 ? PB_OFF : QB_OFF)) + (size_t)gb * 512 + (u.pn & 1) * 256 + wc * 32 + 8 * fq;
        const float sg = u.pn >= 2 ? -1.f : 1.f;
#pragma unroll
        for (int ai = 0; ai < 2; ++ai)
#pragma unroll
            for (int m = 0; m < 4; ++m) { const int np = u.pm * 256 + ai * 128 + wr * 64 + m * 16 + fr + 1;
                if (np <= HN) {
#pragma unroll
                    for (int bj = 0; bj < 2; ++bj) { const f32x4 v0 = acc[ai][bj][m][0], v1 = acc[ai][bj][m][1];
                        if (np >= 16) { u32x4 w; w.x = cvt_pk_bf16(v0[0], v0[1]); w.y = cvt_pk_bf16(v0[2], v0[3]); w.z = cvt_pk_bf16(v1[0], v1[1]); w.w = cvt_pk_bf16(v1[2], v1[3]);
                            *(u32x4*)(base + (size_t)(np - 16) * 512 + bj * 128) = w; }
                        if (np != HN) { u32x4 w; w.x = cvt_pk_bf16(sg * v0[0], sg * v0[1]); w.y = cvt_pk_bf16(sg * v0[2], sg * v0[3]); w.z = cvt_pk_bf16(sg * v1[0], sg * v1[1]); w.w = cvt_pk_bf16(sg * v1[2], sg * v1[3]);
                            *(u32x4*)(base + (size_t)(N - np - 16) * 512 + bj * 128) = w; } } } }
        return false;
    }
};
struct EpiMerge {
    static constexpr bool PERM = true, TWICE = false;
    unsigned char* ws; const float* gates;
    __device__ __forceinline__ bool operator()(Acc& acc, const Unit& u, int wr, int wc, int fr, int fq) const {
        if (u.aux == 1) return true;
        asm volatile("" : "+v"(fr), "+v"(fq));
        const bf16_t* Gs = (const bf16_t*)gates + (u.aux == 0 ? (size_t)0 : (size_t)MT * 1024);
        const int row0 = u.pm * 256 + wr * 64 + fr, col0 = u.pn * 256 + wc * 32 + 8 * fq;
        bf16_t* mix = (bf16_t*)(ws + MIX_OFF);
        u32x4 g2[4][2];
#pragma unroll
        for (int q = 0; q < 3; ++q)
#pragma unroll
            for (int bj = 0; bj < 2; ++bj) g2[q][bj] = *(const u32x4*)(Gs + (size_t)(row0 + q * 16) * 1024 + col0 + bj * 128);
#pragma unroll
        for (int idx = 0; idx < 8; ++idx) { const int ai = idx >> 2, m = idx & 3; const size_t off = (size_t)(row0 + ai * 128 + m * 16) * 1024 + col0;
            if (idx < 5) { const int ai2 = (idx + 3) >> 2, m2 = (idx + 3) & 3; const size_t off2 = (size_t)(row0 + ai2 * 128 + m2 * 16) * 1024 + col0;
#pragma unroll
                for (int bj = 0; bj < 2; ++bj) g2[(idx + 3) & 3][bj] = *(const u32x4*)(Gs + off2 + bj * 128); }
#pragma unroll
            for (int bj = 0; bj < 2; ++bj) { const u32x4 w2 = g2[idx & 3][bj];
                const float sc[8] = {bf_lo(w2.x), bf_hi(w2.x), bf_lo(w2.y), bf_hi(w2.y), bf_lo(w2.z), bf_hi(w2.z), bf_lo(w2.w), bf_hi(w2.w)};
#pragma unroll
                for (int e = 0; e < 4; ++e) { acc[ai][bj][m][0][e] *= sc[e]; acc[ai][bj][m][1][e] *= sc[4 + e]; }
                if (u.aux == 2) { const f32x4 v0 = acc[ai][bj][m][0], v1 = acc[ai][bj][m][1]; u32x4 w;
                    w.x = cvt_pk_bf16(v0[0], v0[1]); w.y = cvt_pk_bf16(v0[2], v0[3]); w.z = cvt_pk_bf16(v1[0], v1[1]); w.w = cvt_pk_bf16(v1[2], v1[3]);
                    *(u32x4*)(mix + off + bj * 128) = w; } } }
        return u.aux == 0;
    }
};
struct EpiRes5 {
    static constexpr bool PERM = true, TWICE = false;
    const float* bp; const float* bs; bf16_t* ob; float* ss;
    __device__ __forceinline__ bool operator()(Acc& acc, const Unit& u, int wr, int wc, int fr, int fq) const {
        asm volatile("" : "+v"(fr), "+v"(fq));
        const int g0 = u.pm * 256; const float* base = g0 < 4 * TP ? bp + (size_t)g0 * 1024 : bs + (size_t)(g0 - 4 * TP) * 1024;
        const int lr0 = wr * 64 + fr, col0 = u.pn * 256 + wc * 32 + 8 * fq;
        f32x4 pre[3][2][2];
#pragma unroll
        for (int q = 0; q < 2; ++q)
#pragma unroll
            for (int bj = 0; bj < 2; ++bj)
#pragma unroll
                for (int n = 0; n < 2; ++n) pre[q][bj][n] = *(const f32x4*)(base + (size_t)(lr0 + q * 16) * 1024 + col0 + bj * 128 + n * 4);
#pragma unroll
        for (int idx = 0; idx < 8; ++idx) { const int ai = idx >> 2, m = idx & 3; const int lr = lr0 + ai * 128 + m * 16; float s = 0.f;
            if (idx < 6) { const int lr2 = lr0 + ((idx + 2) >> 2) * 128 + ((idx + 2) & 3) * 16;
#pragma unroll
                for (int bj = 0; bj < 2; ++bj)
#pragma unroll
                    for (int n = 0; n < 2; ++n) pre[(idx + 2) % 3][bj][n] = *(const f32x4*)(base + (size_t)lr2 * 1024 + col0 + bj * 128 + n * 4); }
#pragma unroll
            for (int bj = 0; bj < 2; ++bj) { const f32x4 o0 = pre[idx % 3][bj][0] + acc[ai][bj][m][0], o1 = pre[idx % 3][bj][1] + acc[ai][bj][m][1];
                s += ((o0[0] * o0[0] + o0[1] * o0[1]) + (o0[2] * o0[2] + o0[3] * o0[3])) + ((o1[0] * o1[0] + o1[1] * o1[1]) + (o1[2] * o1[2] + o1[3] * o1[3]));
                u32x4 w; w.x = cvt_pk_bf16(o0[0], o0[1]); w.y = cvt_pk_bf16(o0[2], o0[3]); w.z = cvt_pk_bf16(o1[0], o1[1]); w.w = cvt_pk_bf16(o1[2], o1[3]);
                *(u32x4*)(ob + (size_t)(g0 + lr) * 1024 + col0 + bj * 128) = w; }
            s += __shfl_xor(s, 16); s += __shfl_xor(s, 32);
            if (fq == 0) atomicAdd(ss + g0 + lr, s); }
        return false;
    }
};
struct EpiRes7 {
    static constexpr bool PERM = true, TWICE = false;
    bf16_t* xb; float* ss;
    __device__ __forceinline__ bool operator()(Acc& acc, const Unit& u, int wr, int wc, int fr, int fq) const {
        asm volatile("" : "+v"(fr), "+v"(fq));
        const int row0 = u.pm * 256 + wr * 64 + fr, col0 = u.pn * 256 + wc * 32 + 8 * fq;
        u32x4 pre[4][2];
#pragma unroll
        for (int q = 0; q < 3; ++q)
#pragma unroll
            for (int bj = 0; bj < 2; ++bj) pre[q][bj] = *(const u32x4*)(xb + (size_t)(row0 + q * 16) * 1024 + col0 + bj * 128);
#pragma unroll
        for (int idx = 0; idx < 8; ++idx) { const int ai = idx >> 2, m = idx & 3; const int row = row0 + ai * 128 + m * 16; float s = 0.f;
            if (idx < 5) { const int row2 = row0 + ((idx + 3) >> 2) * 128 + ((idx + 3) & 3) * 16;
#pragma unroll
                for (int bj = 0; bj < 2; ++bj) pre[(idx + 3) & 3][bj] = *(const u32x4*)(xb + (size_t)row2 * 1024 + col0 + bj * 128); }
#pragma unroll
            for (int bj = 0; bj < 2; ++bj) { const u32x4 b = pre[idx & 3][bj]; const f32x4 a0 = acc[ai][bj][m][0], a1 = acc[ai][bj][m][1];
                const float o[8] = {bf_lo(b.x) + a0[0], bf_hi(b.x) + a0[1], bf_lo(b.y) + a0[2], bf_hi(b.y) + a0[3], bf_lo(b.z) + a1[0], bf_hi(b.z) + a1[1], bf_lo(b.w) + a1[2], bf_hi(b.w) + a1[3]};
#pragma unroll
                for (int e = 0; e < 8; ++e) s += o[e] * o[e];
                u32x4 w; w.x = cvt_pk_bf16(o[0], o[1]); w.y = cvt_pk_bf16(o[2], o[3]); w.z = cvt_pk_bf16(o[4], o[5]); w.w = cvt_pk_bf16(o[6], o[7]);
                *(u32x4*)(xb + (size_t)row * 1024 + col0 + bj * 128) = w; }
            s += __shfl_xor(s, 16); s += __shfl_xor(s, 32);
            if (fq == 0) atomicAdd(ss + row, s); }
        return false;
    }
};
struct EpiUp {
    static constexpr bool PERM = true, TWICE = (EPI2 == 6);
    bf16_t* H; const float* ss;
    __device__ __forceinline__ bool operator()(Acc& acc, const Unit& u, int wr, int wc, int fr, int fq) const {
        asm volatile("" : "+v"(fr), "+v"(fq));
        const int row0 = u.pm * 256 + wr * 64 + fr, col0 = u.pn * 256 + wc * 32 + 8 * fq;
        float rv[8];
#pragma unroll
        for (int idx = 0; idx < 8; ++idx) rv[idx] = ss[row0 + (idx >> 2) * 128 + (idx & 3) * 16];
#pragma unroll
        for (int ai = 0; ai < 2; ++ai)
#pragma unroll
            for (int m = 0; m < 4; ++m) { const int row = row0 + ai * 128 + m * 16; const float rinv = rsqrtf(rv[ai * 4 + m] * (1.0f / 1024.0f) + RMS_EPS);
#pragma unroll
                for (int bj = 0; bj < 2; ++bj) { f32x4 v0 = acc[ai][bj][m][0], v1 = acc[ai][bj][m][1];
#pragma unroll
                    for (int e = 0; e < 4; ++e) { const float a = fmaxf(v0[e] * rinv, 0.f), b = fmaxf(v1[e] * rinv, 0.f); v0[e] = a * a; v1[e] = b * b; }
                    u32x4 w; w.x = cvt_pk_bf16(v0[0], v0[1]); w.y = cvt_pk_bf16(v0[2], v0[3]); w.z = cvt_pk_bf16(v1[0], v1[1]); w.w = cvt_pk_bf16(v1[2], v1[3]);
                    *(u32x4*)(H + (size_t)row * 4096 + col0 + bj * 128) = w; } }
        return false;
    }
};

__device__ __forceinline__ void p0_transpose_item(const float* W, int K, int N, bf16_t* WT, int out_row0, int n0, int k0, const float* sc, float mul, LAS float* scr, int lane) {
    float tv[32];
#pragma unroll
    for (int i = 0; i < 32; ++i) { const int kk = 2 * i + (lane >> 5); tv[i] = W[(size_t)(k0 + kk) * N + n0 + (lane & 31)]; }
#pragma unroll
    for (int i = 0; i < 32; ++i) { const int kk = 2 * i + (lane >> 5); const float s = sc ? sc[k0 + kk] * mul : mul; scr[kk * 33 + (lane & 31)] = tv[i] * s; }
    asm volatile("s_waitcnt lgkmcnt(0)" ::: "memory");
    const int c = lane & 7;
#pragma unroll
    for (int j = 0; j < 4; ++j) { const int n = (lane >> 3) + 8 * j; const LAS float* s = scr + (8 * c) * 33 + n;
        u32x4 o; o.x = cvt_pk_bf16(s[0 * 33], s[1 * 33]); o.y = cvt_pk_bf16(s[2 * 33], s[3 * 33]); o.z = cvt_pk_bf16(s[4 * 33], s[5 * 33]); o.w = cvt_pk_bf16(s[6 * 33], s[7 * 33]);
        *(u32x4*)(WT + (size_t)(out_row0 + n) * K + k0 + 8 * c) = o; }
    asm volatile("s_waitcnt lgkmcnt(0)" ::: "memory");
}

template <int PART> __device__ __forceinline__ void p0_prologue(const Params& p, LAS unsigned char* lds, int bx, int G) {
    const int tid = threadIdx.x, lane = tid & 63, wid = tid >> 6;
    const int gw = bx * 8 + wid, NGW = G * 8, gt = bx * 512 + tid, NGT = G * 512;
    unsigned char* ws = p.ws;
    if (PART == 0) for (int i = gt; i < MT; i += NGT) { ((float*)(ws + SS1_OFF))[i] = 0.f; ((float*)(ws + SS2_OFF))[i] = 0.f; }
    for (int r0_ = 0; r0_ < (P0REP == 0 ? 2 : 1); ++r0_)
    if (PART == 0 && bx < 24) {
        LAS float* hm = (LAS float*)lds;
        LAS float* red = (LAS float*)(lds + 65536);
        for (int r = wid * 2; r < wid * 2 + 2; ++r) { float v[16]; float s = 0.f;
#pragma unroll
            for (int j = 0; j < 16; ++j) { v[j] = p.meta[r * 1024 + lane + 64 * j]; s += v[j] * v[j]; }
            const float rinv = rsqrtf(wave_sum(s) * (1.0f / 1024.0f) + RMS_EPS);
#pragma unroll
            for (int j = 0; j < 16; ++j) hm[r * 1024 + lane + 64 * j] = v[j] * rinv * p.g_mix[lane + 64 * j]; }
        __syncthreads();
        const int n = 512 + bx * 64 + lane; float a[16];
#pragma unroll
        for (int r = 0; r < 16; ++r) a[r] = 0.f;
        for (int k0 = wid * 128; k0 < wid * 128 + 128; k0 += 16) { float w[16];
#pragma unroll
            for (int q = 0; q < 16; ++q) w[q] = p.w_in[(size_t)(k0 + q) * 4096 + n];
#pragma unroll
            for (int q = 0; q < 16; ++q)
#pragma unroll
                for (int r = 0; r < 16; ++r) a[r] += hm[r * 1024 + k0 + q] * w[q]; }
#pragma unroll
        for (int r = 0; r < 16; ++r) red[(wid * 16 + r) * 64 + lane] = a[r];
        __syncthreads();
        for (int o = tid; o < 1024; o += 512) { const int r = o >> 6, l = o & 63; float s = 0.f;
#pragma unroll
            for (int w = 0; w < 8; ++w) s += red[(w * 16 + r) * 64 + l];
            const int nn = 512 + bx * 64 + l; const bf16_t hv = (bf16_t)(cvt_pk_bf16(s, 0.f) & 0xffffu);
            if (nn < 1024) ((bf16_t*)(ws + KMETA_OFF))[r * 512 + nn - 512] = hv;
            else if (nn < 1536) ((bf16_t*)(ws + VMETAT_OFF))[(nn - 1024) * 16 + r] = hv;
            else { const int ch = nn - 1536;
                for (int b = 0; b < 8; ++b) { bf16_t* ut = (bf16_t*)(ws + UT_OFF) + (b < 4 ? (size_t)b * 512 * NP + (size_t)ch * NP : (size_t)4 * 512 * NP + (size_t)(b - 4) * 512 * NS + (size_t)ch * NS); ut[r] = hv; } } }
        __syncthreads();
    }
    for (int r1_ = 0; r1_ < (P0REP == 1 ? 2 : 1); ++r1_)
    if (PART == 0 || PART == 2) {
        LAS float* scr = (LAS float*)(lds + wid * 8448);
        constexpr int I_IN = 16 * 128, I_UP = 16 * 128, I_DN = 64 * 32, I_OUT = 16 * 32, I_NA = 8 * 32, NIT = I_IN + I_UP + I_DN + I_OUT + I_NA;
        for (int it = (PART == 0 ? 0 : I_IN) + gw; it < (PART == 0 ? I_IN : NIT); it += NGW) {
            int r = it;
            if (r < I_IN) { const int kb = r / 128, nb = r % 128, n0 = nb * 32; bf16_t* dst; int orow; float mul = 1.f;
                if (n0 < 512) { dst = (bf16_t*)(ws + WINA_OFF); orow = n0; mul = 0.125f; } else if (n0 < 1024) { dst = (bf16_t*)(ws + WINA_OFF); orow = n0; }
                else if (n0 < 2048) { dst = (bf16_t*)(ws + WINB_OFF); orow = n0 - 1024; }
                else { const int isfn = n0 >= 3072, gc = n0 - (isfn ? 3072 : 2048); dst = (bf16_t*)(ws + WINA_OFF); orow = 1024 + 256 * (gc >> 7) + 128 * isfn + (gc & 127); }
                p0_transpose_item(p.w_in, 1024, 4096, dst, orow, n0, kb * 64, p.g_mix, mul, scr, lane); continue; } r -= I_IN;
            if (r < I_UP) { const int kb = r / 128, nb = r % 128; p0_transpose_item(p.w_up, 1024, 4096, (bf16_t*)(ws + WUP_OFF), nb * 32, nb * 32, kb * 64, p.g_mlp, 1.f, scr, lane); continue; } r -= I_UP;
            if (r < I_DN) { const int kb = r / 32, nb = r % 32; p0_transpose_item(p.w_down, 4096, 1024, (bf16_t*)(ws + WDN_OFF), nb * 32, nb * 32, kb * 64, nullptr, 1.f, scr, lane); continue; } r -= I_DN;
            if (r < I_OUT) { const int kb = r / 32, nb = r % 32; p0_transpose_item(p.w_out, 1024, 1024, (bf16_t*)(ws + WOUT_OFF), nb * 32, nb * 32, kb * 64, nullptr, 1.f, scr, lane); continue; } r -= I_OUT;
            { const int kb = r / 32, nb = r % 32; p0_transpose_item(p.w_na, 512, 1024, (bf16_t*)(ws + WNA_OFF), nb * 32, nb * 32, kb * 64, nullptr, 1.f, scr, lane); }
        }
    }
    for (int r2_ = 0; r2_ < (P0REP == 2 ? 2 : 1); ++r2_)
    if (PART == 2) for (int tw = gw; tw < 64 * 4 * 2; tw += NGW) {
        const int twu = __builtin_amdgcn_readfirstlane(tw); const int c = (twu & 1) * 64 + lane, g = (twu >> 1) & 3, d0 = (twu >> 3) * 16;
        float ac[16], as[16];
#pragma unroll
        for (int q = 0; q < 16; ++q) { ac[q] = 0.f; as[q] = 0.f; }
        const float* wf = p.w_fn + (size_t)g * 128 * 1024 + d0;
#pragma unroll 2
        for (int cp = 0; cp < 128; ++cp) { const float tr = (float)((c * cp) & 127) * (1.0f / 128.0f); const float co = __builtin_amdgcn_cosf(tr), si = __builtin_amdgcn_sinf(tr);
            f32x4 w[4];
#pragma unroll
            for (int q = 0; q < 4; ++q) w[q] = *(const __attribute__((address_space(4))) f32x4*)(unsigned long long)(wf + (size_t)cp * 1024 + 4 * q);
#pragma unroll
            for (int q = 0; q < 16; ++q) { ac[q] += co * w[q >> 2][q & 3]; as[q] -= si * w[q >> 2][q & 3]; } }
        bf16_t* o = (bf16_t*)(ws + WFN_OFF) + (size_t)d0 * 1024 + g * 128 + c;
#pragma unroll
        for (int q = 0; q < 16; ++q) { o[(size_t)q * 1024] = (bf16_t)(cvt_pk_bf16(ac[q], 0.f) & 0xffffu); o[(size_t)q * 1024 + 512] = (bf16_t)(cvt_pk_bf16(as[q], 0.f) & 0xffffu); } }
    for (int r3_ = 0; r3_ < (P0REP == 3 ? 2 : 1); ++r3_)
    if (PART == 1) {
        constexpr int IP = MRP * (KPP / 8), IS = MRS * (KPS / 8);
        for (int it = gt; it < IP + IS; it += NGT) {
            int i, j, N, KP; bf16_t* cm; bf16_t* sm;
            if (it < IP) { i = it / (KPP / 8); j = it % (KPP / 8); N = NP; KP = KPP; cm = (bf16_t*)(ws + CP_OFF); sm = (bf16_t*)(ws + SP_OFF); }
            else { const int q = it - IP; i = q / (KPS / 8); j = q % (KPS / 8); N = NS; KP = KPS; cm = (bf16_t*)(ws + CS_OFF); sm = (bf16_t*)(ws + SSM_OFF); }
            const int np = i + 1, HN = N / 2; const float norm = rsqrtf(128.0f * (float)N), invN = 1.0f / (float)N;
            float cv[8], sv[8]; int mm; { const unsigned prod = (unsigned)np * (unsigned)(8 * j); unsigned q = (unsigned)((float)prod * invN); if (q > 0) --q; mm = (int)(prod - q * (unsigned)N); while (mm >= N) mm -= N; }
#pragma unroll
            for (int e = 0; e < 8; ++e) { const int k = 8 * j + e; const bool ok = (np <= HN) && (k <= HN); const float tr = (float)mm * invN;
                cv[e] = ok ? __builtin_amdgcn_cosf(tr) * norm : 0.f; sv[e] = ok ? __builtin_amdgcn_sinf(tr) * norm : 0.f; mm += np; if (mm >= N) mm -= N; }
            u32x4 wc_, ws_; wc_.x = cvt_pk_bf16(cv[0], cv[1]); wc_.y = cvt_pk_bf16(cv[2], cv[3]); wc_.z = cvt_pk_bf16(cv[4], cv[5]); wc_.w = cvt_pk_bf16(cv[6], cv[7]);
            ws_.x = cvt_pk_bf16(sv[0], sv[1]); ws_.y = cvt_pk_bf16(sv[2], sv[3]); ws_.z = cvt_pk_bf16(sv[4], sv[5]); ws_.w = cvt_pk_bf16(sv[6], sv[7]);
            *(u32x4*)(cm + (size_t)i * KP + 8 * j) = wc_; *(u32x4*)(sm + (size_t)i * KP + 8 * j) = ws_;
        }
    }
    for (int r4_ = 0; r4_ < (P0REP == 4 ? 2 : 1); ++r4_)
    if (PART == 0) for (int g0 = gw; g0 < MT; g0 += 4 * NGW) {
        f32x4 v[4][4];
#pragma unroll
        for (int q = 0; q < 4; ++q) { const int g = g0 + q * NGW; if (g < MT) { const float* xr = g < 4 * TP ? p.xp + (size_t)g * 1024 : p.xs + (size_t)(g - 4 * TP) * 1024;
#pragma unroll
                for (int j = 0; j < 4; ++j) v[q][j] = ((const f32x4*)xr)[lane + 64 * j]; } }
#pragma unroll
        for (int q = 0; q < 4; ++q) { const int g = g0 + q * NGW; if (g < MT) { float s = 0.f;
#pragma unroll
                for (int j = 0; j < 4; ++j) s += (v[q][j][0] * v[q][j][0] + v[q][j][1] * v[q][j][1]) + (v[q][j][2] * v[q][j][2] + v[q][j][3] * v[q][j][3]);
                const float rinv = rsqrtf(wave_sum(s) * (1.0f / 1024.0f) + RMS_EPS);
                u32x2* o = (u32x2*)((bf16_t*)(ws + XB_OFF) + (size_t)g * 1024);
#pragma unroll
                for (int j = 0; j < 4; ++j) { u32x2 w; w.x = cvt_pk_bf16(v[q][j][0] * rinv, v[q][j][1] * rinv); w.y = cvt_pk_bf16(v[q][j][2] * rinv, v[q][j][3] * rinv); o[lane + 64 * j] = w; } } }
    }
}

constexpr int A_KS = 0, A_VS = 73728, A_KM = 147456, A_VM = 149504, A_BS = 151552, A_MB = 155392;
__device__ __forceinline__ void attn_units(const Params& p, LAS unsigned char* lds, const int u_lo, const int u_hi) {
    const int tid = threadIdx.x, lane = tid & 63, wid = __builtin_amdgcn_readfirstlane(tid >> 6), G = gridDim.x, bx = blockIdx.x;
    const int li = lane & 15, g = lane >> 4;
    unsigned char* ws = p.ws;
    const bf16_t* Qb = (const bf16_t*)(ws + Q_OFF); const bf16_t* Kb = (const bf16_t*)(ws + K_OFF); const bf16_t* VT = (const bf16_t*)(ws + VT_OFF);
    bf16_t* att = (bf16_t*)(ws + ATT_OFF);
    int pb = -1, ph = -1, hiR = -1;
    const int sr = tid >> 3, sch = tid & 7;
    u32x4 pf[4]; int pfn = 0, pfR0 = 0;
    for (int un = u_lo; un < u_hi; ++un) {
        int b, h, rp, rows;
        if (un < 2048) { b = un >> 9; h = (un >> 6) & 7; rp = un & 63; rows = 128; } else { const int v = un - 2048; b = 4 + (v >> 8); h = (v >> 5) & 7; rp = v & 31; rows = 64; }
        const int gb = batch_base(b), T = rows * 64, r0 = 2 * rp;
        const int rsA = min(max(r0 - 4, 0), rows - 8), needHi = min(rsA + 8, rows - 1);
        if (b != pb || h != ph) {
            __syncthreads();
            { u32x4 kvv[9], vvv[9];
#pragma unroll
              for (int j = 0; j < 9; ++j) { const int R = min(rsA + j, needHi);
                kvv[j] = *(const u32x4*)(Kb + (size_t)(gb + R * 64 + sr) * 512 + h * 64 + sch * 8);
                vvv[j] = *(const u32x4*)(VT + (size_t)512 * gb + (size_t)(h * 64 + sr) * T + R * 64 + sch * 8); }
#pragma unroll
              for (int j = 0; j < 9; ++j) { const int sl = min(rsA + j, needHi) % 9;
                *(LAS u32x4*)(lds + A_KS + sl * 8192 + sr * 128 + ((sch ^ ((sr & 2) << 1)) * 16)) = kvv[j];
                *(LAS u32x4*)(lds + A_VS + sl * 8192 + sr * 128 + ((sch ^ ((sr >> 1) & 7)) * 16)) = vvv[j]; } }
            if (tid < 128) { const int r = tid >> 3, ch = tid & 7; *(LAS u32x4*)(lds + A_KM + r * 128 + ((ch ^ ((r & 2) << 1)) * 16)) = *(const u32x4*)((const bf16_t*)(ws + KMETA_OFF) + r * 512 + h * 64 + ch * 8); }
            else if (tid < 256) { const int q = tid - 128; *(LAS u32x4*)(lds + A_VM + q * 16) = *(const u32x4*)((const bf16_t*)(ws + VMETAT_OFF) + h * 64 * 16 + q * 8); }
            for (int i = tid; i < 15 * 64; i += 512) { const int ro = i >> 6, x = (i & 63) - 16; ((LAS float*)(lds + A_BS))[i] = (x >= 0 && x <= 30) ? p.rel_bias[(h * 15 + ro) * 31 + x] : 0.f; }
            if (tid < 16) ((LAS float*)(lds + A_MB))[tid] = p.meta_bias[h * 16 + tid];
            pb = b; ph = h; hiR = needHi;
        } else {
#pragma unroll
            for (int j = 0; j < 2; ++j) if (j < pfn) { const int sl = (pfR0 + j) % 9;
                *(LAS u32x4*)(lds + A_KS + sl * 8192 + sr * 128 + ((sch ^ ((sr & 2) << 1)) * 16)) = pf[2 * j];
                *(LAS u32x4*)(lds + A_VS + sl * 8192 + sr * 128 + ((sch ^ ((sr >> 1) & 7)) * 16)) = pf[2 * j + 1]; }
            hiR = needHi;
        }
        __syncthreads();
        pfn = 0;
        if (un + 1 < u_hi) { const int un2 = un + 1; int b2, h2, rp2;
            if (un2 < 2048) { b2 = un2 >> 9; h2 = (un2 >> 6) & 7; rp2 = un2 & 63; } else { const int v = un2 - 2048; b2 = 4 + (v >> 8); h2 = (v >> 5) & 7; rp2 = v & 31; }
            if (b2 == b && h2 == h) { const int rsA2 = min(max(2 * rp2 - 4, 0), rows - 8), nh2 = min(rsA2 + 8, rows - 1); pfR0 = hiR + 1; pfn = nh2 - hiR;
#pragma unroll
                for (int j = 0; j < 2; ++j) if (j < pfn) { const int R = pfR0 + j;
                    pf[2 * j] = *(const u32x4*)(Kb + (size_t)(gb + R * 64 + sr) * 512 + h * 64 + sch * 8);
                    pf[2 * j + 1] = *(const u32x4*)(VT + (size_t)512 * gb + (size_t)(h * 64 + sr) * T + R * 64 + sch * 8); } } }
        const int r = r0 + (wid >> 2), c0 = 16 * (wid & 3), kc0 = min(max(c0 - 8, 0), 32);
        const int rs = min(max(r - 4, 0), rows - 8);
        int slot[8];
        { const int s0 = rs % 9;
#pragma unroll
          for (int w = 0; w < 8; ++w) slot[w] = (s0 + w >= 9) ? s0 + w - 9 : s0 + w; }
        const int c = c0 + li, cs = min(max(c - 8, 0), 48);
        const size_t qrow = (size_t)(gb + r * 64 + c);
        bf16x8 qf[2];
        qf[0] = *(const bf16x8*)(Qb + qrow * 512 + h * 64 + 8 * g); qf[1] = *(const bf16x8*)(Qb + qrow * 512 + h * 64 + 32 + 8 * g);
        f32x4 sa[8][2]; f32x4 sm_;
        {
            const int kr0 = kc0 + li;
#pragma unroll
            for (int w = 0; w < 8; ++w)
#pragma unroll
                for (int j = 0; j < 2; ++j) { const int kr = kr0 + 16 * j; const LAS unsigned char* rowp = lds + A_KS + slot[w] * 8192 + kr * 128;
                    const bf16x8 a0 = *(const LAS bf16x8*)(rowp + ((g ^ ((kr & 2) << 1)) * 16)), a1 = *(const LAS bf16x8*)(rowp + (((g + 4) ^ ((kr & 2) << 1)) * 16));
                    f32x4 z = (f32x4){0.f, 0.f, 0.f, 0.f};
                    z = __builtin_amdgcn_mfma_f32_16x16x32_bf16(a0, qf[0], z, 0, 0, 0); sa[w][j] = __builtin_amdgcn_mfma_f32_16x16x32_bf16(a1, qf[1], z, 0, 0, 0); }
            const LAS unsigned char* rowp = lds + A_KM + li * 128;
            const bf16x8 a0 = *(const LAS bf16x8*)(rowp + ((g ^ ((li & 2) << 1)) * 16)), a1 = *(const LAS bf16x8*)(rowp + (((g + 4) ^ ((li & 2) << 1)) * 16));
            f32x4 z = (f32x4){0.f, 0.f, 0.f, 0.f};
            z = __builtin_amdgcn_mfma_f32_16x16x32_bf16(a0, qf[0], z, 0, 0, 0); sm_ = __builtin_amdgcn_mfma_f32_16x16x32_bf16(a1, qf[1], z, 0, 0, 0);
        }
        const int dl = kc0 + 4 * g - cs;
        const LAS float* bsp = (const LAS float*)(lds + A_BS) + (rs - r + 7) * 64 + (kc0 + 4 * g - c + 31);
        float mx = -1e30f;
#pragma unroll
        for (int w = 0; w < 8; ++w)
#pragma unroll
            for (int j = 0; j < 2; ++j)
#pragma unroll
                for (int e = 0; e < 4; ++e) { const bool ok = (unsigned)(dl + 16 * j + e) < 16u; const float bv = bsp[w * 64 + 16 * j + e];
                    float sv = sa[w][j][e] + bv; sv = ok ? sv : -1e30f; sa[w][j][e] = sv; mx = fmaxf(mx, sv); }
#pragma unroll
        for (int e = 0; e < 4; ++e) { sm_[e] += ((const LAS float*)(lds + A_MB))[4 * g + e]; mx = fmaxf(mx, sm_[e]); }
        mx = fmaxf(mx, __shfl_xor(mx, 16)); mx = fmaxf(mx, __shfl_xor(mx, 32));
        const float mxl = mx * 1.44269504f; float sum = 0.f;
#pragma unroll
        for (int w = 0; w < 8; ++w)
#pragma unroll
            for (int j = 0; j < 2; ++j)
#pragma unroll
                for (int e = 0; e < 4; ++e) { const float pe = __builtin_amdgcn_exp2f(sa[w][j][e] * 1.44269504f - mxl); sa[w][j][e] = pe; sum += pe; }
#pragma unroll
        for (int e = 0; e < 4; ++e) { const float pe = __builtin_amdgcn_exp2f(sm_[e] * 1.44269504f - mxl); sm_[e] = pe; sum += pe; }
        sum += __shfl_xor(sum, 16); sum += __shfl_xor(sum, 32);
        const float rsum = 1.0f / sum;
        f32x4 o[4];
#pragma unroll
        for (int dt = 0; dt < 4; ++dt) o[dt] = (f32x4){0.f, 0.f, 0.f, 0.f};
        const int c8 = (kc0 >> 2) + g;
#pragma unroll
        for (int w = 0; w < 8; ++w) { u32x4 pw; pw.x = cvt_pk_bf16(sa[w][0][0], sa[w][0][1]); pw.y = cvt_pk_bf16(sa[w][0][2], sa[w][0][3]); pw.z = cvt_pk_bf16(sa[w][1][0], sa[w][1][1]); pw.w = cvt_pk_bf16(sa[w][1][2], sa[w][1][3]);
            const bf16x8 pbv = __builtin_bit_cast(bf16x8, pw);
#pragma unroll
            for (int dt = 0; dt < 4; ++dt) { const int d = 16 * dt + li, sw = 2 * ((d >> 1) & 7); const LAS unsigned char* rowp = lds + A_VS + slot[w] * 8192 + d * 128;
                const u32x2 lo = *(const LAS u32x2*)(rowp + ((c8 ^ sw) * 8)), hi = *(const LAS u32x2*)(rowp + (((c8 + 4) ^ sw) * 8));
                u32x4 av; av.x = lo.x; av.y = lo.y; av.z = hi.x; av.w = hi.y;
                o[dt] = __builtin_amdgcn_mfma_f32_16x16x32_bf16(__builtin_bit_cast(bf16x8, av), pbv, o[dt], 0, 0, 0); } }
        { u32x4 pw; pw.x = cvt_pk_bf16(sm_[0], sm_[1]); pw.y = cvt_pk_bf16(sm_[2], sm_[3]); pw.z = 0u; pw.w = 0u; const bf16x8 pbv = __builtin_bit_cast(bf16x8, pw);
#pragma unroll
            for (int dt = 0; dt < 4; ++dt) { const int d = 16 * dt + li; const u32x2 lo = *(const LAS u32x2*)(lds + A_VM + d * 32 + g * 8);
                u32x4 av; av.x = lo.x; av.y = lo.y; av.z = 0u; av.w = 0u;
                o[dt] = __builtin_amdgcn_mfma_f32_16x16x32_bf16(__builtin_bit_cast(bf16x8, av), pbv, o[dt], 0, 0, 0); } }
#pragma unroll
        for (int dt = 0; dt < 4; ++dt) { u32x2 w; w.x = cvt_pk_bf16(o[dt][0] * rsum, o[dt][1] * rsum); w.y = cvt_pk_bf16(o[dt][2] * rsum, o[dt][3] * rsum);
            *(u32x2*)(att + qrow * 512 + h * 64 + 16 * dt + 4 * g) = w; }
        __syncthreads();
    }
}
__device__ __forceinline__ void dft_prep(const Params& p) {
    const int tid = threadIdx.x, G = gridDim.x, bx = blockIdx.x; unsigned char* ws = p.ws;
    {
        const int gt = bx * 512 + tid, NGT = G * 512;
        constexpr int IPP = 4 * 512 * (KPP / 8), IPS = 4 * 512 * (KPS / 8);
        for (int it = gt; it < IPP + IPS; it += NGT) {
            int b, ch, j, N, KP; size_t ub, eb;
            if (it < IPP) { b = it / (512 * (KPP / 8)); const int q = it % (512 * (KPP / 8)); ch = q / (KPP / 8); j = q % (KPP / 8); N = NP; KP = KPP; ub = ((size_t)b * 512 + ch) * NP; eb = ((size_t)b * 512 + ch) * KPP; }
            else { const int v = it - IPP; b = v / (512 * (KPS / 8)); const int q = v % (512 * (KPS / 8)); ch = q / (KPS / 8); j = q % (KPS / 8); N = NS; KP = KPS;
                ub = (size_t)4 * 512 * NP + ((size_t)b * 512 + ch) * NS; eb = (size_t)4 * 512 * KPP + ((size_t)b * 512 + ch) * KPS; }
            (void)KP;
            const bf16_t* ut = (const bf16_t*)(ws + UT_OFF) + ub; const int HN = N / 2, k0 = 8 * j;
            float ev[8], ov[8];
            if (k0 < HN) { const u32x4 f = *(const u32x4*)(ut + k0); const u32x4 rv = *(const u32x4*)(ut + N - k0 - 8);
                const float fw[8] = {bf_lo(f.x), bf_hi(f.x), bf_lo(f.y), bf_hi(f.y), bf_lo(f.z), bf_hi(f.z), bf_lo(f.w), bf_hi(f.w)};
                const float rr[8] = {bf_lo(rv.x), bf_hi(rv.x), bf_lo(rv.y), bf_hi(rv.y), bf_lo(rv.z), bf_hi(rv.z), bf_lo(rv.w), bf_hi(rv.w)};
                const float r0v = (k0 > 0) ? __uint_as_float((unsigned)ut[N - k0] << 16) : 0.f;
#pragma unroll
                for (int e = 0; e < 8; ++e) { const float rvv = (e == 0) ? r0v : rr[8 - e]; ev[e] = fw[e] + rvv; ov[e] = fw[e] - rvv; }
                if (k0 == 0) { ev[0] = fw[0]; ov[0] = 0.f; } }
            else {
#pragma unroll
                for (int e = 0; e < 8; ++e) { ev[e] = 0.f; ov[e] = 0.f; }
                if (k0 == HN) ev[0] = __uint_as_float((unsigned)ut[HN] << 16); }
            u32x4 we, wo; we.x = cvt_pk_bf16(ev[0], ev[1]); we.y = cvt_pk_bf16(ev[2], ev[3]); we.z = cvt_pk_bf16(ev[4], ev[5]); we.w = cvt_pk_bf16(ev[6], ev[7]);
            wo.x = cvt_pk_bf16(ov[0], ov[1]); wo.y = cvt_pk_bf16(ov[2], ov[3]); wo.z = cvt_pk_bf16(ov[4], ov[5]); wo.w = cvt_pk_bf16(ov[6], ov[7]);
            *(u32x4*)((bf16_t*)(ws + UE_OFF) + eb + k0) = we; *(u32x4*)((bf16_t*)(ws + UO_OFF) + eb + k0) = wo;
        }
    }
}

#define XB_TMO      128
#define XB_XCNT(j)  (256  + 64 * (j))
#define XB_XSUB(j)  (1280 + 64 * (j))
#define XB_XGEN(j)  (2304 + 64 * (j))
#define XB_TOP      3328
#define XB_TOPGEN   3392
#define XCD_BAR_WORDS 3456
#define XB_SPIN_CAP (1u << 18)

__device__ __forceinline__ unsigned xb_ld(unsigned* p)              { return __hip_atomic_load(p, __ATOMIC_RELAXED, __HIP_MEMORY_SCOPE_AGENT); }
__device__ __forceinline__ unsigned xb_add(unsigned* p, unsigned v) { return __hip_atomic_fetch_add(p, v, __ATOMIC_RELAXED, __HIP_MEMORY_SCOPE_AGENT); }
__device__ __forceinline__ unsigned xb_xcc_id() { return (unsigned)__builtin_amdgcn_s_getreg((3 << 11) | 20) & 0xFu; }
#define XB_SPIN(cond, bar) do { unsigned _sp = 0; while (cond) { __builtin_amdgcn_s_sleep(1); \
    if ((++_sp & 255u) == 0u) { if (xb_ld(&(bar)[XB_TMO])) break; if (_sp > XB_SPIN_CAP) { atomicAdd(&(bar)[XB_TMO], 1u); break; } } } } while (0)

struct XcdBarrier {
    unsigned* bar; unsigned x;
    volatile LAS unsigned* st;
};

__device__ __forceinline__ XcdBarrier xcd_barrier_post(unsigned* bar, volatile LAS unsigned* st) {
    XcdBarrier b; b.bar = bar; b.x = xb_xcc_id(); b.st = st;
    if (threadIdx.x == 0) (void)xb_add(&bar[XB_XCNT(b.x)], 1u);
    return b;
}
__device__ __forceinline__ void xcd_barrier_complete(unsigned* bar, unsigned x, unsigned& nloc, unsigned& nx) {
    const unsigned G = gridDim.x * gridDim.y * gridDim.z;
    unsigned sum, cnt, mine, sp = 0u;
    for (;;) {
        sum = 0u; cnt = 0u; mine = 0u;
#pragma unroll
        for (unsigned j = 0; j < 16; ++j) { const unsigned c = xb_ld(&bar[XB_XCNT(j)]); sum += c; cnt += (c > 0u) ? 1u : 0u; mine = (j == x) ? c : mine; }
        if (sum == G) break;
        __builtin_amdgcn_s_sleep(1);
        if ((++sp & 255u) == 0u) { if (xb_ld(&bar[XB_TMO])) break; if (sp > XB_SPIN_CAP) { atomicAdd(&bar[XB_TMO], 1u); break; } }
    }
    nloc = mine > 0u ? mine : 1u; nx = cnt > 0u ? cnt : 1u;
}

__device__ __forceinline__ void xcd_barrier(const XcdBarrier& b) {
    asm volatile("s_waitcnt vmcnt(0)" ::: "memory");
    __syncthreads();
    if (threadIdx.x == 0) {
        unsigned* bar = b.bar;
        __builtin_amdgcn_s_waitcnt(0);
        unsigned nloc = b.st[0], nx = b.st[1];
        if (nloc == 0u) { xcd_barrier_complete(bar, b.x, nloc, nx); b.st[0] = nloc; b.st[1] = nx; }
        const unsigned old = xb_add(&bar[XB_XSUB(b.x)], 1u);
        const unsigned gen = old / nloc;
        if (old + 1u == (gen + 1u) * nloc) {
            __builtin_amdgcn_fence(__ATOMIC_RELEASE, "agent");
            asm volatile("s_waitcnt vmcnt(0)" ::: "memory");
            const unsigned og = xb_add(&bar[XB_TOP], 1u);
            const unsigned tg = og / nx;
            if (og + 1u == (tg + 1u) * nx) xb_add(&bar[XB_TOPGEN], 1u);
            else XB_SPIN(xb_ld(&bar[XB_TOPGEN]) == tg, bar);
            __builtin_amdgcn_fence(__ATOMIC_ACQUIRE, "agent");
            xb_add(&bar[XB_XGEN(b.x)], 1u);
            asm volatile("s_waitcnt vmcnt(0)" ::: "memory");
        } else {
            XB_SPIN(xb_ld(&bar[XB_XGEN(b.x)]) == gen, bar);
            __builtin_amdgcn_fence(__ATOMIC_ACQUIRE, "agent");
            asm volatile("s_waitcnt vmcnt(0)" ::: "memory");
        }
    }
    __syncthreads();
}


#ifndef STG_W6
#define STG_W6 0
#endif
__device__ __forceinline__ void phase_stagger(int w_ticks) {
    if (w_ticks > 0) { const int bx = blockIdx.x, rank = (bx & 7) * (gridDim.x >> 3) + (bx >> 3);
        const unsigned long long t1 = __builtin_amdgcn_s_memrealtime() + (unsigned long long)((long)w_ticks * rank / gridDim.x);
        while (__builtin_amdgcn_s_memrealtime() < t1) __builtin_amdgcn_s_sleep(8); }
}
__global__ void __launch_bounds__(512, 2) mega_fwd(Params p) {
    extern __shared__ __attribute__((aligned(16))) unsigned char lds_raw[];
    LAS unsigned char* lds = (LAS unsigned char*)lds_raw;
    const int lo = p.ph_lo, hi = p.ph_hi, G = gridDim.x, bx = blockIdx.x;
    unsigned char* ws = p.ws;
    unsigned long long tsa_ = 0, tsb_ = 0;
#define TSA(k) do { if (TS_PHASE == (k)) tsa_ = __builtin_amdgcn_s_memrealtime(); } while (0)
#define TSB(k) do { if (TS_PHASE == (k)) tsb_ = __builtin_amdgcn_s_memrealtime(); } while (0)
#define IN(k) (lo <= (k) && (k) < hi)
    volatile LAS unsigned* bst = (volatile LAS unsigned*)(lds + LDS_BYTES - 64);
    if (threadIdx.x < 2) bst[threadIdx.x] = 0u;
    __syncthreads();
    if (bx == 0) { for (int i = threadIdx.x; i < 4096; i += 512) __hip_atomic_store((unsigned*)ws + i, 0u, __ATOMIC_RELAXED, __HIP_MEMORY_SCOPE_AGENT); }
    if (hi - lo > 1) cg::this_grid().sync();
    XcdBarrier xbar = xcd_barrier_post((unsigned*)ws, bst);
#define SEAM(k) do { if (IN(k) && IN((k) + 1)) { xcd_barrier(xbar); } } while (0)
#define REPS(k) for (int rep_ = 0; rep_ < ((REP_PHASE == (k)) ? 2 : 1); ++rep_)
#define REPSYNC(k) do { if (REP_PHASE == (k) && rep_ == 0) cg::this_grid().sync(); } while (0)
    TSA(0);
    if (IN(0)) REPS(0) { p0_prologue<0>(p, lds, bx, G); __syncthreads(); REPSYNC(0); }
    SEAM(0); TSB(0);
    TSA(1);
    if (IN(1)) REPS(1) {
        { SchedRect<1> S{}; S.A0 = (const char*)(ws + XB_OFF); S.B0 = (const char*)(ws + WINA_OFF); S.pa0 = 2048; S.nt0 = 16; S.nM = MT / 256; S.nN = 12; S.G = G; S.c = bx;
          EpiP1a E{ws, p.out}; pg8::gemm_phase<false>(lds, S, E); }
        { SchedRect<1> S{}; S.A0 = (const char*)(ws + XB_OFF); S.B0 = (const char*)(ws + WINB_OFF); S.pa0 = 2048; S.nt0 = 16; S.nM = MT / 256; S.nN = 4; S.G = G; S.c = bx;
          EpiP1b E{ws}; pg8::gemm_phase<true>(lds, S, E); }
        REPSYNC(1);
    }
    SEAM(1); TSB(1);
    TSA(2);
    if (IN(2)) REPS(2) { p0_prologue<1>(p, lds, bx, G); dft_prep(p); __syncthreads(); REPSYNC(2); }
    SEAM(2); TSB(2);
    TSA(3);
    if (IN(3)) REPS(3) { SchedDft S{(const char*)ws, G, bx}; EpiDft E{ws}; pg8::gemm_phase<false>(lds, S, E);
        int a_lo, a_hi;
        if (G == 256) {
            if (bx < 16) { a_lo = bx * 6; a_hi = a_lo + 6; } else if (bx < 80) { a_lo = 96 + (bx - 16) * 13; a_hi = a_lo + 13; } else if (bx < 160) { a_lo = 928 + (bx - 80) * 12; a_hi = a_lo + 12; }
            else { p0_prologue<2>(p, lds, bx - 160, 96); if (bx < 224) { a_lo = 1888 + (bx - 160) * 10; a_hi = a_lo + 10; } else { a_lo = 2528 + (bx - 224) * 17; a_hi = a_lo + 17; } }
        } else { p0_prologue<2>(p, lds, bx, G); const int per = (3072 + G - 1) / G; a_lo = bx * per; a_hi = min(a_lo + per, 3072); }
        __syncthreads();
        attn_units(p, lds, a_lo, a_hi);
        __syncthreads();
        REPSYNC(3); }
    SEAM(3); TSB(3);
    TSA(4);
    if (IN(4)) REPS(4) {
        SchedMerge S{(const char*)ws, G, bx};
        EpiMerge E{ws, p.out}; pg8::gemm_phase<false>(lds, S, E); REPSYNC(4);
    }
    SEAM(4); TSB(4);
    TSA(5);
    if (IN(5)) {
        SchedRect<1> S{}; S.A0 = (const char*)(ws + MIX_OFF); S.B0 = (const char*)(ws + WOUT_OFF); S.pa0 = 2048; S.nt0 = 16; S.nM = MT / 256; S.nN = 4; S.G = G; S.c = bx;
        EpiRes5 E{p.xp, p.xs, (bf16_t*)(ws + X1B_OFF), (float*)(ws + SS1_OFF)}; pg8::gemm_phase<false>(lds, S, E);
    }
    SEAM(5); TSB(5);
    TSA(6);
    if (IN(6)) REPS(6) {
        phase_stagger(STG_W6);
        SchedRect<1> S{}; S.A0 = (const char*)(ws + X1B_OFF); S.B0 = (const char*)(ws + WUP_OFF); S.pa0 = 2048; S.nt0 = 16; S.nM = MT / 256; S.nN = 16; S.G = G; S.c = bx;
        EpiUp E{(bf16_t*)(ws + H_OFF), (const float*)(ws + SS1_OFF)}; pg8::gemm_phase<false>(lds, S, E); REPSYNC(6);
    }
    SEAM(6); TSB(6);
    TSA(7);
    if (IN(7)) {
        SchedRect<1> S{}; S.A0 = (const char*)(ws + H_OFF); S.B0 = (const char*)(ws + WDN_OFF); S.pa0 = 8192; S.nt0 = 64; S.nM = MT / 256; S.nN = 4; S.G = G; S.c = bx;
        EpiRes7 E{(bf16_t*)(ws + X1B_OFF), (float*)(ws + SS2_OFF)}; pg8::gemm_phase<false>(lds, S, E);
    }
    SEAM(7); TSB(7);
    TSA(8);
    if (IN(8)) {
        const int tid = threadIdx.x, lane = tid & 63, wid = tid >> 6; const float* ss2 = (const float*)(ws + SS2_OFF);
        f32x4 gf[2][2];
#pragma unroll
        for (int j = 0; j < 2; ++j) { gf[j][0] = *(const f32x4*)(p.g_final + 512 * j + lane * 8); gf[j][1] = *(const f32x4*)(p.g_final + 512 * j + lane * 8 + 4); }
        for (int g0 = bx * 8 + wid; g0 < MT; g0 += 2 * G * 8) {
            u32x4 v[2][2]; float rinv[2];
#pragma unroll
            for (int q = 0; q < 2; ++q) { const int g = g0 + q * G * 8; if (g < MT) { const bf16_t* xr = (const bf16_t*)(ws + X1B_OFF) + (size_t)g * 1024;
                    v[q][0] = *(const u32x4*)(xr + lane * 8); v[q][1] = *(const u32x4*)(xr + 512 + lane * 8); rinv[q] = rsqrtf(ss2[g] * (1.0f / 1024.0f) + RMS_EPS); } }
#pragma unroll
            for (int q = 0; q < 2; ++q) { const int g = g0 + q * G * 8; if (g < MT) { float* o = p.out + (size_t)g * 1024;
#pragma unroll
                    for (int j = 0; j < 2; ++j) { const u32x4 b = v[q][j]; f32x4 o0, o1;
                        o0[0] = bf_lo(b.x); o0[1] = bf_hi(b.x); o0[2] = bf_lo(b.y); o0[3] = bf_hi(b.y); o1[0] = bf_lo(b.z); o1[1] = bf_hi(b.z); o1[2] = bf_lo(b.w); o1[3] = bf_hi(b.w);
                        *(f32x4*)(o + 512 * j + lane * 8) = o0 * rinv[q] * gf[j][0]; *(f32x4*)(o + 512 * j + lane * 8 + 4) = o1 * rinv[q] * gf[j][1]; } } }
        }
    }
    TSB(8);
    if (TS_PHASE >= 0 && bx == 0) { const unsigned long long t1 = __builtin_amdgcn_s_memrealtime() + (tsb_ - tsa_); while (__builtin_amdgcn_s_memrealtime() < t1) __builtin_amdgcn_s_sleep(8); }
#undef IN
#undef SEAM
}

extern "C" void kernel_launch(void* const* d_in, const int* in_sizes, int n_in, void* d_out, int out_size, void* d_ws, size_t ws_size, hipStream_t stream) {
    static int grid = 0;
    if (grid == 0) {
        if (n_in != 14 || out_size != MT * D || ws_size < WS_NEED) { fprintf(stderr, "kernel_launch: unexpected shapes (n_in %d, out %d, ws %zu)\n", n_in, out_size, ws_size); grid = -1; return; }
        int dev = 0, cus = 0, per_cu = 0;
        hipGetDevice(&dev); hipDeviceGetAttribute(&cus, hipDeviceAttributeMultiprocessorCount, dev);
        if (hipFuncSetAttribute((const void*)mega_fwd, hipFuncAttributeMaxDynamicSharedMemorySize, LDS_BYTES) != hipSuccess) { fprintf(stderr, "kernel_launch: hipFuncSetAttribute failed\n"); grid = -1; return; }
        if (hipOccupancyMaxActiveBlocksPerMultiprocessor(&per_cu, (const void*)mega_fwd, 512, LDS_BYTES) != hipSuccess || per_cu < 1) per_cu = 1;
        (void)hipGetLastError();
        grid = cus * per_cu;
    }
    if (grid < 0) return;
    Params p{};
    p.xp = (const float*)d_in[0]; p.xs = (const float*)d_in[1]; p.meta = (const float*)d_in[2]; p.w_in = (const float*)d_in[3]; p.rel_bias = (const float*)d_in[4]; p.meta_bias = (const float*)d_in[5];
    p.w_na = (const float*)d_in[6]; p.w_fn = (const float*)d_in[7]; p.w_out = (const float*)d_in[8]; p.g_mix = (const float*)d_in[9]; p.g_mlp = (const float*)d_in[10]; p.w_up = (const float*)d_in[11];
    p.w_down = (const float*)d_in[12]; p.g_final = (const float*)d_in[13]; p.out = (float*)d_out; p.ws = (unsigned char*)d_ws;
#if MK_PER_PHASE
    for (int ph = 0; ph < 9; ++ph) { p.ph_lo = ph; p.ph_hi = ph + 1; hipLaunchKernelGGL(mega_fwd, dim3(grid), dim3(512), LDS_BYTES, stream, p); }
#else
    p.ph_lo = 0; p.ph_hi = 9;
    void* args[] = {&p};
    hipError_t e = hipLaunchCooperativeKernel((const void*)mega_fwd, dim3(grid), dim3(512), args, LDS_BYTES, stream);
    if (e != hipSuccess) fprintf(stderr, "cooperative launch failed: %s (grid %d)\n", hipGetErrorString(e), grid);
#endif
}
```

```cpp
#include <hip/hip_runtime.h>
#include <hip/hip_cooperative_groups.h>
#include <cstdio>
#include <cstdint>
namespace cg = cooperative_groups;

#ifndef MK_PER_PHASE
#define MK_PER_PHASE 0
#endif

#ifndef TS_PHASE
#define TS_PHASE -1
#endif
#ifndef P0REP
#define P0REP -1
#endif
#ifndef EPI2
#define EPI2 -1
#endif
#ifndef REP_PHASE
#define REP_PHASE -1
#endif
#define LAS __attribute__((address_space(3)))
typedef unsigned short bf16_t;
typedef short bf16x8 __attribute__((ext_vector_type(8)));
typedef float f32x4 __attribute__((ext_vector_type(4)));
typedef float f32x2 __attribute__((ext_vector_type(2)));
typedef unsigned u32x4 __attribute__((ext_vector_type(4)));
typedef unsigned u32x2 __attribute__((ext_vector_type(2)));

constexpr int D = 1024, TP = 8192, TS = 4096, MT = 4 * TP + 4 * TS;
constexpr int NP = TP + 16, NS = TS + 16;
constexpr int KPP = 4224, KPS = 2176;
constexpr int MRP = 4352, MRS = 2304;
constexpr float RMS_EPS = 1e-6f;
constexpr size_t MiB = 1u << 20;
constexpr size_t SS1_OFF = 64 * 1024, SS2_OFF = 256 * 1024, KMETA_OFF = 512 * 1024, VMETAT_OFF = 528 * 1024;
constexpr size_t WINA_OFF = 1 * MiB, WINB_OFF = 7 * MiB, WUP_OFF = 9 * MiB, WDN_OFF = 17 * MiB, WOUT_OFF = 25 * MiB, WNA_OFF = 27 * MiB, WFN_OFF = 28 * MiB;
constexpr size_t XB_OFF = 30 * MiB;
constexpr size_t CP_OFF = 126 * MiB, SP_OFF = CP_OFF + (size_t)MRP * KPP * 2, CS_OFF = SP_OFF + (size_t)MRP * KPP * 2, SSM_OFF = CS_OFF + (size_t)MRS * KPS * 2;
constexpr size_t Q_OFF = 234 * MiB, K_OFF = 282 * MiB, VT_OFF = 330 * MiB, UT_OFF = 378 * MiB;
constexpr size_t ATT_OFF = 30 * MiB, UE_OFF = 427 * MiB, UO_OFF = 452 * MiB;
constexpr size_t PB_OFF = 78 * MiB, QB_OFF = 378 * MiB, MIX_OFF = 126 * MiB, X1B_OFF = 414 * MiB, H_OFF = 30 * MiB;
constexpr size_t WS_NEED = 510 * MiB;
static_assert(SSM_OFF + (size_t)MRS * KPS * 2 <= 234 * MiB, "dft matrices");
static_assert(UT_OFF + (size_t)512 * 2 * (4 * NP + 4 * NS) <= UE_OFF, "ut");
constexpr int LDS_BYTES = 160 * 1024;

__device__ __forceinline__ unsigned cvt_pk_bf16(float lo, float hi) { unsigned r; asm volatile("v_cvt_pk_bf16_f32 %0, %1, %2" : "=v"(r) : "v"(lo), "v"(hi)); return r; }
__device__ __forceinline__ float bf_lo(unsigned w) { return __uint_as_float(w << 16); }
__device__ __forceinline__ float bf_hi(unsigned w) { return __uint_as_float(w & 0xffff0000u); }
__device__ __forceinline__ float wave_sum(float v) {
#pragma unroll
    for (int o = 1; o < 64; o <<= 1) v += __shfl_xor(v, o);
    return v;
}
__device__ __forceinline__ int batch_base(int b) { return b < 4 ? b * TP : 4 * TP + (b - 4) * TS; }

struct Params {
    const float* xp; const float* xs; const float* meta; const float* w_in; const float* rel_bias; const float* meta_bias;
    const float* w_na; const float* w_fn; const float* w_out; const float* g_mix; const float* g_mlp; const float* w_up; const float* w_down; const float* g_final;
    float* out; unsigned char* ws; int ph_lo, ph_hi;
};

namespace pg8 {
constexpr int BM = 256, BK = 64, HALF = 128, HTB = HALF * BK * 2, STAGE_BYTES = 8 * HTB;
__device__ __forceinline__ int lds_byte(int r, int c) { const int st = (r >> 4) * 2 + (c >> 5), rr = r & 15, cc = c & 31, ob = rr * 64 + cc * 2; return st * 1024 + (ob ^ (((ob >> 9) & 1) << 5)); }
__device__ __forceinline__ void stage_rc(int b, int& R, int& C) { const int st = b / 1024, sb = b % 1024, swz = sb ^ (((sb >> 9) & 1) << 5); R = (st >> 1) * 16 + swz / 64; C = (st & 1) * 32 + (swz % 64) / 2; }
__device__ __forceinline__ int perm32(int rho) { const int n = rho >> 4, i = rho & 15; return 8 * (i >> 2) + 4 * n + (i & 3); }

struct Unit { const char* A; const char* B; int pa, pb, nt, pm, pn, aux; };

__device__ __forceinline__ bool rect_tile(long L, int nM, int nN, int& pm, int& pn) {
    const int nwg = nM * nN; if (L >= nwg) return false;
    int wgid = (int)L; { const int q = nwg / 8, r = nwg % 8, xcd = wgid % 8, off = wgid / 8; wgid = (xcd < r ? xcd * (q + 1) : r * (q + 1) + (xcd - r) * q) + off; }
    const int nig = 8 * nN, gid = wgid / nig, fm = gid * 8, gsz = (nM - fm) < 8 ? (nM - fm) : 8;
    pm = fm + ((wgid % nig) % gsz); pn = (wgid % nig) / gsz; return true;
}

template <bool TRANS, class Epi, class Sched>
__device__ __forceinline__ void gemm_phase(LAS unsigned char* lds, const Sched& S, const Epi& E) {
    const int tid = threadIdx.x, wid = __builtin_amdgcn_readfirstlane(tid >> 6), lane = tid & 63, wr = wid >> 2, wc = wid & 3, fr = lane & 15, fq = lane >> 4;
    int RA[2], RB[2], CB[2];
#pragma unroll
    for (int i = 0; i < 2; ++i) { int R, C; stage_rc(tid * 16 + i * 8192, R, C); RA[i] = R; RB[i] = Epi::PERM ? ((R & ~31) + perm32(R & 31)) : R; CB[i] = C * 2; }
    const unsigned ldsw = (unsigned)wid * 1024u;
    const int aoff = lds_byte(wr * 64 + fr, fq * 8), boff = lds_byte(wc * 32 + fr, fq * 8);
#define PG8_SA(b, h) (((b) * 2 + (h)) * HTB)
#define PG8_SB(b, h) ((4 + (b) * 2 + (h)) * HTB)
#define PG8_STAGE(bufoff, gbase, pitch, RR) do { _Pragma("unroll") for (int _i = 0; _i < 2; ++_i) \
        __builtin_amdgcn_global_load_lds((const unsigned*)((const char*)(gbase) + (unsigned)((RR)[_i] * (pitch) + CB[_i])), (LAS unsigned*)(lds + (bufoff) + ldsw + _i * 8192), 16, 0, 0); } while (0)
#define PG8_LDA(dst, b, h) do { _Pragma("unroll") for (int m = 0; m < 4; ++m) _Pragma("unroll") for (int k = 0; k < 2; ++k) dst[m][k] = *(const LAS bf16x8*)(lds + PG8_SA(b, h) + aoff + m * 2048 + k * 1024); } while (0)
#define PG8_LDB(dst, b, h) do { _Pragma("unroll") for (int n = 0; n < 2; ++n) _Pragma("unroll") for (int k = 0; k < 2; ++k) dst[n][k] = *(const LAS bf16x8*)(lds + PG8_SB(b, h) + boff + n * 2048 + k * 1024); } while (0)
#define PG8_MMA(ai, bj, At, Bt) do { __builtin_amdgcn_s_setprio(1); _Pragma("unroll") for (int m = 0; m < 4; ++m) _Pragma("unroll") for (int n = 0; n < 2; ++n) _Pragma("unroll") for (int k = 0; k < 2; ++k) \
        acc[ai][bj][m][n] = TRANS ? __builtin_amdgcn_mfma_f32_16x16x32_bf16(At[m][k], Bt[n][k], acc[ai][bj][m][n], 0, 0, 0) \
                                  : __builtin_amdgcn_mfma_f32_16x16x32_bf16(Bt[n][k], At[m][k], acc[ai][bj][m][n], 0, 0, 0); __builtin_amdgcn_s_setprio(0); } while (0)
#define PG8_WAIT_V(n) asm volatile("s_waitcnt vmcnt(" #n ")" ::: "memory")
#define PG8_WAIT_L(n) asm volatile("s_waitcnt lgkmcnt(" #n ")" ::: "memory")
#define PG8_BAR __builtin_amdgcn_s_barrier()
#define PG8_SCHED __builtin_amdgcn_sched_barrier(0)
    Unit cur, nxt; int ui = 0;
    if (!S.next(0, cur)) return;
    f32x4 acc[2][2][4][2];
#pragma unroll
    for (int a = 0; a < 2; ++a)
#pragma unroll
        for (int b = 0; b < 2; ++b)
#pragma unroll
            for (int m = 0; m < 4; ++m)
#pragma unroll
                for (int n = 0; n < 2; ++n) acc[a][b][m][n] = (f32x4){0.f, 0.f, 0.f, 0.f};
    bf16x8 At[4][2], B0[2][2], B1[2][2];
    const char* cA = cur.A; const char* cB = cur.B; int cpa = cur.pa, cpb = cur.pb;
    {
        const size_t hA = (size_t)HALF * cpa, hB = (size_t)HALF * cpb;
        PG8_STAGE(PG8_SB(0, 0), cB, cpb, RB); PG8_STAGE(PG8_SB(0, 1), cB + hB, cpb, RB); PG8_STAGE(PG8_SA(0, 0), cA, cpa, RA); PG8_STAGE(PG8_SA(0, 1), cA + hA, cpa, RA);
        if (wr == 1) PG8_BAR;
        PG8_WAIT_V(2); PG8_BAR;
        PG8_STAGE(PG8_SB(1, 0), cB + 128, cpb, RB); PG8_STAGE(PG8_SA(1, 0), cA + 128, cpa, RA); PG8_STAGE(PG8_SB(1, 1), cB + hB + 128, cpb, RB);
        PG8_WAIT_V(6); PG8_BAR;
    }
    for (;;) {
        const bool has_next = S.next(ui + 1, nxt);
        const char* nA = has_next ? nxt.A : cA; const char* nB = has_next ? nxt.B : cB; const int npa = has_next ? nxt.pa : cpa, npb = has_next ? nxt.pb : cpb;
        const int nt = cur.nt; const size_t hA = (size_t)HALF * cpa;
        for (int t = 0; t < nt; t += 2) {
            const bool last = (t == nt - 2);
            const char* a1 = cA + (size_t)(t + 1) * 128;
            const char* a2 = last ? nA : cA + (size_t)(t + 2) * 128; const char* b2 = last ? nB : cB + (size_t)(t + 2) * 128;
            const int pa2 = last ? npa : cpa, pb2 = last ? npb : cpb; const size_t hA2 = (size_t)HALF * pa2, hB2 = (size_t)HALF * pb2;
            const char* a3 = a2 + 128; const char* b3 = b2 + 128;
            PG8_LDB(B0, 0, 0); PG8_LDB(B1, 0, 1); PG8_SCHED; PG8_LDA(At, 0, 0); PG8_STAGE(PG8_SA(1, 1), a1 + hA, cpa, RA);
            PG8_WAIT_V(8); PG8_WAIT_L(0); PG8_BAR; PG8_MMA(0, 0, At, B0); PG8_MMA(0, 1, At, B1); PG8_BAR; PG8_SCHED;
            PG8_LDA(At, 0, 1); PG8_STAGE(PG8_SB(0, 0), b2, pb2, RB); PG8_STAGE(PG8_SB(0, 1), b2 + hB2, pb2, RB); PG8_STAGE(PG8_SA(0, 0), a2, pa2, RA);
            PG8_WAIT_V(8); PG8_WAIT_L(0); PG8_BAR; PG8_MMA(1, 0, At, B0); PG8_MMA(1, 1, At, B1); PG8_BAR; PG8_SCHED;
            PG8_LDB(B0, 1, 0); PG8_LDB(B1, 1, 1); PG8_SCHED; PG8_LDA(At, 1, 0); PG8_STAGE(PG8_SA(0, 1), a2 + hA2, pa2, RA);
            PG8_WAIT_V(8); PG8_WAIT_L(0); PG8_BAR; PG8_MMA(0, 0, At, B0); PG8_MMA(0, 1, At, B1); PG8_BAR; PG8_SCHED;
            PG8_LDA(At, 1, 1); PG8_STAGE(PG8_SB(1, 0), b3, pb2, RB); PG8_STAGE(PG8_SB(1, 1), b3 + hB2, pb2, RB); PG8_STAGE(PG8_SA(1, 0), a3, pa2, RA);
            PG8_WAIT_V(8); PG8_WAIT_L(0); PG8_BAR; PG8_MMA(1, 0, At, B0); PG8_MMA(1, 1, At, B1); PG8_BAR; PG8_SCHED;
        }
        if (wr == 0) PG8_BAR;
        if (Epi::TWICE) (void)E(acc, cur, wr, wc, fr, fq);
        const bool keep = E(acc, cur, wr, wc, fr, fq);
        if (!has_next) break;
        if (!keep) {
#pragma unroll
            for (int a = 0; a < 2; ++a)
#pragma unroll
                for (int b = 0; b < 2; ++b)
#pragma unroll
                    for (int m = 0; m < 4; ++m)
#pragma unroll
                        for (int n = 0; n < 2; ++n) acc[a][b][m][n] = (f32x4){0.f, 0.f, 0.f, 0.f};
        }
        cur = nxt; cA = nA; cB = nB; cpa = npa; cpb = npb; ++ui;
        if (wr == 1) PG8_BAR;
    }
    PG8_WAIT_V(0);
    PG8_BAR;
#undef PG8_SA
#undef PG8_SB
#undef PG8_STAGE
#undef PG8_LDA
#undef PG8_LDB
#undef PG8_MMA
#undef PG8_WAIT_V
#undef PG8_WAIT_L
#undef PG8_BAR
#undef PG8_SCHED
}
}
using pg8::Unit;

template <int NSUB> struct SchedRect {
    const char* A0; const char* B0; const char* A1; const char* B1; int pa0, nt0, pa1, nt1; int nM, nN, G, c;
    __device__ __forceinline__ bool next(int i, Unit& u) const {
        const int ti = i / NSUB, s = i % NSUB; int pm, pn;
        if (!pg8::rect_tile((long)ti * G + c, nM, nN, pm, pn)) return false;
        const int pa = (NSUB > 1 && s) ? pa1 : pa0;
        u.pa = pa; u.pb = pa; u.nt = (NSUB > 1 && s) ? nt1 : nt0; u.pm = pm; u.pn = pn; u.aux = s;
        u.A = ((NSUB > 1 && s) ? A1 : A0) + (size_t)pm * 256 * pa; u.B = ((NSUB > 1 && s) ? B1 : B0) + (size_t)pn * 256 * pa; return true;
    }
};

struct SchedMerge {
    const char* ws; int G, c;
    __device__ __forceinline__ bool next(int i, Unit& u) const {
        const int ti = i / 3, s = i % 3; int pm, pn;
        if (!pg8::rect_tile((long)ti * G + c, MT / 256, 4, pm, pn)) return false;
        u.pa = 1024; u.nt = 8; u.pm = pm; u.pn = pn; u.aux = s;
        if (s == 0) { u.A = ws + ATT_OFF + (size_t)pm * 256 * 1024; u.B = ws + WNA_OFF + (size_t)pn * 256 * 1024; u.pb = 1024; }
        else { u.A = ws + (s == 1 ? PB_OFF : QB_OFF) + (size_t)pm * 256 * 1024; u.B = ws + WFN_OFF + (size_t)pn * 256 * 2048 + (s == 2 ? 1024 : 0); u.pb = 2048; }
        return true;
    }
};
struct SchedDft {
    const char* ws; int G, c;
    __device__ __forceinline__ bool next(int i, Unit& u) const {
        const long L = (long)i * G + c; if (L >= 416) return false;
        int pm, b, pn;
        if (L < 272) {
            if (L < 256) { const int x = (int)L & 7, s = (int)L >> 3; pm = 8 * (x >> 2) + (s & 7); b = s >> 3; pn = x & 3; }
            else { const int e = (int)L - 256; pm = 16; b = e >> 2; pn = e & 3; }
            u.pa = KPP * 2; u.pb = KPP * 2; u.nt = KPP / 64;
            u.A = ws + (pn < 2 ? CP_OFF : SP_OFF) + (size_t)pm * 256 * KPP * 2;
            u.B = ws + (pn < 2 ? UE_OFF : UO_OFF) + ((size_t)b * 512 + (pn & 1) * 256) * KPP * 2;
        } else {
            const int l = (int)L - 272, x = l & 7, s = l >> 3; pn = x & 3; pm = s % 9; b = 4 + 2 * (s / 9) + (x >> 2);
            u.pa = KPS * 2; u.pb = KPS * 2; u.nt = KPS / 64;
            u.A = ws + (pn < 2 ? CS_OFF : SSM_OFF) + (size_t)pm * 256 * KPS * 2;
            u.B = ws + (pn < 2 ? UE_OFF : UO_OFF) + (size_t)4 * 512 * KPP * 2 + ((size_t)(b - 4) * 512 + (pn & 1) * 256) * KPS * 2;
        }
        u.pm = pm; u.pn = pn; u.aux = b; return true;
    }
};

__device__ __forceinline__ float sigmoidf_(float v) { return __builtin_amdgcn_rcpf(1.0f + __builtin_amdgcn_exp2f(-1.44269504f * v)); }
typedef f32x4 Acc[2][2][4][2];

struct EpiP1a {
    static constexpr bool PERM = true, TWICE = (EPI2 == 1);
    unsigned char* ws; float* gates;
    __device__ __forceinline__ bool operator()(Acc& acc, const Unit& u, int wr, int wc, int fr, int fq) const {
        asm volatile("" : "+v"(fr), "+v"(fq));
        const int row0 = u.pm * 256 + wr * 64 + fr;
        if (u.pn < 4) {
            bf16_t* base = (bf16_t*)(ws + (u.pn < 2 ? Q_OFF : K_OFF)); const int col0 = (u.pn & 1) * 256 + wc * 32 + 8 * fq;
#pragma unroll
            for (int ai = 0; ai < 2; ++ai)
#pragma unroll
                for (int m = 0; m < 4; ++m) { bf16_t* rowp = base + (size_t)(row0 + ai * 128 + m * 16) * 512 + col0;
#pragma unroll
                    for (int bj = 0; bj < 2; ++bj) { const f32x4 v0 = acc[ai][bj][m][0], v1 = acc[ai][bj][m][1];
                        u32x4 w; w.x = cvt_pk_bf16(v0[0], v0[1]); w.y = cvt_pk_bf16(v0[2], v0[3]); w.z = cvt_pk_bf16(v1[0], v1[1]); w.w = cvt_pk_bf16(v1[2], v1[3]);
                        *(u32x4*)(rowp + bj * 128) = w; } }
        } else {
            bf16_t* Rb = (bf16_t*)gates; bf16_t* Sb = Rb + (size_t)MT * 1024; const int col0 = (u.pn - 4) * 128 + wc * 32 + 8 * fq;
#pragma unroll
            for (int ai = 0; ai < 2; ++ai)
#pragma unroll
                for (int m = 0; m < 4; ++m) { const size_t off = (size_t)(row0 + ai * 128 + m * 16) * 1024 + col0; float rr[8], s2[8];
#pragma unroll
                    for (int n = 0; n < 2; ++n)
#pragma unroll
                        for (int e = 0; e < 4; ++e) { const float e1 = __builtin_amdgcn_exp2f(fminf(-1.44269504f * acc[ai][0][m][n][e], 60.f)), e2 = __builtin_amdgcn_exp2f(fminf(-1.44269504f * acc[ai][1][m][n][e], 60.f));
                            s2[4 * n + e] = __builtin_amdgcn_rcpf(1.0f + e2); rr[4 * n + e] = (1.0f + e2) * __builtin_amdgcn_rcpf(1.0f + e1); }
                    u32x4 w; w.x = cvt_pk_bf16(rr[0], rr[1]); w.y = cvt_pk_bf16(rr[2], rr[3]); w.z = cvt_pk_bf16(rr[4], rr[5]); w.w = cvt_pk_bf16(rr[6], rr[7]);
                    *(u32x4*)(Rb + off) = w;
                    w.x = cvt_pk_bf16(s2[0], s2[1]); w.y = cvt_pk_bf16(s2[2], s2[3]); w.z = cvt_pk_bf16(s2[4], s2[5]); w.w = cvt_pk_bf16(s2[6], s2[7]);
                    *(u32x4*)(Sb + off) = w; }
        }
        return false;
    }
};
struct EpiP1b {
    static constexpr bool PERM = false, TWICE = (EPI2 == 1);
    unsigned char* ws;
    __device__ __forceinline__ bool operator()(Acc& acc, const Unit& u, int wr, int wc, int fr, int fq) const {
        asm volatile("" : "+v"(fr), "+v"(fq));
        const int g0 = u.pm * 256; const int b = g0 < 4 * TP ? g0 / TP : 4 + (g0 - 4 * TP) / TS; const int gb = batch_base(b), T = b < 4 ? TP : TS, N = T + 16;
        bf16_t* base; size_t pitch; int coff;
        if (u.pn < 2) { base = (bf16_t*)(ws + VT_OFF) + (size_t)512 * gb; pitch = T; coff = u.pn * 256; }
        else { base = (bf16_t*)(ws + UT_OFF) + (b < 4 ? (size_t)b * 512 * NP : (size_t)4 * 512 * NP + (size_t)(b - 4) * 512 * NS) + 16; pitch = N; coff = (u.pn - 2) * 256; }
        const int t0 = g0 - gb + wr * 64 + 4 * fq, c0 = coff + wc * 32 + fr;
#pragma unroll
        for (int ai = 0; ai < 2; ++ai)
#pragma unroll
            for (int bj = 0; bj < 2; ++bj)
#pragma unroll
                for (int m = 0; m < 4; ++m)
#pragma unroll
                    for (int n = 0; n < 2; ++n) { const f32x4 v = acc[ai][bj][m][n]; u32x2 w; w.x = cvt_pk_bf16(v[0], v[1]); w.y = cvt_pk_bf16(v[2], v[3]);
                        *(u32x2*)(base + (size_t)(c0 + bj * 128 + n * 16) * pitch + t0 + ai * 128 + m * 16) = w; }
        return false;
    }
};
struct EpiDft {
    static constexpr bool PERM = true, TWICE = (EPI2 == 3);
    unsigned char* ws;
    __device__ __forceinline__ bool operator()(Acc& acc, const Unit& u, int wr, int wc, int fr, int fq) const {
        asm volatile("" : "+v"(fr), "+v"(fq));
        const int b = u.aux, gb = batch_base(b), N = (b < 4 ? TP : TS) + 16, HN = N / 2;
        bf16_t* base = (bf16_t*)(ws + (u.pn < 2 ? PB_OFF : QB_OFF)) + (size_t)gb * 512 + (u.pn & 1) * 256 + wc * 32 + 8 * fq;
        const float sg = u.pn >= 2 ? -1.f : 1.f;
#pragma unroll
        for (int ai = 0; ai < 2; ++ai)
#pragma unroll
            for (int m = 0; m < 4; ++m) { const int np = u.pm * 256 + ai * 128 + wr * 64 + m * 16 + fr + 1;
                if (np <= HN) {
#pragma unroll
                    for (int bj = 0; bj < 2; ++bj) { const f32x4 v0 = acc[ai][bj][m][0], v1 = acc[ai][bj][m][1];
                        if (np >= 16) { u32x4 w; w.x = cvt_pk_bf16(v0[0], v0[1]); w.y = cvt_pk_bf16(v0[2], v0[3]); w.z = cvt_pk_bf16(v1[0], v1[1]); w.w = cvt_pk_bf16(v1[2], v1[3]);
                            *(u32x4*)(base + (size_t)(np - 16) * 512 + bj * 128) = w; }
                        if (np != HN) { u32x4 w; w.x = cvt_pk_bf16(sg * v0[0], sg * v0[1]); w.y = cvt_pk_bf16(sg * v0[2], sg * v0[3]); w.z = cvt_pk_bf16(sg * v1[0], sg * v1[1]); w.w = cvt_pk_bf16(sg * v1[2], sg * v1[3]);
                            *(u32x4*)(base + (size_t)(N - np - 16) * 512 + bj * 128) = w; } } } }
        return false;
    }
};
struct EpiMerge {
    static constexpr bool PERM = true, TWICE = false;
    unsigned char* ws; const float* gates;
    __device__ __forceinline__ bool operator()(Acc& acc, const Unit& u, int wr, int wc, int fr, int fq) const {
        if (u.aux == 1) return true;
        asm volatile("" : "+v"(fr), "+v"(fq));
        const bf16_t* Gs = (const bf16_t*)gates + (u.aux == 0 ? (size_t)0 : (size_t)MT * 1024);
        const int row0 = u.pm * 256 + wr * 64 + fr, col0 = u.pn * 256 + wc * 32 + 8 * fq;
        bf16_t* mix = (bf16_t*)(ws + MIX_OFF);
        u32x4 g2[4][2];
#pragma unroll
        for (int q = 0; q < 3; ++q)
#pragma unroll
            for (int bj = 0; bj < 2; ++bj) g2[q][bj] = *(const u32x4*)(Gs + (size_t)(row0 + q * 16) * 1024 + col0 + bj * 128);
#pragma unroll
        for (int idx = 0; idx < 8; ++idx) { const int ai = idx >> 2, m = idx & 3; const size_t off = (size_t)(row0 + ai * 128 + m * 16) * 1024 + col0;
            if (idx < 5) { const int ai2 = (idx + 3) >> 2, m2 = (idx + 3) & 3; const size_t off2 = (size_t)(row0 + ai2 * 128 + m2 * 16) * 1024 + col0;
#pragma unroll
                for (int bj = 0; bj < 2; ++bj) g2[(idx + 3) & 3][bj] = *(const u32x4*)(Gs + off2 + bj * 128); }
#pragma unroll
            for (int bj = 0; bj < 2; ++bj) { const u32x4 w2 = g2[idx & 3][bj];
                const float sc[8] = {bf_lo(w2.x), bf_hi(w2.x), bf_lo(w2.y), bf_hi(w2.y), bf_lo(w2.z), bf_hi(w2.z), bf_lo(w2.w), bf_hi(w2.w)};
#pragma unroll
                for (int e = 0; e < 4; ++e) { acc[ai][bj][m][0][e] *= sc[e]; acc[ai][bj][m][1][e] *= sc[4 + e]; }
                if (u.aux == 2) { const f32x4 v0 = acc[ai][bj][m][0], v1 = acc[ai][bj][m][1]; u32x4 w;
                    w.x = cvt_pk_bf16(v0[0], v0[1]); w.y = cvt_pk_bf16(v0[2], v0[3]); w.z = cvt_pk_bf16(v1[0], v1[1]); w.w = cvt_pk_bf16(v1[2], v1[3]);
                    *(u32x4*)(mix + off + bj * 128) = w; } } }
        return u.aux == 0;
    }
};
struct EpiRes5 {
    static constexpr bool PERM = true, TWICE = false;
    const float* bp; const float* bs; bf16_t* ob; float* ss;
    __device__ __forceinline__ bool operator()(Acc& acc, const Unit& u, int wr, int wc, int fr, int fq) const {
        asm volatile("" : "+v"(fr), "+v"(fq));
        const int g0 = u.pm * 256; const float* base = g0 < 4 * TP ? bp + (size_t)g0 * 1024 : bs + (size_t)(g0 - 4 * TP) * 1024;
        const int lr0 = wr * 64 + fr, col0 = u.pn * 256 + wc * 32 + 8 * fq;
        f32x4 pre[3][2][2];
#pragma unroll
        for (int q = 0; q < 2; ++q)
#pragma unroll
            for (int bj = 0; bj < 2; ++bj)
#pragma unroll
                for (int n = 0; n < 2; ++n) pre[q][bj][n] = *(const f32x4*)(base + (size_t)(lr0 + q * 16) * 1024 + col0 + bj * 128 + n * 4);
#pragma unroll
        for (int idx = 0; idx < 8; ++idx) { const int ai = idx >> 2, m = idx & 3; const int lr = lr0 + ai * 128 + m * 16; float s = 0.f;
            if (idx < 6) { const int lr2 = lr0 + ((idx + 2) >> 2) * 128 + ((idx + 2) & 3) * 16;
#pragma unroll
                for (int bj = 0; bj < 2; ++bj)
#pragma unroll
                    for (int n = 0; n < 2; ++n) pre[(idx + 2) % 3][bj][n] = *(const f32x4*)(base + (size_t)lr2 * 1024 + col0 + bj * 128 + n * 4); }
#pragma unroll
            for (int bj = 0; bj < 2; ++bj) { const f32x4 o0 = pre[idx % 3][bj][0] + acc[ai][bj][m][0], o1 = pre[idx % 3][bj][1] + acc[ai][bj][m][1];
                s += ((o0[0] * o0[0] + o0[1] * o0[1]) + (o0[2] * o0[2] + o0[3] * o0[3])) + ((o1[0] * o1[0] + o1[1] * o1[1]) + (o1[2] * o1[2] + o1[3] * o1[3]));
                u32x4 w; w.x = cvt_pk_bf16(o0[0], o0[1]); w.y = cvt_pk_bf16(o0[2], o0[3]); w.z = cvt_pk_bf16(o1[0], o1[1]); w.w = cvt_pk_bf16(o1[2], o1[3]);
                *(u32x4*)(ob + (size_t)(g0 + lr) * 1024 + col0 + bj * 128) = w; }
            s += __shfl_xor(s, 16); s += __shfl_xor(s, 32);
            if (fq == 0) atomicAdd(ss + g0 + lr, s); }
        return false;
    }
};
struct EpiRes7 {
    static constexpr bool PERM = true, TWICE = false;
    bf16_t* xb; float* ss;
    __device__ __forceinline__ bool operator()(Acc& acc, const Unit& u, int wr, int wc, int fr, int fq) const {
        asm volatile("" : "+v"(fr), "+v"(fq));
        const int row0 = u.pm * 256 + wr * 64 + fr, col0 = u.pn * 256 + wc * 32 + 8 * fq;
        u32x4 pre[4][2];
#pragma unroll
        for (int q = 0; q < 3; ++q)
#pragma unroll
            for (int bj = 0; bj < 2; ++bj) pre[q][bj] = *(const u32x4*)(xb + (size_t)(row0 + q * 16) * 1024 + col0 + bj * 128);
#pragma unroll
        for (int idx = 0; idx < 8; ++idx) { const int ai = idx >> 2, m = idx & 3; const int row = row0 + ai * 128 + m * 16; float s = 0.f;
            if (idx < 5) { const int row2 = row0 + ((idx + 3) >> 2) * 128 + ((idx + 3) & 3) * 16;
#pragma unroll
                for (int bj = 0; bj < 2; ++bj) pre[(idx + 3) & 3][bj] = *(const u32x4*)(xb + (size_t)row2 * 1024 + col0 + bj * 128); }
#pragma unroll
            for (int bj = 0; bj < 2; ++bj) { const u32x4 b = pre[idx & 3][bj]; const f32x4 a0 = acc[ai][bj][m][0], a1 = acc[ai][bj][m][1];
                const float o[8] = {bf_lo(b.x) + a0[0], bf_hi(b.x) + a0[1], bf_lo(b.y) + a0[2], bf_hi(b.y) + a0[3], bf_lo(b.z) + a1[0], bf_hi(b.z) + a1[1], bf_lo(b.w) + a1[2], bf_hi(b.w) + a1[3]};
#pragma unroll
                for (int e = 0; e < 8; ++e) s += o[e] * o[e];
                u32x4 w; w.x = cvt_pk_bf16(o[0], o[1]); w.y = cvt_pk_bf16(o[2], o[3]); w.z = cvt_pk_bf16(o[4], o[5]); w.w = cvt_pk_bf16(o[6], o[7]);
                *(u32x4*)(xb + (size_t)row * 1024 + col0 + bj * 128) = w; }
            s += __shfl_xor(s, 16); s += __shfl_xor(s, 32);
            if (fq == 0) atomicAdd(ss + row, s); }
        return false;
    }
};
struct EpiUp {
    static constexpr bool PERM = true, TWICE = (EPI2 == 6);
    bf16_t* H; const float* ss;
    __device__ __forceinline__ bool operator()(Acc& acc, const Unit& u, int wr, int wc, int fr, int fq) const {
        asm volatile("" : "+v"(fr), "+v"(fq));
        const int row0 = u.pm * 256 + wr * 64 + fr, col0 = u.pn * 256 + wc * 32 + 8 * fq;
        float rv[8];
#pragma unroll
        for (int idx = 0; idx < 8; ++idx) rv[idx] = ss[row0 + (idx >> 2) * 128 + (idx & 3) * 16];
#pragma unroll
        for (int ai = 0; ai < 2; ++ai)
#pragma unroll
            for (int m = 0; m < 4; ++m) { const int row = row0 + ai * 128 + m * 16; const float rinv = rsqrtf(rv[ai * 4 + m] * (1.0f / 1024.0f) + RMS_EPS);
#pragma unroll
                for (int bj = 0; bj < 2; ++bj) { f32x4 v0 = acc[ai][bj][m][0], v1 = acc[ai][bj][m][1];
#pragma unroll
                    for (int e = 0; e < 4; ++e) { const float a = fmaxf(v0[e] * rinv, 0.f), b = fmaxf(v1[e] * rinv, 0.f); v0[e] = a * a; v1[e] = b * b; }
                    u32x4 w; w.x = cvt_pk_bf16(v0[0], v0[1]); w.y = cvt_pk_bf16(v0[2], v0[3]); w.z = cvt_pk_bf16(v1[0], v1[1]); w.w = cvt_pk_bf16(v1[2], v1[3]);
                    *(u32x4*)(H + (size_t)row * 4096 + col0 + bj * 128) = w; } }
        return false;
    }
};

__device__ __forceinline__ void p0_transpose_item(const float* W, int K, int N, bf16_t* WT, int out_row0, int n0, int k0, const float* sc, float mul, LAS float* scr, int lane) {
    float tv[32];
#pragma unroll
    for (int i = 0; i < 32; ++i) { const int kk = 2 * i + (lane >> 5); tv[i] = W[(size_t)(k0 + kk) * N + n0 + (lane & 31)]; }
#pragma unroll
    for (int i = 0; i < 32; ++i) { const int kk = 2 * i + (lane >> 5); const float s = sc ? sc[k0 + kk] * mul : mul; scr[kk * 33 + (lane & 31)] = tv[i] * s; }
    asm volatile("s_waitcnt lgkmcnt(0)" ::: "memory");
    const int c = lane & 7;
#pragma unroll
    for (int j = 0; j < 4; ++j) { const int n = (lane >> 3) + 8 * j; const LAS float* s = scr + (8 * c) * 33 + n;
        u32x4 o; o.x = cvt_pk_bf16(s[0 * 33], s[1 * 33]); o.y = cvt_pk_bf16(s[2 * 33], s[3 * 33]); o.z = cvt_pk_bf16(s[4 * 33], s[5 * 33]); o.w = cvt_pk_bf16(s[6 * 33], s[7 * 33]);
        *(u32x4*)(WT + (size_t)(out_row0 + n) * K + k0 + 8 * c) = o; }
    asm volatile("s_waitcnt lgkmcnt(0)" ::: "memory");
}

template <int PART> __device__ __forceinline__ void p0_prologue(const Params& p, LAS unsigned char* lds, int bx, int G) {
    const int tid = threadIdx.x, lane = tid & 63, wid = tid >> 6;
    const int gw = bx * 8 + wid, NGW = G * 8, gt = bx * 512 + tid, NGT = G * 512;
    unsigned char* ws = p.ws;
    if (PART == 0) for (int i = gt; i < MT; i += NGT) { ((float*)(ws + SS1_OFF))[i] = 0.f; ((float*)(ws + SS2_OFF))[i] = 0.f; }
    for (int r0_ = 0; r0_ < (P0REP == 0 ? 2 : 1); ++r0_)
    if (PART == 0 && bx < 24) {
        LAS float* hm = (LAS float*)lds;
        LAS float* red = (LAS float*)(lds + 65536);
        for (int r = wid * 2; r < wid * 2 + 2; ++r) { float v[16]; float s = 0.f;
#pragma unroll
            for (int j = 0; j < 16; ++j) { v[j] = p.meta[r * 1024 + lane + 64 * j]; s += v[j] * v[j]; }
            const float rinv = rsqrtf(wave_sum(s) * (1.0f / 1024.0f) + RMS_EPS);
#pragma unroll
            for (int j = 0; j < 16; ++j) hm[r * 1024 + lane + 64 * j] = v[j] * rinv * p.g_mix[lane + 64 * j]; }
        __syncthreads();
        const int n = 512 + bx * 64 + lane; float a[16];
#pragma unroll
        for (int r = 0; r < 16; ++r) a[r] = 0.f;
        for (int k0 = wid * 128; k0 < wid * 128 + 128; k0 += 16) { float w[16];
#pragma unroll
            for (int q = 0; q < 16; ++q) w[q] = p.w_in[(size_t)(k0 + q) * 4096 + n];
#pragma unroll
            for (int q = 0; q < 16; ++q)
#pragma unroll
                for (int r = 0; r < 16; ++r) a[r] += hm[r * 1024 + k0 + q] * w[q]; }
#pragma unroll
        for (int r = 0; r < 16; ++r) red[(wid * 16 + r) * 64 + lane] = a[r];
        __syncthreads();
        for (int o = tid; o < 1024; o += 512) { const int r = o >> 6, l = o & 63; float s = 0.f;
#pragma unroll
            for (int w = 0; w < 8; ++w) s += red[(w * 16 + r) * 64 + l];
            const int nn = 512 + bx * 64 + l; const bf16_t hv = (bf16_t)(cvt_pk_bf16(s, 0.f) & 0xffffu);
            if (nn < 1024) ((bf16_t*)(ws + KMETA_OFF))[r * 512 + nn - 512] = hv;
            else if (nn < 1536) ((bf16_t*)(ws + VMETAT_OFF))[(nn - 1024) * 16 + r] = hv;
            else { const int ch = nn - 1536;
                for (int b = 0; b < 8; ++b) { bf16_t* ut = (bf16_t*)(ws + UT_OFF) + (b < 4 ? (size_t)b * 512 * NP + (size_t)ch * NP : (size_t)4 * 512 * NP + (size_t)(b - 4) * 512 * NS + (size_t)ch * NS); ut[r] = hv; } } }
        __syncthreads();
    }
    for (int r1_ = 0; r1_ < (P0REP == 1 ? 2 : 1); ++r1_)
    if (PART == 0 || PART == 2) {
        LAS float* scr = (LAS float*)(lds + wid * 8448);
        constexpr int I_IN = 16 * 128, I_UP = 16 * 128, I_DN = 64 * 32, I_OUT = 16 * 32, I_NA = 8 * 32, NIT = I_IN + I_UP + I_DN + I_OUT + I_NA;
        for (int it = (PART == 0 ? 0 : I_IN) + gw; it < (PART == 0 ? I_IN : NIT); it += NGW) {
            int r = it;
            if (r < I_IN) { const int kb = r / 128, nb = r % 128, n0 = nb * 32; bf16_t* dst; int orow; float mul = 1.f;
                if (n0 < 512) { dst = (bf16_t*)(ws + WINA_OFF); orow = n0; mul = 0.125f; } else if (n0 < 1024) { dst = (bf16_t*)(ws + WINA_OFF); orow = n0; }
                else if (n0 < 2048) { dst = (bf16_t*)(ws + WINB_OFF); orow = n0 - 1024; }
                else { const int isfn = n0 >= 3072, gc = n0 - (isfn ? 3072 : 2048); dst = (bf16_t*)(ws + WINA_OFF); orow = 1024 + 256 * (gc >> 7) + 128 * isfn + (gc & 127); }
                p0_transpose_item(p.w_in, 1024, 4096, dst, orow, n0, kb * 64, p.g_mix, mul, scr, lane); continue; } r -= I_IN;
            if (r < I_UP) { const int kb = r / 128, nb = r % 128; p0_transpose_item(p.w_up, 1024, 4096, (bf16_t*)(ws + WUP_OFF), nb * 32, nb * 32, kb * 64, p.g_mlp, 1.f, scr, lane); continue; } r -= I_UP;
            if (r < I_DN) { const int kb = r / 32, nb = r % 32; p0_transpose_item(p.w_down, 4096, 1024, (bf16_t*)(ws + WDN_OFF), nb * 32, nb * 32, kb * 64, nullptr, 1.f, scr, lane); continue; } r -= I_DN;
            if (r < I_OUT) { const int kb = r / 32, nb = r % 32; p0_transpose_item(p.w_out, 1024, 1024, (bf16_t*)(ws + WOUT_OFF), nb * 32, nb * 32, kb * 64, nullptr, 1.f, scr, lane); continue; } r -= I_OUT;
            { const int kb = r / 32, nb = r % 32; p0_transpose_item(p.w_na, 512, 1024, (bf16_t*)(ws + WNA_OFF), nb * 32, nb * 32, kb * 64, nullptr, 1.f, scr, lane); }
        }
    }
    for (int r2_ = 0; r2_ < (P0REP == 2 ? 2 : 1); ++r2_)
    if (PART == 2) for (int tw = gw; tw < 64 * 4 * 2; tw += NGW) {
        const int twu = __builtin_amdgcn_readfirstlane(tw); const int c = (twu & 1) * 64 + lane, g = (twu >> 1) & 3, d0 = (twu >> 3) * 16;
        float ac[16], as[16];
#pragma unroll
        for (int q = 0; q < 16; ++q) { ac[q] = 0.f; as[q] = 0.f; }
        const float* wf = p.w_fn + (size_t)g * 128 * 1024 + d0;
#pragma unroll 2
        for (int cp = 0; cp < 128; ++cp) { const float tr = (float)((c * cp) & 127) * (1.0f / 128.0f); const float co = __builtin_amdgcn_cosf(tr), si = __builtin_amdgcn_sinf(tr);
            f32x4 w[4];
#pragma unroll
            for (int q = 0; q < 4; ++q) w[q] = *(const __attribute__((address_space(4))) f32x4*)(unsigned long long)(wf + (size_t)cp * 1024 + 4 * q);
#pragma unroll
            for (int q = 0; q < 16; ++q) { ac[q] += co * w[q >> 2][q & 3]; as[q] -= si * w[q >> 2][q & 3]; } }
        bf16_t* o = (bf16_t*)(ws + WFN_OFF) + (size_t)d0 * 1024 + g * 128 + c;
#pragma unroll
        for (int q = 0; q < 16; ++q) { o[(size_t)q * 1024] = (bf16_t)(cvt_pk_bf16(ac[q], 0.f) & 0xffffu); o[(size_t)q * 1024 + 512] = (bf16_t)(cvt_pk_bf16(as[q], 0.f) & 0xffffu); } }
    for (int r3_ = 0; r3_ < (P0REP == 3 ? 2 : 1); ++r3_)
    if (PART == 1) {
        constexpr int IP = MRP * (KPP / 8), IS = MRS * (KPS / 8);
        for (int it = gt; it < IP + IS; it += NGT) {
            int i, j, N, KP; bf16_t* cm; bf16_t* sm;
            if (it < IP) { i = it / (KPP / 8); j = it % (KPP / 8); N = NP; KP = KPP; cm = (bf16_t*)(ws + CP_OFF); sm = (bf16_t*)(ws + SP_OFF); }
            else { const int q = it - IP; i = q / (KPS / 8); j = q % (KPS / 8); N = NS; KP = KPS; cm = (bf16_t*)(ws + CS_OFF); sm = (bf16_t*)(ws + SSM_OFF); }
            const int np = i + 1, HN = N / 2; const float norm = rsqrtf(128.0f * (float)N), invN = 1.0f / (float)N;
            float cv[8], sv[8]; int mm; { const unsigned prod = (unsigned)np * (unsigned)(8 * j); unsigned q = (unsigned)((float)prod * invN); if (q > 0) --q; mm = (int)(prod - q * (unsigned)N); while (mm >= N) mm -= N; }
#pragma unroll
            for (int e = 0; e < 8; ++e) { const int k = 8 * j + e; const bool ok = (np <= HN) && (k <= HN); const float tr = (float)mm * invN;
                cv[e] = ok ? __builtin_amdgcn_cosf(tr) * norm : 0.f; sv[e] = ok ? __builtin_amdgcn_sinf(tr) * norm : 0.f; mm += np; if (mm >= N) mm -= N; }
            u32x4 wc_, ws_; wc_.x = cvt_pk_bf16(cv[0], cv[1]); wc_.y = cvt_pk_bf16(cv[2], cv[3]); wc_.z = cvt_pk_bf16(cv[4], cv[5]); wc_.w = cvt_pk_bf16(cv[6], cv[7]);
            ws_.x = cvt_pk_bf16(sv[0], sv[1]); ws_.y = cvt_pk_bf16(sv[2], sv[3]); ws_.z = cvt_pk_bf16(sv[4], sv[5]); ws_.w = cvt_pk_bf16(sv[6], sv[7]);
            *(u32x4*)(cm + (size_t)i * KP + 8 * j) = wc_; *(u32x4*)(sm + (size_t)i * KP + 8 * j) = ws_;
        }
    }
    if (PART == 0) {
        constexpr int NCH = MT / 4;
        const bool uneven = (G == 256); const int nm = 24 * 8, nn = 256 * 8 - nm;
        for (int itx = 0; ; ++itx) {
            int chunk;
            if (!uneven) chunk = gw + itx * NGW;
            else if (bx >= 24) { const int wp = gw - nm; chunk = itx < 6 ? itx * nn + wp : (itx == 6 && wp < NCH - 6 * nn - 4 * nm ? 6 * nn + 4 * nm + wp : NCH); }
            else chunk = itx < 4 ? 6 * nn + gw * 4 + itx : NCH;
            if (chunk >= NCH) break;
            f32x4 v[4][4];
#pragma unroll
            for (int q = 0; q < 4; ++q) { const int g = chunk * 4 + q; const float* xr = g < 4 * TP ? p.xp + (size_t)g * 1024 : p.xs + (size_t)(g - 4 * TP) * 1024;
#pragma unroll
                for (int j = 0; j < 4; ++j) v[q][j] = ((const f32x4*)xr)[lane + 64 * j]; }
#pragma unroll
            for (int q = 0; q < 4; ++q) { const int g = chunk * 4 + q; float s = 0.f;
#pragma unroll
                for (int j = 0; j < 4; ++j) s += (v[q][j][0] * v[q][j][0] + v[q][j][1] * v[q][j][1]) + (v[q][j][2] * v[q][j][2] + v[q][j][3] * v[q][j][3]);
                const float rinv = rsqrtf(wave_sum(s) * (1.0f / 1024.0f) + RMS_EPS);
                u32x2* o = (u32x2*)((bf16_t*)(ws + XB_OFF) + (size_t)g * 1024);
#pragma unroll
                for (int j = 0; j < 4; ++j) { u32x2 w; w.x = cvt_pk_bf16(v[q][j][0] * rinv, v[q][j][1] * rinv); w.y = cvt_pk_bf16(v[q][j][2] * rinv, v[q][j][3] * rinv); o[lane + 64 * j] = w; } }
        }
    }
}

constexpr int A_KS = 0, A_VS = 73728, A_KM = 147456, A_VM = 149504, A_BS = 151552, A_MB = 155392;
__device__ __forceinline__ void attn_units(const Params& p, LAS unsigned char* lds, const int u_lo, const int u_hi) {
    const int tid = threadIdx.x, lane = tid & 63, wid = __builtin_amdgcn_readfirstlane(tid >> 6), G = gridDim.x, bx = blockIdx.x;
    const int li = lane & 15, g = lane >> 4;
    unsigned char* ws = p.ws;
    const bf16_t* Qb = (const bf16_t*)(ws + Q_OFF); const bf16_t* Kb = (const bf16_t*)(ws + K_OFF); const bf16_t* VT = (const bf16_t*)(ws + VT_OFF);
    bf16_t* att = (bf16_t*)(ws + ATT_OFF);
    int pb = -1, ph = -1, hiR = -1;
    const int sr = tid >> 3, sch = tid & 7;
    u32x4 pf[4]; int pfn = 0, pfR0 = 0;
    for (int un = u_lo; un < u_hi; ++un) {
        int b, h, rp, rows;
        if (un < 2048) { b = un >> 9; h = (un >> 6) & 7; rp = un & 63; rows = 128; } else { const int v = un - 2048; b = 4 + (v >> 8); h = (v >> 5) & 7; rp = v & 31; rows = 64; }
        const int gb = batch_base(b), T = rows * 64, r0 = 2 * rp;
        const int rsA = min(max(r0 - 4, 0), rows - 8), needHi = min(rsA + 8, rows - 1);
        if (b != pb || h != ph) {
            __syncthreads();
            { u32x4 kvv[9], vvv[9];
#pragma unroll
              for (int j = 0; j < 9; ++j) { const int R = min(rsA + j, needHi);
                kvv[j] = *(const u32x4*)(Kb + (size_t)(gb + R * 64 + sr) * 512 + h * 64 + sch * 8);
                vvv[j] = *(const u32x4*)(VT + (size_t)512 * gb + (size_t)(h * 64 + sr) * T + R * 64 + sch * 8); }
#pragma unroll
              for (int j = 0; j < 9; ++j) { const int sl = min(rsA + j, needHi) % 9;
                *(LAS u32x4*)(lds + A_KS + sl * 8192 + sr * 128 + ((sch ^ (sr & 7)) * 16)) = kvv[j];
                *(LAS u32x4*)(lds + A_VS + sl * 8192 + sr * 128 + ((sch ^ ((sr >> 1) & 7)) * 16)) = vvv[j]; } }
            if (tid < 128) { const int r = tid >> 3, ch = tid & 7; *(LAS u32x4*)(lds + A_KM + r * 128 + ((ch ^ (r & 7)) * 16)) = *(const u32x4*)((const bf16_t*)(ws + KMETA_OFF) + r * 512 + h * 64 + ch * 8); }
            else if (tid < 256) { const int q = tid - 128; *(LAS u32x4*)(lds + A_VM + q * 16) = *(const u32x4*)((const bf16_t*)(ws + VMETAT_OFF) + h * 64 * 16 + q * 8); }
            for (int i = tid; i < 15 * 64; i += 512) { const int ro = i >> 6, x = (i & 63) - 16; ((LAS float*)(lds + A_BS))[i] = (x >= 0 && x <= 30) ? p.rel_bias[(h * 15 + ro) * 31 + x] : 0.f; }
            if (tid < 16) ((LAS float*)(lds + A_MB))[tid] = p.meta_bias[h * 16 + tid];
            pb = b; ph = h; hiR = needHi;
        } else {
#pragma unroll
            for (int j = 0; j < 2; ++j) if (j < pfn) { const int sl = (pfR0 + j) % 9;
                *(LAS u32x4*)(lds + A_KS + sl * 8192 + sr * 128 + ((sch ^ (sr & 7)) * 16)) = pf[2 * j];
                *(LAS u32x4*)(lds + A_VS + sl * 8192 + sr * 128 + ((sch ^ ((sr >> 1) & 7)) * 16)) = pf[2 * j + 1]; }
            hiR = needHi;
        }
        __syncthreads();
        pfn = 0;
        if (un + 1 < u_hi) { const int un2 = un + 1; int b2, h2, rp2;
            if (un2 < 2048) { b2 = un2 >> 9; h2 = (un2 >> 6) & 7; rp2 = un2 & 63; } else { const int v = un2 - 2048; b2 = 4 + (v >> 8); h2 = (v >> 5) & 7; rp2 = v & 31; }
            if (b2 == b && h2 == h) { const int rsA2 = min(max(2 * rp2 - 4, 0), rows - 8), nh2 = min(rsA2 + 8, rows - 1); pfR0 = hiR + 1; pfn = nh2 - hiR;
#pragma unroll
                for (int j = 0; j < 2; ++j) if (j < pfn) { const int R = pfR0 + j;
                    pf[2 * j] = *(const u32x4*)(Kb + (size_t)(gb + R * 64 + sr) * 512 + h * 64 + sch * 8);
                    pf[2 * j + 1] = *(const u32x4*)(VT + (size_t)512 * gb + (size_t)(h * 64 + sr) * T + R * 64 + sch * 8); } } }
        const int r = r0 + (wid >> 2), c0 = 16 * (wid & 3), kc0 = min(max(c0 - 8, 0), 32);
        const int rs = min(max(r - 4, 0), rows - 8);
        int slot[8];
        { const int s0 = rs % 9;
#pragma unroll
          for (int w = 0; w < 8; ++w) slot[w] = (s0 + w >= 9) ? s0 + w - 9 : s0 + w; }
        const int c = c0 + li, cs = min(max(c - 8, 0), 48);
        const size_t qrow = (size_t)(gb + r * 64 + c);
        bf16x8 qf[2];
        qf[0] = *(const bf16x8*)(Qb + qrow * 512 + h * 64 + 8 * g); qf[1] = *(const bf16x8*)(Qb + qrow * 512 + h * 64 + 32 + 8 * g);
        f32x4 sa[8][2]; f32x4 sm_;
        {
            const int kr0 = kc0 + li;
#pragma unroll
            for (int w = 0; w < 8; ++w)
#pragma unroll
                for (int j = 0; j < 2; ++j) { const int kr = kr0 + 16 * j; const LAS unsigned char* rowp = lds + A_KS + slot[w] * 8192 + kr * 128;
                    const bf16x8 a0 = *(const LAS bf16x8*)(rowp + ((g ^ (kr & 7)) * 16)), a1 = *(const LAS bf16x8*)(rowp + (((g + 4) ^ (kr & 7)) * 16));
                    f32x4 z = (f32x4){0.f, 0.f, 0.f, 0.f};
                    z = __builtin_amdgcn_mfma_f32_16x16x32_bf16(a0, qf[0], z, 0, 0, 0); sa[w][j] = __builtin_amdgcn_mfma_f32_16x16x32_bf16(a1, qf[1], z, 0, 0, 0); }
            const LAS unsigned char* rowp = lds + A_KM + li * 128;
            const bf16x8 a0 = *(const LAS bf16x8*)(rowp + ((g ^ (li & 7)) * 16)), a1 = *(const LAS bf16x8*)(rowp + (((g + 4) ^ (li & 7)) * 16));
            f32x4 z = (f32x4){0.f, 0.f, 0.f, 0.f};
            z = __builtin_amdgcn_mfma_f32_16x16x32_bf16(a0, qf[0], z, 0, 0, 0); sm_ = __builtin_amdgcn_mfma_f32_16x16x32_bf16(a1, qf[1], z, 0, 0, 0);
        }
        const int dl = kc0 + 4 * g - cs;
        const LAS float* bsp = (const LAS float*)(lds + A_BS) + (rs - r + 7) * 64 + (kc0 + 4 * g - c + 31);
        float mx = -1e30f;
#pragma unroll
        for (int w = 0; w < 8; ++w)
#pragma unroll
            for (int j = 0; j < 2; ++j)
#pragma unroll
                for (int e = 0; e < 4; ++e) { const bool ok = (unsigned)(dl + 16 * j + e) < 16u; const float bv = bsp[w * 64 + 16 * j + e];
                    float sv = sa[w][j][e] + bv; sv = ok ? sv : -1e30f; sa[w][j][e] = sv; mx = fmaxf(mx, sv); }
#pragma unroll
        for (int e = 0; e < 4; ++e) { sm_[e] += ((const LAS float*)(lds + A_MB))[4 * g + e]; mx = fmaxf(mx, sm_[e]); }
        mx = fmaxf(mx, __shfl_xor(mx, 16)); mx = fmaxf(mx, __shfl_xor(mx, 32));
        const float mxl = mx * 1.44269504f; float sum = 0.f;
#pragma unroll
        for (int w = 0; w < 8; ++w)
#pragma unroll
            for (int j = 0; j < 2; ++j)
#pragma unroll
                for (int e = 0; e < 4; ++e) { const float pe = __builtin_amdgcn_exp2f(sa[w][j][e] * 1.44269504f - mxl); sa[w][j][e] = pe; sum += pe; }
#pragma unroll
        for (int e = 0; e < 4; ++e) { const float pe = __builtin_amdgcn_exp2f(sm_[e] * 1.44269504f - mxl); sm_[e] = pe; sum += pe; }
        sum += __shfl_xor(sum, 16); sum += __shfl_xor(sum, 32);
        const float rsum = 1.0f / sum;
        f32x4 o[4];
#pragma unroll
        for (int dt = 0; dt < 4; ++dt) o[dt] = (f32x4){0.f, 0.f, 0.f, 0.f};
        const int c8 = (kc0 >> 2) + g;
#pragma unroll
        for (int w = 0; w < 8; ++w) { u32x4 pw; pw.x = cvt_pk_bf16(sa[w][0][0], sa[w][0][1]); pw.y = cvt_pk_bf16(sa[w][0][2], sa[w][0][3]); pw.z = cvt_pk_bf16(sa[w][1][0], sa[w][1][1]); pw.w = cvt_pk_bf16(sa[w][1][2], sa[w][1][3]);
            const bf16x8 pbv = __builtin_bit_cast(bf16x8, pw);
#pragma unroll
            for (int dt = 0; dt < 4; ++dt) { const int d = 16 * dt + li, sw = 2 * ((d >> 1) & 7); const LAS unsigned char* rowp = lds + A_VS + slot[w] * 8192 + d * 128;
                const u32x2 lo = *(const LAS u32x2*)(rowp + ((c8 ^ sw) * 8)), hi = *(const LAS u32x2*)(rowp + (((c8 + 4) ^ sw) * 8));
                u32x4 av; av.x = lo.x; av.y = lo.y; av.z = hi.x; av.w = hi.y;
                o[dt] = __builtin_amdgcn_mfma_f32_16x16x32_bf16(__builtin_bit_cast(bf16x8, av), pbv, o[dt], 0, 0, 0); } }
        { u32x4 pw; pw.x = cvt_pk_bf16(sm_[0], sm_[1]); pw.y = cvt_pk_bf16(sm_[2], sm_[3]); pw.z = 0u; pw.w = 0u; const bf16x8 pbv = __builtin_bit_cast(bf16x8, pw);
#pragma unroll
            for (int dt = 0; dt < 4; ++dt) { const int d = 16 * dt + li; const u32x2 lo = *(const LAS u32x2*)(lds + A_VM + d * 32 + g * 8);
                u32x4 av; av.x = lo.x; av.y = lo.y; av.z = 0u; av.w = 0u;
                o[dt] = __builtin_amdgcn_mfma_f32_16x16x32_bf16(__builtin_bit_cast(bf16x8, av), pbv, o[dt], 0, 0, 0); } }
#pragma unroll
        for (int dt = 0; dt < 4; ++dt) { u32x2 w; w.x = cvt_pk_bf16(o[dt][0] * rsum, o[dt][1] * rsum); w.y = cvt_pk_bf16(o[dt][2] * rsum, o[dt][3] * rsum);
            *(u32x2*)(att + qrow * 512 + h * 64 + 16 * dt + 4 * g) = w; }
        __syncthreads();
    }
}
__device__ __forceinline__ void dft_prep(const Params& p) {
    const int tid = threadIdx.x, G = gridDim.x, bx = blockIdx.x; unsigned char* ws = p.ws;
    {
        const int gt = bx * 512 + tid, NGT = G * 512;
        constexpr int IPP = 4 * 512 * (KPP / 8), IPS = 4 * 512 * (KPS / 8);
        for (int it = gt; it < IPP + IPS; it += NGT) {
            int b, ch, j, N, KP; size_t ub, eb;
            if (it < IPP) { b = it / (512 * (KPP / 8)); const int q = it % (512 * (KPP / 8)); ch = q / (KPP / 8); j = q % (KPP / 8); N = NP; KP = KPP; ub = ((size_t)b * 512 + ch) * NP; eb = ((size_t)b * 512 + ch) * KPP; }
            else { const int v = it - IPP; b = v / (512 * (KPS / 8)); const int q = v % (512 * (KPS / 8)); ch = q / (KPS / 8); j = q % (KPS / 8); N = NS; KP = KPS;
                ub = (size_t)4 * 512 * NP + ((size_t)b * 512 + ch) * NS; eb = (size_t)4 * 512 * KPP + ((size_t)b * 512 + ch) * KPS; }
            (void)KP;
            const bf16_t* ut = (const bf16_t*)(ws + UT_OFF) + ub; const int HN = N / 2, k0 = 8 * j;
            float ev[8], ov[8];
            if (k0 < HN) { const u32x4 f = *(const u32x4*)(ut + k0); const u32x4 rv = *(const u32x4*)(ut + N - k0 - 8);
                const float fw[8] = {bf_lo(f.x), bf_hi(f.x), bf_lo(f.y), bf_hi(f.y), bf_lo(f.z), bf_hi(f.z), bf_lo(f.w), bf_hi(f.w)};
                const float rr[8] = {bf_lo(rv.x), bf_hi(rv.x), bf_lo(rv.y), bf_hi(rv.y), bf_lo(rv.z), bf_hi(rv.z), bf_lo(rv.w), bf_hi(rv.w)};
                const float r0v = (k0 > 0) ? __uint_as_float((unsigned)ut[N - k0] << 16) : 0.f;
#pragma unroll
                for (int e = 0; e < 8; ++e) { const float rvv = (e == 0) ? r0v : rr[8 - e]; ev[e] = fw[e] + rvv; ov[e] = fw[e] - rvv; }
                if (k0 == 0) { ev[0] = fw[0]; ov[0] = 0.f; } }
            else {
#pragma unroll
                for (int e = 0; e < 8; ++e) { ev[e] = 0.f; ov[e] = 0.f; }
                if (k0 == HN) ev[0] = __uint_as_float((unsigned)ut[HN] << 16); }
            u32x4 we, wo; we.x = cvt_pk_bf16(ev[0], ev[1]); we.y = cvt_pk_bf16(ev[2], ev[3]); we.z = cvt_pk_bf16(ev[4], ev[5]); we.w = cvt_pk_bf16(ev[6], ev[7]);
            wo.x = cvt_pk_bf16(ov[0], ov[1]); wo.y = cvt_pk_bf16(ov[2], ov[3]); wo.z = cvt_pk_bf16(ov[4], ov[5]); wo.w = cvt_pk_bf16(ov[6], ov[7]);
            *(u32x4*)((bf16_t*)(ws + UE_OFF) + eb + k0) = we; *(u32x4*)((bf16_t*)(ws + UO_OFF) + eb + k0) = wo;
        }
    }
}

#define XB_TMO      128
#define XB_XCNT(j)  (256  + 64 * (j))
#define XB_XSUB(j)  (1280 + 64 * (j))
#define XB_XGEN(j)  (2304 + 64 * (j))
#define XB_TOP      3328
#define XB_TOPGEN   3392
#define XCD_BAR_WORDS 3456
#define XB_SPIN_CAP (1u << 18)

__device__ __forceinline__ unsigned xb_ld(unsigned* p)              { return __hip_atomic_load(p, __ATOMIC_RELAXED, __HIP_MEMORY_SCOPE_AGENT); }
__device__ __forceinline__ unsigned xb_add(unsigned* p, unsigned v) { return __hip_atomic_fetch_add(p, v, __ATOMIC_RELAXED, __HIP_MEMORY_SCOPE_AGENT); }
__device__ __forceinline__ unsigned xb_xcc_id() { return (unsigned)__builtin_amdgcn_s_getreg((3 << 11) | 20) & 0xFu; }
#define XB_SPIN(cond, bar) do { unsigned _sp = 0; while (cond) { __builtin_amdgcn_s_sleep(1); \
    if ((++_sp & 255u) == 0u) { if (xb_ld(&(bar)[XB_TMO])) break; if (_sp > XB_SPIN_CAP) { atomicAdd(&(bar)[XB_TMO], 1u); break; } } } } while (0)

struct XcdBarrier {
    unsigned* bar; unsigned x;
    volatile LAS unsigned* st;
};

__device__ __forceinline__ XcdBarrier xcd_barrier_post(unsigned* bar, volatile LAS unsigned* st) {
    XcdBarrier b; b.bar = bar; b.x = xb_xcc_id(); b.st = st;
    if (threadIdx.x == 0) (void)xb_add(&bar[XB_XCNT(b.x)], 1u);
    return b;
}
__device__ __forceinline__ void xcd_barrier_complete(unsigned* bar, unsigned x, unsigned& nloc, unsigned& nx) {
    const unsigned G = gridDim.x * gridDim.y * gridDim.z;
    unsigned sum, cnt, mine, sp = 0u;
    for (;;) {
        sum = 0u; cnt = 0u; mine = 0u;
#pragma unroll
        for (unsigned j = 0; j < 16; ++j) { const unsigned c = xb_ld(&bar[XB_XCNT(j)]); sum += c; cnt += (c > 0u) ? 1u : 0u; mine = (j == x) ? c : mine; }
        if (sum == G) break;
        __builtin_amdgcn_s_sleep(1);
        if ((++sp & 255u) == 0u) { if (xb_ld(&bar[XB_TMO])) break; if (sp > XB_SPIN_CAP) { atomicAdd(&bar[XB_TMO], 1u); break; } }
    }
    nloc = mine > 0u ? mine : 1u; nx = cnt > 0u ? cnt : 1u;
}

__device__ __forceinline__ void xcd_barrier(const XcdBarrier& b) {
    asm volatile("s_waitcnt vmcnt(0)" ::: "memory");
    __syncthreads();
    if (threadIdx.x == 0) {
        unsigned* bar = b.bar;
        __builtin_amdgcn_s_waitcnt(0);
        unsigned nloc = b.st[0], nx = b.st[1];
        if (nloc == 0u) { xcd_barrier_complete(bar, b.x, nloc, nx); b.st[0] = nloc; b.st[1] = nx; }
        const unsigned old = xb_add(&bar[XB_XSUB(b.x)], 1u);
        const unsigned gen = old / nloc;
        if (old + 1u == (gen + 1u) * nloc) {
            __builtin_amdgcn_fence(__ATOMIC_RELEASE, "agent");
            asm volatile("s_waitcnt vmcnt(0)" ::: "memory");
            const unsigned og = xb_add(&bar[XB_TOP], 1u);
            const unsigned tg = og / nx;
            if (og + 1u == (tg + 1u) * nx) xb_add(&bar[XB_TOPGEN], 1u);
            else XB_SPIN(xb_ld(&bar[XB_TOPGEN]) == tg, bar);
            __builtin_amdgcn_fence(__ATOMIC_ACQUIRE, "agent");
            xb_add(&bar[XB_XGEN(b.x)], 1u);
            asm volatile("s_waitcnt vmcnt(0)" ::: "memory");
        } else {
            XB_SPIN(xb_ld(&bar[XB_XGEN(b.x)]) == gen, bar);
            __builtin_amdgcn_fence(__ATOMIC_ACQUIRE, "agent");
            asm volatile("s_waitcnt vmcnt(0)" ::: "memory");
        }
    }
    __syncthreads();
}


#ifndef STG_W6
#define STG_W6 0
#endif
__device__ __forceinline__ void phase_stagger(int w_ticks) {
    if (w_ticks > 0) { const int bx = blockIdx.x, rank = (bx & 7) * (gridDim.x >> 3) + (bx >> 3);
        const unsigned long long t1 = __builtin_amdgcn_s_memrealtime() + (unsigned long long)((long)w_ticks * rank / gridDim.x);
        while (__builtin_amdgcn_s_memrealtime() < t1) __builtin_amdgcn_s_sleep(8); }
}
__global__ void __launch_bounds__(512, 2) mega_fwd(Params p) {
    extern __shared__ __attribute__((aligned(16))) unsigned char lds_raw[];
    LAS unsigned char* lds = (LAS unsigned char*)lds_raw;
    const int lo = p.ph_lo, hi = p.ph_hi, G = gridDim.x, bx = blockIdx.x;
    unsigned char* ws = p.ws;
    unsigned long long tsa_ = 0, tsb_ = 0;
#define TSA(k) do { if (TS_PHASE == (k)) tsa_ = __builtin_amdgcn_s_memrealtime(); } while (0)
#define TSB(k) do { if (TS_PHASE == (k)) tsb_ = __builtin_amdgcn_s_memrealtime(); } while (0)
#define IN(k) (lo <= (k) && (k) < hi)
    volatile LAS unsigned* bst = (volatile LAS unsigned*)(lds + LDS_BYTES - 64);
    if (threadIdx.x < 2) bst[threadIdx.x] = 0u;
    __syncthreads();
    if (bx == 0) { for (int i = threadIdx.x; i < 4096; i += 512) __hip_atomic_store((unsigned*)ws + i, 0u, __ATOMIC_RELAXED, __HIP_MEMORY_SCOPE_AGENT); }
    if (hi - lo > 1) cg::this_grid().sync();
    XcdBarrier xbar = xcd_barrier_post((unsigned*)ws, bst);
#define SEAM(k) do { if (IN(k) && IN((k) + 1)) { xcd_barrier(xbar); } } while (0)
#define REPS(k) for (int rep_ = 0; rep_ < ((REP_PHASE == (k)) ? 2 : 1); ++rep_)
#define REPSYNC(k) do { if (REP_PHASE == (k) && rep_ == 0) cg::this_grid().sync(); } while (0)
    TSA(0);
    if (IN(0)) REPS(0) { p0_prologue<0>(p, lds, bx, G); __syncthreads(); REPSYNC(0); }
    SEAM(0); TSB(0);
    TSA(1);
    if (IN(1)) REPS(1) {
        { SchedRect<1> S{}; S.A0 = (const char*)(ws + XB_OFF); S.B0 = (const char*)(ws + WINA_OFF); S.pa0 = 2048; S.nt0 = 16; S.nM = MT / 256; S.nN = 12; S.G = G; S.c = bx;
          EpiP1a E{ws, p.out}; pg8::gemm_phase<false>(lds, S, E); }
        { SchedRect<1> S{}; S.A0 = (const char*)(ws + XB_OFF); S.B0 = (const char*)(ws + WINB_OFF); S.pa0 = 2048; S.nt0 = 16; S.nM = MT / 256; S.nN = 4; S.G = G; S.c = bx;
          EpiP1b E{ws}; pg8::gemm_phase<true>(lds, S, E); }
        REPSYNC(1);
    }
    SEAM(1); TSB(1);
    TSA(2);
    if (IN(2)) REPS(2) { p0_prologue<1>(p, lds, bx, G); dft_prep(p); __syncthreads(); REPSYNC(2); }
    SEAM(2); TSB(2);
    TSA(3);
    if (IN(3)) REPS(3) { SchedDft S{(const char*)ws, G, bx}; EpiDft E{ws}; pg8::gemm_phase<false>(lds, S, E);
        int a_lo, a_hi;
        if (G == 256) {
            if (bx < 16) { a_lo = bx * 6; a_hi = a_lo + 6; } else if (bx < 80) { a_lo = 96 + (bx - 16) * 13; a_hi = a_lo + 13; } else if (bx < 160) { a_lo = 928 + (bx - 80) * 12; a_hi = a_lo + 12; }
            else { p0_prologue<2>(p, lds, bx - 160, 96); if (bx < 224) { a_lo = 1888 + (bx - 160) * 10; a_hi = a_lo + 10; } else { a_lo = 2528 + (bx - 224) * 17; a_hi = a_lo + 17; } }
        } else { p0_prologue<2>(p, lds, bx, G); const int per = (3072 + G - 1) / G; a_lo = bx * per; a_hi = min(a_lo + per, 3072); }
        __syncthreads();
        attn_units(p, lds, a_lo, a_hi);
        __syncthreads();
        REPSYNC(3); }
    SEAM(3); TSB(3);
    TSA(4);
    if (IN(4)) REPS(4) {
        SchedMerge S{(const char*)ws, G, bx};
        EpiMerge E{ws, p.out}; pg8::gemm_phase<false>(lds, S, E); REPSYNC(4);
    }
    SEAM(4); TSB(4);
    TSA(5);
    if (IN(5)) {
        SchedRect<1> S{}; S.A0 = (const char*)(ws + MIX_OFF); S.B0 = (const char*)(ws + WOUT_OFF); S.pa0 = 2048; S.nt0 = 16; S.nM = MT / 256; S.nN = 4; S.G = G; S.c = bx;
        EpiRes5 E{p.xp, p.xs, (bf16_t*)(ws + X1B_OFF), (float*)(ws + SS1_OFF)}; pg8::gemm_phase<false>(lds, S, E);
    }
    SEAM(5); TSB(5);
    TSA(6);
    if (IN(6)) REPS(6) {
        phase_stagger(STG_W6);
        SchedRect<1> S{}; S.A0 = (const char*)(ws + X1B_OFF); S.B0 = (const char*)(ws + WUP_OFF); S.pa0 = 2048; S.nt0 = 16; S.nM = MT / 256; S.nN = 16; S.G = G; S.c = bx;
        EpiUp E{(bf16_t*)(ws + H_OFF), (const float*)(ws + SS1_OFF)}; pg8::gemm_phase<false>(lds, S, E); REPSYNC(6);
    }
    SEAM(6); TSB(6);
    TSA(7);
    if (IN(7)) {
        SchedRect<1> S{}; S.A0 = (const char*)(ws + H_OFF); S.B0 = (const char*)(ws + WDN_OFF); S.pa0 = 8192; S.nt0 = 64; S.nM = MT / 256; S.nN = 4; S.G = G; S.c = bx;
        EpiRes7 E{(bf16_t*)(ws + X1B_OFF), (float*)(ws + SS2_OFF)}; pg8::gemm_phase<false>(lds, S, E);
    }
    SEAM(7); TSB(7);
    TSA(8);
    if (IN(8)) {
        const int tid = threadIdx.x, lane = tid & 63, wid = tid >> 6; const float* ss2 = (const float*)(ws + SS2_OFF);
        f32x4 gf[2][2];
#pragma unroll
        for (int j = 0; j < 2; ++j) { gf[j][0] = *(const f32x4*)(p.g_final + 512 * j + lane * 8); gf[j][1] = *(const f32x4*)(p.g_final + 512 * j + lane * 8 + 4); }
        for (int g0 = bx * 8 + wid; g0 < MT; g0 += 2 * G * 8) {
            u32x4 v[2][2]; float rinv[2];
#pragma unroll
            for (int q = 0; q < 2; ++q) { const int g = g0 + q * G * 8; if (g < MT) { const bf16_t* xr = (const bf16_t*)(ws + X1B_OFF) + (size_t)g * 1024;
                    v[q][0] = *(const u32x4*)(xr + lane * 8); v[q][1] = *(const u32x4*)(xr + 512 + lane * 8); rinv[q] = rsqrtf(ss2[g] * (1.0f / 1024.0f) + RMS_EPS); } }
#pragma unroll
            for (int q = 0; q < 2; ++q) { const int g = g0 + q * G * 8; if (g < MT) { float* o = p.out + (size_t)g * 1024;
#pragma unroll
                    for (int j = 0; j < 2; ++j) { const u32x4 b = v[q][j]; f32x4 o0, o1;
                        o0[0] = bf_lo(b.x); o0[1] = bf_hi(b.x); o0[2] = bf_lo(b.y); o0[3] = bf_hi(b.y); o1[0] = bf_lo(b.z); o1[1] = bf_hi(b.z); o1[2] = bf_lo(b.w); o1[3] = bf_hi(b.w);
                        *(f32x4*)(o + 512 * j + lane * 8) = o0 * rinv[q] * gf[j][0]; *(f32x4*)(o + 512 * j + lane * 8 + 4) = o1 * rinv[q] * gf[j][1]; } } }
        }
    }
    TSB(8);
    if (TS_PHASE >= 0 && bx == 0) { const unsigned long long t1 = __builtin_amdgcn_s_memrealtime() + (tsb_ - tsa_); while (__builtin_amdgcn_s_memrealtime() < t1) __builtin_amdgcn_s_sleep(8); }
#undef IN
#undef SEAM
}

extern "C" void kernel_launch(void* const* d_in, const int* in_sizes, int n_in, void* d_out, int out_size, void* d_ws, size_t ws_size, hipStream_t stream) {
    static int grid = 0;
    if (grid == 0) {
        if (n_in != 14 || out_size != MT * D || ws_size < WS_NEED) { fprintf(stderr, "kernel_launch: unexpected shapes (n_in %d, out %d, ws %zu)\n", n_in, out_size, ws_size); grid = -1; return; }
        int dev = 0, cus = 0, per_cu = 0;
        hipGetDevice(&dev); hipDeviceGetAttribute(&cus, hipDeviceAttributeMultiprocessorCount, dev);
        if (hipFuncSetAttribute((const void*)mega_fwd, hipFuncAttributeMaxDynamicSharedMemorySize, LDS_BYTES) != hipSuccess) { fprintf(stderr, "kernel_launch: hipFuncSetAttribute failed\n"); grid = -1; return; }
        if (hipOccupancyMaxActiveBlocksPerMultiprocessor(&per_cu, (const void*)mega_fwd, 512, LDS_BYTES) != hipSuccess || per_cu < 1) per_cu = 1;
        (void)hipGetLastError();
        grid = cus * per_cu;
    }
    if (grid < 0) return;
    Params p{};
    p.xp = (const float*)d_in[0]; p.xs = (const float*)d_in[1]; p.meta = (const float*)d_in[2]; p.w_in = (const float*)d_in[3]; p.rel_bias = (const float*)d_in[4]; p.meta_bias = (const float*)d_in[5];
    p.w_na = (const float*)d_in[6]; p.w_fn = (const float*)d_in[7]; p.w_out = (const float*)d_in[8]; p.g_mix = (const float*)d_in[9]; p.g_mlp = (const float*)d_in[10]; p.w_up = (const float*)d_in[11];
    p.w_down = (const float*)d_in[12]; p.g_final = (const float*)d_in[13]; p.out = (float*)d_out; p.ws = (unsigned char*)d_ws;
#if MK_PER_PHASE
    for (int ph = 0; ph < 9; ++ph) { p.ph_lo = ph; p.ph_hi = ph + 1; hipLaunchKernelGGL(mega_fwd, dim3(grid), dim3(512), LDS_BYTES, stream, p); }
#else
    p.ph_lo = 0; p.ph_hi = 9;
    void* args[] = {&p};
    hipError_t e = hipLaunchCooperativeKernel((const void*)mega_fwd, dim3(grid), dim3(512), args, LDS_BYTES, stream);
    if (e != hipSuccess) fprintf(stderr, "cooperative launch failed: %s (grid %d)\n", hipGetErrorString(e), grid);
#endif
}
```

```cpp
#include <hip/hip_runtime.h>
#include <hip/hip_cooperative_groups.h>
#include <cstdio>
#include <cstdint>
namespace cg = cooperative_groups;

#ifndef MK_PER_PHASE
#define MK_PER_PHASE 0
#endif

#ifndef TS_PHASE
#define TS_PHASE -1
#endif
#ifndef P0REP
#define P0REP -1
#endif
#ifndef EPI2
#define EPI2 -1
#endif
#ifndef REP_PHASE
#define REP_PHASE -1
#endif
#define LAS __attribute__((address_space(3)))
typedef unsigned short bf16_t;
typedef short bf16x8 __attribute__((ext_vector_type(8)));
typedef float f32x4 __attribute__((ext_vector_type(4)));
typedef float f32x2 __attribute__((ext_vector_type(2)));
typedef unsigned u32x4 __attribute__((ext_vector_type(4)));
typedef unsigned u32x2 __attribute__((ext_vector_type(2)));

constexpr int D = 1024, TP = 8192, TS = 4096, MT = 4 * TP + 4 * TS;
constexpr int NP = TP + 16, NS = TS + 16;
constexpr int KPP = 4224, KPS = 2176;
constexpr int MRP = 4352, MRS = 2304;
constexpr float RMS_EPS = 1e-6f;
constexpr size_t MiB = 1u << 20;
constexpr size_t SS1_OFF = 64 * 1024, SS2_OFF = 256 * 1024, KMETA_OFF = 512 * 1024, VMETAT_OFF = 528 * 1024;
constexpr size_t WINA_OFF = 1 * MiB, WINB_OFF = 7 * MiB, WUP_OFF = 9 * MiB, WDN_OFF = 17 * MiB, WOUT_OFF = 25 * MiB, WNA_OFF = 27 * MiB, WFN_OFF = 28 * MiB;
constexpr size_t XB_OFF = 30 * MiB;
constexpr size_t CP_OFF = 126 * MiB, SP_OFF = CP_OFF + (size_t)MRP * KPP * 2, CS_OFF = SP_OFF + (size_t)MRP * KPP * 2, SSM_OFF = CS_OFF + (size_t)MRS * KPS * 2;
constexpr size_t Q_OFF = 234 * MiB, K_OFF = 282 * MiB, VT_OFF = 330 * MiB, UT_OFF = 378 * MiB;
constexpr size_t ATT_OFF = 30 * MiB, UE_OFF = 427 * MiB, UO_OFF = 452 * MiB;
constexpr size_t PB_OFF = 78 * MiB, QB_OFF = 378 * MiB, MIX_OFF = 126 * MiB, X1B_OFF = 414 * MiB, H_OFF = 30 * MiB;
constexpr size_t WS_NEED = 510 * MiB;
static_assert(SSM_OFF + (size_t)MRS * KPS * 2 <= 234 * MiB, "dft matrices");
static_assert(UT_OFF + (size_t)512 * 2 * (4 * NP + 4 * NS) <= UE_OFF, "ut");
constexpr int LDS_BYTES = 160 * 1024;

__device__ __forceinline__ unsigned cvt_pk_bf16(float lo, float hi) { unsigned r; asm volatile("v_cvt_pk_bf16_f32 %0, %1, %2" : "=v"(r) : "v"(lo), "v"(hi)); return r; }
__device__ __forceinline__ float bf_lo(unsigned w) { return __uint_as_float(w << 16); }
__device__ __forceinline__ float bf_hi(unsigned w) { return __uint_as_float(w & 0xffff0000u); }
__device__ __forceinline__ float wave_sum(float v) {
#pragma unroll
    for (int o = 1; o < 64; o <<= 1) v += __shfl_xor(v, o);
    return v;
}
__device__ __forceinline__ int batch_base(int b) { return b < 4 ? b * TP : 4 * TP + (b - 4) * TS; }

struct Params {
    const float* xp; const float* xs; const float* meta; const float* w_in; const float* rel_bias; const float* meta_bias;
    const float* w_na; const float* w_fn; const float* w_out; const float* g_mix; const float* g_mlp; const float* w_up; const float* w_down; const float* g_final;
    float* out; unsigned char* ws; int ph_lo, ph_hi;
};

namespace pg8 {
constexpr int BM = 256, BK = 64, HALF = 128, HTB = HALF * BK * 2, STAGE_BYTES = 8 * HTB;
__device__ __forceinline__ int lds_byte(int r, int c) { const int st = (r >> 4) * 2 + (c >> 5), rr = r & 15, cc = c & 31, ob = rr * 64 + cc * 2; return st * 1024 + (ob ^ (((ob >> 9) & 1) << 5)); }
__device__ __forceinline__ void stage_rc(int b, int& R, int& C) { const int st = b / 1024, sb = b % 1024, swz = sb ^ (((sb >> 9) & 1) << 5); R = (st >> 1) * 16 + swz / 64; C = (st & 1) * 32 + (swz % 64) / 2; }
__device__ __forceinline__ int perm32(int rho) { const int n = rho >> 4, i = rho & 15; return 8 * (i >> 2) + 4 * n + (i & 3); }

struct Unit { const char* A; const char* B; int pa, pb, nt, pm, pn, aux; };

__device__ __forceinline__ bool rect_tile(long L, int nM, int nN, int& pm, int& pn) {
    const int nwg = nM * nN; if (L >= nwg) return false;
    int wgid = (int)L; { const int q = nwg / 8, r = nwg % 8, xcd = wgid % 8, off = wgid / 8; wgid = (xcd < r ? xcd * (q + 1) : r * (q + 1) + (xcd - r) * q) + off; }
    const int nig = 8 * nN, gid = wgid / nig, fm = gid * 8, gsz = (nM - fm) < 8 ? (nM - fm) : 8;
    pm = fm + ((wgid % nig) % gsz); pn = (wgid % nig) / gsz; return true;
}

template <bool TRANS, class Epi, class Sched>
__device__ __forceinline__ void gemm_phase(LAS unsigned char* lds, const Sched& S, const Epi& E) {
    const int tid = threadIdx.x, wid = __builtin_amdgcn_readfirstlane(tid >> 6), lane = tid & 63, wr = wid >> 2, wc = wid & 3, fr = lane & 15, fq = lane >> 4;
    int RA[2], RB[2], CB[2];
#pragma unroll
    for (int i = 0; i < 2; ++i) { int R, C; stage_rc(tid * 16 + i * 8192, R, C); RA[i] = R; RB[i] = Epi::PERM ? ((R & ~31) + perm32(R & 31)) : R; CB[i] = C * 2; }
    const unsigned ldsw = (unsigned)wid * 1024u;
    const int aoff = lds_byte(wr * 64 + fr, fq * 8), boff = lds_byte(wc * 32 + fr, fq * 8);
#define PG8_SA(b, h) (((b) * 2 + (h)) * HTB)
#define PG8_SB(b, h) ((4 + (b) * 2 + (h)) * HTB)
#define PG8_STAGE(bufoff, gbase, pitch, RR) do { _Pragma("unroll") for (int _i = 0; _i < 2; ++_i) \
        __builtin_amdgcn_global_load_lds((const unsigned*)((const char*)(gbase) + (unsigned)((RR)[_i] * (pitch) + CB[_i])), (LAS unsigned*)(lds + (bufoff) + ldsw + _i * 8192), 16, 0, 0); } while (0)
#define PG8_LDA(dst, b, h) do { _Pragma("unroll") for (int m = 0; m < 4; ++m) _Pragma("unroll") for (int k = 0; k < 2; ++k) dst[m][k] = *(const LAS bf16x8*)(lds + PG8_SA(b, h) + aoff + m * 2048 + k * 1024); } while (0)
#define PG8_LDB(dst, b, h) do { _Pragma("unroll") for (int n = 0; n < 2; ++n) _Pragma("unroll") for (int k = 0; k < 2; ++k) dst[n][k] = *(const LAS bf16x8*)(lds + PG8_SB(b, h) + boff + n * 2048 + k * 1024); } while (0)
#define PG8_MMA(ai, bj, At, Bt) do { __builtin_amdgcn_s_setprio(1); _Pragma("unroll") for (int m = 0; m < 4; ++m) _Pragma("unroll") for (int n = 0; n < 2; ++n) _Pragma("unroll") for (int k = 0; k < 2; ++k) \
        acc[ai][bj][m][n] = TRANS ? __builtin_amdgcn_mfma_f32_16x16x32_bf16(At[m][k], Bt[n][k], acc[ai][bj][m][n], 0, 0, 0) \
                                  : __builtin_amdgcn_mfma_f32_16x16x32_bf16(Bt[n][k], At[m][k], acc[ai][bj][m][n], 0, 0, 0); __builtin_amdgcn_s_setprio(0); } while (0)
#define PG8_WAIT_V(n) asm volatile("s_waitcnt vmcnt(" #n ")" ::: "memory")
#define PG8_WAIT_L(n) asm volatile("s_waitcnt lgkmcnt(" #n ")" ::: "memory")
#define PG8_BAR __builtin_amdgcn_s_barrier()
#define PG8_SCHED __builtin_amdgcn_sched_barrier(0)
    Unit cur, nxt; int ui = 0;
    if (!S.next(0, cur)) return;
    f32x4 acc[2][2][4][2];
#pragma unroll
    for (int a = 0; a < 2; ++a)
#pragma unroll
        for (int b = 0; b < 2; ++b)
#pragma unroll
            for (int m = 0; m < 4; ++m)
#pragma unroll
                for (int n = 0; n < 2; ++n) acc[a][b][m][n] = (f32x4){0.f, 0.f, 0.f, 0.f};
    bf16x8 At[4][2], B0[2][2], B1[2][2];
    const char* cA = cur.A; const char* cB = cur.B; int cpa = cur.pa, cpb = cur.pb;
    {
        const size_t hA = (size_t)HALF * cpa, hB = (size_t)HALF * cpb;
        PG8_STAGE(PG8_SB(0, 0), cB, cpb, RB); PG8_STAGE(PG8_SB(0, 1), cB + hB, cpb, RB); PG8_STAGE(PG8_SA(0, 0), cA, cpa, RA); PG8_STAGE(PG8_SA(0, 1), cA + hA, cpa, RA);
        if (wr == 1) PG8_BAR;
        PG8_WAIT_V(2); PG8_BAR;
        PG8_STAGE(PG8_SB(1, 0), cB + 128, cpb, RB); PG8_STAGE(PG8_SA(1, 0), cA + 128, cpa, RA); PG8_STAGE(PG8_SB(1, 1), cB + hB + 128, cpb, RB);
        PG8_WAIT_V(6); PG8_BAR;
    }
    for (;;) {
        const bool has_next = S.next(ui + 1, nxt);
        const char* nA = has_next ? nxt.A : cA; const char* nB = has_next ? nxt.B : cB; const int npa = has_next ? nxt.pa : cpa, npb = has_next ? nxt.pb : cpb;
        const int nt = cur.nt; const size_t hA = (size_t)HALF * cpa;
        for (int t = 0; t < nt; t += 2) {
            const bool last = (t == nt - 2);
            const char* a1 = cA + (size_t)(t + 1) * 128;
            const char* a2 = last ? nA : cA + (size_t)(t + 2) * 128; const char* b2 = last ? nB : cB + (size_t)(t + 2) * 128;
            const int pa2 = last ? npa : cpa, pb2 = last ? npb : cpb; const size_t hA2 = (size_t)HALF * pa2, hB2 = (size_t)HALF * pb2;
            const char* a3 = a2 + 128; const char* b3 = b2 + 128;
            PG8_LDB(B0, 0, 0); PG8_LDB(B1, 0, 1); PG8_SCHED; PG8_LDA(At, 0, 0); PG8_STAGE(PG8_SA(1, 1), a1 + hA, cpa, RA);
            PG8_WAIT_V(8); PG8_WAIT_L(0); PG8_BAR; PG8_MMA(0, 0, At, B0); PG8_MMA(0, 1, At, B1); PG8_BAR; PG8_SCHED;
            PG8_LDA(At, 0, 1); PG8_STAGE(PG8_SB(0, 0), b2, pb2, RB); PG8_STAGE(PG8_SB(0, 1), b2 + hB2, pb2, RB); PG8_STAGE(PG8_SA(0, 0), a2, pa2, RA);
            PG8_WAIT_V(8); PG8_WAIT_L(0); PG8_BAR; PG8_MMA(1, 0, At, B0); PG8_MMA(1, 1, At, B1); PG8_BAR; PG8_SCHED;
            PG8_LDB(B0, 1, 0); PG8_LDB(B1, 1, 1); PG8_SCHED; PG8_LDA(At, 1, 0); PG8_STAGE(PG8_SA(0, 1), a2 + hA2, pa2, RA);
            PG8_WAIT_V(8); PG8_WAIT_L(0); PG8_BAR; PG8_MMA(0, 0, At, B0); PG8_MMA(0, 1, At, B1); PG8_BAR; PG8_SCHED;
            PG8_LDA(At, 1, 1); PG8_STAGE(PG8_SB(1, 0), b3, pb2, RB); PG8_STAGE(PG8_SB(1, 1), b3 + hB2, pb2, RB); PG8_STAGE(PG8_SA(1, 0), a3, pa2, RA);
            PG8_WAIT_V(8); PG8_WAIT_L(0); PG8_BAR; PG8_MMA(1, 0, At, B0); PG8_MMA(1, 1, At, B1); PG8_BAR; PG8_SCHED;
        }
        if (wr == 0) PG8_BAR;
        if (Epi::TWICE) (void)E(acc, cur, wr, wc, fr, fq);
        const bool keep = E(acc, cur, wr, wc, fr, fq);
        if (!has_next) break;
        if (!keep) {
#pragma unroll
            for (int a = 0; a < 2; ++a)
#pragma unroll
                for (int b = 0; b < 2; ++b)
#pragma unroll
                    for (int m = 0; m < 4; ++m)
#pragma unroll
                        for (int n = 0; n < 2; ++n) acc[a][b][m][n] = (f32x4){0.f, 0.f, 0.f, 0.f};
        }
        cur = nxt; cA = nA; cB = nB; cpa = npa; cpb = npb; ++ui;
        if (wr == 1) PG8_BAR;
    }
    PG8_WAIT_V(0);
    PG8_BAR;
#undef PG8_SA
#undef PG8_SB
#undef PG8_STAGE
#undef PG8_LDA
#undef PG8_LDB
#undef PG8_MMA
#undef PG8_WAIT_V
#undef PG8_WAIT_L
#undef PG8_BAR
#undef PG8_SCHED
}
}
using pg8::Unit;

template <int NSUB> struct SchedRect {
    const char* A0; const char* B0; const char* A1; const char* B1; int pa0, nt0, pa1, nt1; int nM, nN, G, c;
    __device__ __forceinline__ bool next(int i, Unit& u) const {
        const int ti = i / NSUB, s = i % NSUB; int pm, pn;
        if (!pg8::rect_tile((long)ti * G + c, nM, nN, pm, pn)) return false;
        const int pa = (NSUB > 1 && s) ? pa1 : pa0;
        u.pa = pa; u.pb = pa; u.nt = (NSUB > 1 && s) ? nt1 : nt0; u.pm = pm; u.pn = pn; u.aux = s;
        u.A = ((NSUB > 1 && s) ? A1 : A0) + (size_t)pm * 256 * pa; u.B = ((NSUB > 1 && s) ? B1 : B0) + (size_t)pn * 256 * pa; return true;
    }
};

struct SchedMerge {
    const char* ws; int G, c;
    __device__ __forceinline__ bool next(int i, Unit& u) const {
        const int ti = i / 3, s = i % 3; int pm, pn;
        if (!pg8::rect_tile((long)ti * G + c, MT / 256, 4, pm, pn)) return false;
        u.pa = 1024; u.nt = 8; u.pm = pm; u.pn = pn; u.aux = s;
        if (s == 0) { u.A = ws + ATT_OFF + (size_t)pm * 256 * 1024; u.B = ws + WNA_OFF + (size_t)pn * 256 * 1024; u.pb = 1024; }
        else { u.A = ws + (s == 1 ? PB_OFF : QB_OFF) + (size_t)pm * 256 * 1024; u.B = ws + WFN_OFF + (size_t)pn * 256 * 2048 + (s == 2 ? 1024 : 0); u.pb = 2048; }
        return true;
    }
};
struct SchedDft {
    const char* ws; int G, c;
    __device__ __forceinline__ bool next(int i, Unit& u) const {
        const long L = (long)i * G + c; if (L >= 416) return false;
        int pm, b, pn;
        if (L < 272) {
            if (L < 256) { const int x = (int)L & 7, s = (int)L >> 3; pm = 8 * (x >> 2) + (s & 7); b = s >> 3; pn = x & 3; }
            else { const int e = (int)L - 256; pm = 16; b = e >> 2; pn = e & 3; }
            u.pa = KPP * 2; u.pb = KPP * 2; u.nt = KPP / 64;
            u.A = ws + (pn < 2 ? CP_OFF : SP_OFF) + (size_t)pm * 256 * KPP * 2;
            u.B = ws + (pn < 2 ? UE_OFF : UO_OFF) + ((size_t)b * 512 + (pn & 1) * 256) * KPP * 2;
        } else {
            const int l = (int)L - 272, x = l & 7, s = l >> 3; pn = x & 3; pm = s % 9; b = 4 + 2 * (s / 9) + (x >> 2);
            u.pa = KPS * 2; u.pb = KPS * 2; u.nt = KPS / 64;
            u.A = ws + (pn < 2 ? CS_OFF : SSM_OFF) + (size_t)pm * 256 * KPS * 2;
            u.B = ws + (pn < 2 ? UE_OFF : UO_OFF) + (size_t)4 * 512 * KPP * 2 + ((size_t)(b - 4) * 512 + (pn & 1) * 256) * KPS * 2;
        }
        u.pm = pm; u.pn = pn; u.aux = b; return true;
    }
};

__device__ __forceinline__ float sigmoidf_(float v) { return __builtin_amdgcn_rcpf(1.0f + __builtin_amdgcn_exp2f(-1.44269504f * v)); }
typedef f32x4 Acc[2][2][4][2];

struct EpiP1a {
    static constexpr bool PERM = true, TWICE = (EPI2 == 1);
    unsigned char* ws; float* gates;
    __device__ __forceinline__ bool operator()(Acc& acc, const Unit& u, int wr, int wc, int fr, int fq) const {
        asm volatile("" : "+v"(fr), "+v"(fq));
        const int row0 = u.pm * 256 + wr * 64 + fr;
        if (u.pn < 4) {
            bf16_t* base = (bf16_t*)(ws + (u.pn < 2 ? Q_OFF : K_OFF)); const int col0 = (u.pn & 1) * 256 + wc * 32 + 8 * fq;
#pragma unroll
            for (int ai = 0; ai < 2; ++ai)
#pragma unroll
                for (int m = 0; m < 4; ++m) { bf16_t* rowp = base + (size_t)(row0 + ai * 128 + m * 16) * 512 + col0;
#pragma unroll
                    for (int bj = 0; bj < 2; ++bj) { const f32x4 v0 = acc[ai][bj][m][0], v1 = acc[ai][bj][m][1];
                        u32x4 w; w.x = cvt_pk_bf16(v0[0], v0[1]); w.y = cvt_pk_bf16(v0[2], v0[3]); w.z = cvt_pk_bf16(v1[0], v1[1]); w.w = cvt_pk_bf16(v1[2], v1[3]);
                        *(u32x4*)(rowp + bj * 128) = w; } }
        } else {
            bf16_t* Rb = (bf16_t*)gates; bf16_t* Sb = Rb + (size_t)MT * 1024; const int col0 = (u.pn - 4) * 128 + wc * 32 + 8 * fq;
#pragma unroll
            for (int ai = 0; ai < 2; ++ai)
#pragma unroll
                for (int m = 0; m < 4; ++m) { const size_t off = (size_t)(row0 + ai * 128 + m * 16) * 1024 + col0; float rr[8], s2[8];
#pragma unroll
                    for (int n = 0; n < 2; ++n)
#pragma unroll
                        for (int e = 0; e < 4; ++e) { const float e1 = __builtin_amdgcn_exp2f(fminf(-1.44269504f * acc[ai][0][m][n][e], 60.f)), e2 = __builtin_amdgcn_exp2f(fminf(-1.44269504f * acc[ai][1][m][n][e], 60.f));
                            const float d1 = 1.0f + e1, d2 = 1.0f + e2, t = __builtin_amdgcn_rcpf(d1 * d2);
                            s2[4 * n + e] = t * d1; rr[4 * n + e] = d2 * d2 * t; }
                    u32x4 w; w.x = cvt_pk_bf16(rr[0], rr[1]); w.y = cvt_pk_bf16(rr[2], rr[3]); w.z = cvt_pk_bf16(rr[4], rr[5]); w.w = cvt_pk_bf16(rr[6], rr[7]);
                    *(u32x4*)(Rb + off) = w;
                    w.x = cvt_pk_bf16(s2[0], s2[1]); w.y = cvt_pk_bf16(s2[2], s2[3]); w.z = cvt_pk_bf16(s2[4], s2[5]); w.w = cvt_pk_bf16(s2[6], s2[7]);
                    *(u32x4*)(Sb + off) = w; }
        }
        return false;
    }
};
struct EpiP1b {
    static constexpr bool PERM = false, TWICE = (EPI2 == 1);
    unsigned char* ws;
    __device__ __forceinline__ bool operator()(Acc& acc, const Unit& u, int wr, int wc, int fr, int fq) const {
        asm volatile("" : "+v"(fr), "+v"(fq));
        const int g0 = u.pm * 256; const int b = g0 < 4 * TP ? g0 / TP : 4 + (g0 - 4 * TP) / TS; const int gb = batch_base(b), T = b < 4 ? TP : TS, N = T + 16;
        bf16_t* base; size_t pitch; int coff;
        if (u.pn < 2) { base = (bf16_t*)(ws + VT_OFF) + (size_t)512 * gb; pitch = T; coff = u.pn * 256; }
        else { base = (bf16_t*)(ws + UT_OFF) + (b < 4 ? (size_t)b * 512 * NP : (size_t)4 * 512 * NP + (size_t)(b - 4) * 512 * NS) + 16; pitch = N; coff = (u.pn - 2) * 256; }
        const int t0 = g0 - gb + wr * 64 + 4 * fq, c0 = coff + wc * 32 + fr;
#pragma unroll
        for (int ai = 0; ai < 2; ++ai)
#pragma unroll
            for (int bj = 0; bj < 2; ++bj)
#pragma unroll
                for (int m = 0; m < 4; ++m)
#pragma unroll
                    for (int n = 0; n < 2; ++n) { const f32x4 v = acc[ai][bj][m][n]; u32x2 w; w.x = cvt_pk_bf16(v[0], v[1]); w.y = cvt_pk_bf16(v[2], v[3]);
                        *(u32x2*)(base + (size_t)(c0 + bj * 128 + n * 16) * pitch + t0 + ai * 128 + m * 16) = w; }
        return false;
    }
};
struct EpiDft {
    static constexpr bool PERM = true, TWICE = (EPI2 == 3);
    unsigned char* ws;
    __device__ __forceinline__ bool operator()(Acc& acc, const Unit& u, int wr, int wc, int fr, int fq) const {
        asm volatile("" : "+v"(fr), "+v"(fq));
        const int b = u.aux, gb = batch_base(b), N = (b < 4 ? TP : TS) + 16, HN = N / 2;
        bf16_t* base = (bf16_t*)(ws + (u.pn < 2 ? PB_OFF : QB_OFF)) + (size_t)gb * 512 + (u.pn & 1) * 256 + wc * 32 + 8 * fq;
        const float sg = u.pn >= 2 ? -1.f : 1.f;
#pragma unroll
        for (int ai = 0; ai < 2; ++ai)
#pragma unroll
            for (int m = 0; m < 4; ++m) { const int np = u.pm * 256 + ai * 128 + wr * 64 + m * 16 + fr + 1;
                if (np <= HN) {
#pragma unroll
                    for (int bj = 0; bj < 2; ++bj) { const f32x4 v0 = acc[ai][bj][m][0], v1 = acc[ai][bj][m][1];
                        if (np >= 16) { u32x4 w; w.x = cvt_pk_bf16(v0[0], v0[1]); w.y = cvt_pk_bf16(v0[2], v0[3]); w.z = cvt_pk_bf16(v1[0], v1[1]); w.w = cvt_pk_bf16(v1[2], v1[3]);
                            *(u32x4*)(base + (size_t)(np - 16) * 512 + bj * 128) = w; }
                        if (np != HN) { u32x4 w; w.x = cvt_pk_bf16(sg * v0[0], sg * v0[1]); w.y = cvt_pk_bf16(sg * v0[2], sg * v0[3]); w.z = cvt_pk_bf16(sg * v1[0], sg * v1[1]); w.w = cvt_pk_bf16(sg * v1[2], sg * v1[3]);
                            *(u32x4*)(base + (size_t)(N - np - 16) * 512 + bj * 128) = w; } } } }
        return false;
    }
};
struct EpiMerge {
    static constexpr bool PERM = true, TWICE = false;
    unsigned char* ws; const float* gates;
    __device__ __forceinline__ bool operator()(Acc& acc, const Unit& u, int wr, int wc, int fr, int fq) const {
        if (u.aux == 1) return true;
        asm volatile("" : "+v"(fr), "+v"(fq));
        const bf16_t* Gs = (const bf16_t*)gates + (u.aux == 0 ? (size_t)0 : (size_t)MT * 1024);
        const int row0 = u.pm * 256 + wr * 64 + fr, col0 = u.pn * 256 + wc * 32 + 8 * fq;
        bf16_t* mix = (bf16_t*)(ws + MIX_OFF);
        u32x4 g2[4][2];
#pragma unroll
        for (int q = 0; q < 3; ++q)
#pragma unroll
            for (int bj = 0; bj < 2; ++bj) g2[q][bj] = *(const u32x4*)(Gs + (size_t)(row0 + q * 16) * 1024 + col0 + bj * 128);
#pragma unroll
        for (int idx = 0; idx < 8; ++idx) { const int ai = idx >> 2, m = idx & 3; const size_t off = (size_t)(row0 + ai * 128 + m * 16) * 1024 + col0;
            if (idx < 5) { const int ai2 = (idx + 3) >> 2, m2 = (idx + 3) & 3; const size_t off2 = (size_t)(row0 + ai2 * 128 + m2 * 16) * 1024 + col0;
#pragma unroll
                for (int bj = 0; bj < 2; ++bj) g2[(idx + 3) & 3][bj] = *(const u32x4*)(Gs + off2 + bj * 128); }
#pragma unroll
            for (int bj = 0; bj < 2; ++bj) { const u32x4 w2 = g2[idx & 3][bj];
                const float sc[8] = {bf_lo(w2.x), bf_hi(w2.x), bf_lo(w2.y), bf_hi(w2.y), bf_lo(w2.z), bf_hi(w2.z), bf_lo(w2.w), bf_hi(w2.w)};
#pragma unroll
                for (int e = 0; e < 4; ++e) { acc[ai][bj][m][0][e] *= sc[e]; acc[ai][bj][m][1][e] *= sc[4 + e]; }
                if (u.aux == 2) { const f32x4 v0 = acc[ai][bj][m][0], v1 = acc[ai][bj][m][1]; u32x4 w;
                    w.x = cvt_pk_bf16(v0[0], v0[1]); w.y = cvt_pk_bf16(v0[2], v0[3]); w.z = cvt_pk_bf16(v1[0], v1[1]); w.w = cvt_pk_bf16(v1[2], v1[3]);
                    *(u32x4*)(mix + off + bj * 128) = w; } } }
        return u.aux == 0;
    }
};
struct EpiRes5 {
    static constexpr bool PERM = true, TWICE = false;
    const float* bp; const float* bs; bf16_t* ob; float* ss;
    __device__ __forceinline__ bool operator()(Acc& acc, const Unit& u, int wr, int wc, int fr, int fq) const {
        asm volatile("" : "+v"(fr), "+v"(fq));
        const int g0 = u.pm * 256; const float* base = g0 < 4 * TP ? bp + (size_t)g0 * 1024 : bs + (size_t)(g0 - 4 * TP) * 1024;
        const int lr0 = wr * 64 + fr, col0 = u.pn * 256 + wc * 32 + 8 * fq;
        f32x4 pre[3][2][2];
#pragma unroll
        for (int q = 0; q < 2; ++q)
#pragma unroll
            for (int bj = 0; bj < 2; ++bj)
#pragma unroll
                for (int n = 0; n < 2; ++n) pre[q][bj][n] = *(const f32x4*)(base + (size_t)(lr0 + q * 16) * 1024 + col0 + bj * 128 + n * 4);
#pragma unroll
        for (int idx = 0; idx < 8; ++idx) { const int ai = idx >> 2, m = idx & 3; const int lr = lr0 + ai * 128 + m * 16; float s = 0.f;
            if (idx < 6) { const int lr2 = lr0 + ((idx + 2) >> 2) * 128 + ((idx + 2) & 3) * 16;
#pragma unroll
                for (int bj = 0; bj < 2; ++bj)
#pragma unroll
                    for (int n = 0; n < 2; ++n) pre[(idx + 2) % 3][bj][n] = *(const f32x4*)(base + (size_t)lr2 * 1024 + col0 + bj * 128 + n * 4); }
#pragma unroll
            for (int bj = 0; bj < 2; ++bj) { const f32x4 o0 = pre[idx % 3][bj][0] + acc[ai][bj][m][0], o1 = pre[idx % 3][bj][1] + acc[ai][bj][m][1];
                s += ((o0[0] * o0[0] + o0[1] * o0[1]) + (o0[2] * o0[2] + o0[3] * o0[3])) + ((o1[0] * o1[0] + o1[1] * o1[1]) + (o1[2] * o1[2] + o1[3] * o1[3]));
                u32x4 w; w.x = cvt_pk_bf16(o0[0], o0[1]); w.y = cvt_pk_bf16(o0[2], o0[3]); w.z = cvt_pk_bf16(o1[0], o1[1]); w.w = cvt_pk_bf16(o1[2], o1[3]);
                *(u32x4*)(ob + (size_t)(g0 + lr) * 1024 + col0 + bj * 128) = w; }
            s += __shfl_xor(s, 16); s += __shfl_xor(s, 32);
            if (fq == 0) atomicAdd(ss + g0 + lr, s); }
        return false;
    }
};
struct EpiRes7 {
    static constexpr bool PERM = true, TWICE = false;
    bf16_t* xb; float* ss;
    __device__ __forceinline__ bool operator()(Acc& acc, const Unit& u, int wr, int wc, int fr, int fq) const {
        asm volatile("" : "+v"(fr), "+v"(fq));
        const int row0 = u.pm * 256 + wr * 64 + fr, col0 = u.pn * 256 + wc * 32 + 8 * fq;
        u32x4 pre[4][2];
#pragma unroll
        for (int q = 0; q < 3; ++q)
#pragma unroll
            for (int bj = 0; bj < 2; ++bj) pre[q][bj] = *(const u32x4*)(xb + (size_t)(row0 + q * 16) * 1024 + col0 + bj * 128);
#pragma unroll
        for (int idx = 0; idx < 8; ++idx) { const int ai = idx >> 2, m = idx & 3; const int row = row0 + ai * 128 + m * 16; float s = 0.f;
            if (idx < 5) { const int row2 = row0 + ((idx + 3) >> 2) * 128 + ((idx + 3) & 3) * 16;
#pragma unroll
                for (int bj = 0; bj < 2; ++bj) pre[(idx + 3) & 3][bj] = *(const u32x4*)(xb + (size_t)row2 * 1024 + col0 + bj * 128); }
#pragma unroll
            for (int bj = 0; bj < 2; ++bj) { const u32x4 b = pre[idx & 3][bj]; const f32x4 a0 = acc[ai][bj][m][0], a1 = acc[ai][bj][m][1];
                const float o[8] = {bf_lo(b.x) + a0[0], bf_hi(b.x) + a0[1], bf_lo(b.y) + a0[2], bf_hi(b.y) + a0[3], bf_lo(b.z) + a1[0], bf_hi(b.z) + a1[1], bf_lo(b.w) + a1[2], bf_hi(b.w) + a1[3]};
#pragma unroll
                for (int e = 0; e < 8; ++e) s += o[e] * o[e];
                u32x4 w; w.x = cvt_pk_bf16(o[0], o[1]); w.y = cvt_pk_bf16(o[2], o[3]); w.z = cvt_pk_bf16(o[4], o[5]); w.w = cvt_pk_bf16(o[6], o[7]);
                *(u32x4*)(xb + (size_t)row * 1024 + col0 + bj * 128) = w; }
            s += __shfl_xor(s, 16); s += __shfl_xor(s, 32);
            if (fq == 0) atomicAdd(ss + row, s); }
        return false;
    }
};
struct EpiUp {
    static constexpr bool PERM = true, TWICE = (EPI2 == 6);
    bf16_t* H; const float* ss;
    __device__ __forceinline__ bool operator()(Acc& acc, const Unit& u, int wr, int wc, int fr, int fq) const {
        asm volatile("" : "+v"(fr), "+v"(fq));
        const int row0 = u.pm * 256 + wr * 64 + fr, col0 = u.pn * 256 + wc * 32 + 8 * fq;
        float rv[8];
#pragma unroll
        for (int idx = 0; idx < 8; ++idx) rv[idx] = ss[row0 + (idx >> 2) * 128 + (idx & 3) * 16];
#pragma unroll
        for (int ai = 0; ai < 2; ++ai)
#pragma unroll
            for (int m = 0; m < 4; ++m) { const int row = row0 + ai * 128 + m * 16; const float rinv = rsqrtf(rv[ai * 4 + m] * (1.0f / 1024.0f) + RMS_EPS);
#pragma unroll
                for (int bj = 0; bj < 2; ++bj) { f32x4 v0 = acc[ai][bj][m][0], v1 = acc[ai][bj][m][1];
#pragma unroll
                    for (int e = 0; e < 4; ++e) { const float a = fmaxf(v0[e] * rinv, 0.f), b = fmaxf(v1[e] * rinv, 0.f); v0[e] = a * a; v1[e] = b * b; }
                    u32x4 w; w.x = cvt_pk_bf16(v0[0], v0[1]); w.y = cvt_pk_bf16(v0[2], v0[3]); w.z = cvt_pk_bf16(v1[0], v1[1]); w.w = cvt_pk_bf16(v1[2], v1[3]);
                    *(u32x4*)(H + (size_t)row * 4096 + col0 + bj * 128) = w; } }
        return false;
    }
};

__device__ __forceinline__ void p0_transpose_item(const float* W, int K, int N, bf16_t* WT, int out_row0, int n0, int k0, const float* sc, float mul, LAS float* scr, int lane) {
    float tv[32];
#pragma unroll
    for (int i = 0; i < 32; ++i) { const int kk = 2 * i + (lane >> 5); tv[i] = W[(size_t)(k0 + kk) * N + n0 + (lane & 31)]; }
#pragma unroll
    for (int i = 0; i < 32; ++i) { const int kk = 2 * i + (lane >> 5); const float s = sc ? sc[k0 + kk] * mul : mul; scr[kk * 33 + (lane & 31)] = tv[i] * s; }
    asm volatile("s_waitcnt lgkmcnt(0)" ::: "memory");
    const int c = lane & 7;
#pragma unroll
    for (int j = 0; j < 4; ++j) { const int n = (lane >> 3) + 8 * j; const LAS float* s = scr + (8 * c) * 33 + n;
        u32x4 o; o.x = cvt_pk_bf16(s[0 * 33], s[1 * 33]); o.y = cvt_pk_bf16(s[2 * 33], s[3 * 33]); o.z = cvt_pk_bf16(s[4 * 33], s[5 * 33]); o.w = cvt_pk_bf16(s[6 * 33], s[7 * 33]);
        *(u32x4*)(WT + (size_t)(out_row0 + n) * K + k0 + 8 * c) = o; }
    asm volatile("s_waitcnt lgkmcnt(0)" ::: "memory");
}

template <int PART> __device__ __forceinline__ void p0_prologue(const Params& p, LAS unsigned char* lds, int bx, int G) {
    const int tid = threadIdx.x, lane = tid & 63, wid = tid >> 6;
    const int gw = bx * 8 + wid, NGW = G * 8, gt = bx * 512 + tid, NGT = G * 512;
    unsigned char* ws = p.ws;
    if (PART == 0) for (int i = gt; i < MT; i += NGT) { ((float*)(ws + SS1_OFF))[i] = 0.f; ((float*)(ws + SS2_OFF))[i] = 0.f; }
    for (int r0_ = 0; r0_ < (P0REP == 0 ? 2 : 1); ++r0_)
    if (PART == 0 && bx < 24) {
        LAS float* hm = (LAS float*)lds;
        LAS float* red = (LAS float*)(lds + 65536);
        for (int r = wid * 2; r < wid * 2 + 2; ++r) { float v[16]; float s = 0.f;
#pragma unroll
            for (int j = 0; j < 16; ++j) { v[j] = p.meta[r * 1024 + lane + 64 * j]; s += v[j] * v[j]; }
            const float rinv = rsqrtf(wave_sum(s) * (1.0f / 1024.0f) + RMS_EPS);
#pragma unroll
            for (int j = 0; j < 16; ++j) hm[r * 1024 + lane + 64 * j] = v[j] * rinv * p.g_mix[lane + 64 * j]; }
        __syncthreads();
        const int n = 512 + bx * 64 + lane; float a[16];
#pragma unroll
        for (int r = 0; r < 16; ++r) a[r] = 0.f;
        for (int k0 = wid * 128; k0 < wid * 128 + 128; k0 += 16) { float w[16];
#pragma unroll
            for (int q = 0; q < 16; ++q) w[q] = p.w_in[(size_t)(k0 + q) * 4096 + n];
#pragma unroll
            for (int q = 0; q < 16; ++q)
#pragma unroll
                for (int r = 0; r < 16; ++r) a[r] += hm[r * 1024 + k0 + q] * w[q]; }
#pragma unroll
        for (int r = 0; r < 16; ++r) red[(wid * 16 + r) * 64 + lane] = a[r];
        __syncthreads();
        for (int o = tid; o < 1024; o += 512) { const int r = o >> 6, l = o & 63; float s = 0.f;
#pragma unroll
            for (int w = 0; w < 8; ++w) s += red[(w * 16 + r) * 64 + l];
            const int nn = 512 + bx * 64 + l; const bf16_t hv = (bf16_t)(cvt_pk_bf16(s, 0.f) & 0xffffu);
            if (nn < 1024) ((bf16_t*)(ws + KMETA_OFF))[r * 512 + nn - 512] = hv;
            else if (nn < 1536) ((bf16_t*)(ws + VMETAT_OFF))[(nn - 1024) * 16 + r] = hv;
            else { const int ch = nn - 1536;
                for (int b = 0; b < 8; ++b) { bf16_t* ut = (bf16_t*)(ws + UT_OFF) + (b < 4 ? (size_t)b * 512 * NP + (size_t)ch * NP : (size_t)4 * 512 * NP + (size_t)(b - 4) * 512 * NS + (size_t)ch * NS); ut[r] = hv; } } }
        __syncthreads();
    }
    for (int r1_ = 0; r1_ < (P0REP == 1 ? 2 : 1); ++r1_)
    if (PART == 0 || PART == 2) {
        LAS float* scr = (LAS float*)(lds + wid * 8448);
        constexpr int I_IN = 16 * 128, I_UP = 16 * 128, I_DN = 64 * 32, I_OUT = 16 * 32, I_NA = 8 * 32, NIT = I_IN + I_UP + I_DN + I_OUT + I_NA;
        for (int it = (PART == 0 ? 0 : I_IN) + gw; it < (PART == 0 ? I_IN : NIT); it += NGW) {
            int r = it;
            if (r < I_IN) { const int kb = r / 128, nb = r % 128, n0 = nb * 32; bf16_t* dst; int orow; float mul = 1.f;
                if (n0 < 512) { dst = (bf16_t*)(ws + WINA_OFF); orow = n0; mul = 0.125f; } else if (n0 < 1024) { dst = (bf16_t*)(ws + WINA_OFF); orow = n0; }
                else if (n0 < 2048) { dst = (bf16_t*)(ws + WINB_OFF); orow = n0 - 1024; }
                else { const int isfn = n0 >= 3072, gc = n0 - (isfn ? 3072 : 2048); dst = (bf16_t*)(ws + WINA_OFF); orow = 1024 + 256 * (gc >> 7) + 128 * isfn + (gc & 127); }
                p0_transpose_item(p.w_in, 1024, 4096, dst, orow, n0, kb * 64, p.g_mix, mul, scr, lane); continue; } r -= I_IN;
            if (r < I_UP) { const int kb = r / 128, nb = r % 128; p0_transpose_item(p.w_up, 1024, 4096, (bf16_t*)(ws + WUP_OFF), nb * 32, nb * 32, kb * 64, p.g_mlp, 1.f, scr, lane); continue; } r -= I_UP;
            if (r < I_DN) { const int kb = r / 32, nb = r % 32; p0_transpose_item(p.w_down, 4096, 1024, (bf16_t*)(ws + WDN_OFF), nb * 32, nb * 32, kb * 64, nullptr, 1.f, scr, lane); continue; } r -= I_DN;
            if (r < I_OUT) { const int kb = r / 32, nb = r % 32; p0_transpose_item(p.w_out, 1024, 1024, (bf16_t*)(ws + WOUT_OFF), nb * 32, nb * 32, kb * 64, nullptr, 1.f, scr, lane); continue; } r -= I_OUT;
            { const int kb = r / 32, nb = r % 32; p0_transpose_item(p.w_na, 512, 1024, (bf16_t*)(ws + WNA_OFF), nb * 32, nb * 32, kb * 64, nullptr, 1.f, scr, lane); }
        }
    }
    for (int r2_ = 0; r2_ < (P0REP == 2 ? 2 : 1); ++r2_)
    if (PART == 2) for (int tw = gw; tw < 64 * 4 * 2; tw += NGW) {
        const int twu = __builtin_amdgcn_readfirstlane(tw); const int c = (twu & 1) * 64 + lane, g = (twu >> 1) & 3, d0 = (twu >> 3) * 16;
        float ac[16], as[16];
#pragma unroll
        for (int q = 0; q < 16; ++q) { ac[q] = 0.f; as[q] = 0.f; }
        const float* wf = p.w_fn + (size_t)g * 128 * 1024 + d0;
#pragma unroll 2
        for (int cp = 0; cp < 128; ++cp) { const float tr = (float)((c * cp) & 127) * (1.0f / 128.0f); const float co = __builtin_amdgcn_cosf(tr), si = __builtin_amdgcn_sinf(tr);
            f32x4 w[4];
#pragma unroll
            for (int q = 0; q < 4; ++q) w[q] = *(const __attribute__((address_space(4))) f32x4*)(unsigned long long)(wf + (size_t)cp * 1024 + 4 * q);
#pragma unroll
            for (int q = 0; q < 16; ++q) { ac[q] += co * w[q >> 2][q & 3]; as[q] -= si * w[q >> 2][q & 3]; } }
        bf16_t* o = (bf16_t*)(ws + WFN_OFF) + (size_t)d0 * 1024 + g * 128 + c;
#pragma unroll
        for (int q = 0; q < 16; ++q) { o[(size_t)q * 1024] = (bf16_t)(cvt_pk_bf16(ac[q], 0.f) & 0xffffu); o[(size_t)q * 1024 + 512] = (bf16_t)(cvt_pk_bf16(as[q], 0.f) & 0xffffu); } }
    for (int r3_ = 0; r3_ < (P0REP == 3 ? 2 : 1); ++r3_)
    if (PART == 1) {
        constexpr int IP = MRP * (KPP / 8), IS = MRS * (KPS / 8);
        for (int it = gt; it < IP + IS; it += NGT) {
            int i, j, N, KP; bf16_t* cm; bf16_t* sm;
            if (it < IP) { i = it / (KPP / 8); j = it % (KPP / 8); N = NP; KP = KPP; cm = (bf16_t*)(ws + CP_OFF); sm = (bf16_t*)(ws + SP_OFF); }
            else { const int q = it - IP; i = q / (KPS / 8); j = q % (KPS / 8); N = NS; KP = KPS; cm = (bf16_t*)(ws + CS_OFF); sm = (bf16_t*)(ws + SSM_OFF); }
            const int np = i + 1, HN = N / 2; const float norm = rsqrtf(128.0f * (float)N), invN = 1.0f / (float)N;
            float cv[8], sv[8]; int mm; { const unsigned prod = (unsigned)np * (unsigned)(8 * j); unsigned q = (unsigned)((float)prod * invN); if (q > 0) --q; mm = (int)(prod - q * (unsigned)N); while (mm >= N) mm -= N; }
#pragma unroll
            for (int e = 0; e < 8; ++e) { const int k = 8 * j + e; const bool ok = (np <= HN) && (k <= HN); const float tr = (float)mm * invN;
                cv[e] = ok ? __builtin_amdgcn_cosf(tr) * norm : 0.f; sv[e] = ok ? __builtin_amdgcn_sinf(tr) * norm : 0.f; mm += np; if (mm >= N) mm -= N; }
            u32x4 wc_, ws_; wc_.x = cvt_pk_bf16(cv[0], cv[1]); wc_.y = cvt_pk_bf16(cv[2], cv[3]); wc_.z = cvt_pk_bf16(cv[4], cv[5]); wc_.w = cvt_pk_bf16(cv[6], cv[7]);
            ws_.x = cvt_pk_bf16(sv[0], sv[1]); ws_.y = cvt_pk_bf16(sv[2], sv[3]); ws_.z = cvt_pk_bf16(sv[4], sv[5]); ws_.w = cvt_pk_bf16(sv[6], sv[7]);
            *(u32x4*)(cm + (size_t)i * KP + 8 * j) = wc_; *(u32x4*)(sm + (size_t)i * KP + 8 * j) = ws_;
        }
    }
    if (PART == 0) {
        constexpr int NCH = MT / 4;
        const bool uneven = (G == 256); const int nm = 24 * 8, nn = 256 * 8 - nm;
        for (int itx = 0; ; ++itx) {
            int chunk;
            if (!uneven) chunk = gw + itx * NGW;
            else if (bx >= 24) { const int wp = gw - nm; chunk = itx < 6 ? itx * nn + wp : (itx == 6 && wp < NCH - 6 * nn - 4 * nm ? 6 * nn + 4 * nm + wp : NCH); }
            else chunk = itx < 4 ? 6 * nn + gw * 4 + itx : NCH;
            if (chunk >= NCH) break;
            f32x4 v[4][4];
#pragma unroll
            for (int q = 0; q < 4; ++q) { const int g = chunk * 4 + q; const float* xr = g < 4 * TP ? p.xp + (size_t)g * 1024 : p.xs + (size_t)(g - 4 * TP) * 1024;
#pragma unroll
                for (int j = 0; j < 4; ++j) v[q][j] = ((const f32x4*)xr)[lane + 64 * j]; }
#pragma unroll
            for (int q = 0; q < 4; ++q) { const int g = chunk * 4 + q; float s = 0.f;
#pragma unroll
                for (int j = 0; j < 4; ++j) s += (v[q][j][0] * v[q][j][0] + v[q][j][1] * v[q][j][1]) + (v[q][j][2] * v[q][j][2] + v[q][j][3] * v[q][j][3]);
                const float rinv = rsqrtf(wave_sum(s) * (1.0f / 1024.0f) + RMS_EPS);
                u32x2* o = (u32x2*)((bf16_t*)(ws + XB_OFF) + (size_t)g * 1024);
#pragma unroll
                for (int j = 0; j < 4; ++j) { u32x2 w; w.x = cvt_pk_bf16(v[q][j][0] * rinv, v[q][j][1] * rinv); w.y = cvt_pk_bf16(v[q][j][2] * rinv, v[q][j][3] * rinv); o[lane + 64 * j] = w; } }
        }
    }
}

constexpr int A_KS = 0, A_VS = 73728, A_KM = 147456, A_VM = 149504, A_BS = 151552, A_MB = 155392;
__device__ __forceinline__ void attn_units(const Params& p, LAS unsigned char* lds, const int u_lo, const int u_hi) {
    const int tid = threadIdx.x, lane = tid & 63, wid = __builtin_amdgcn_readfirstlane(tid >> 6), G = gridDim.x, bx = blockIdx.x;
    const int li = lane & 15, g = lane >> 4;
    unsigned char* ws = p.ws;
    const bf16_t* Qb = (const bf16_t*)(ws + Q_OFF); const bf16_t* Kb = (const bf16_t*)(ws + K_OFF); const bf16_t* VT = (const bf16_t*)(ws + VT_OFF);
    bf16_t* att = (bf16_t*)(ws + ATT_OFF);
    int pb = -1, ph = -1, hiR = -1;
    const int sr = tid >> 3, sch = tid & 7;
    u32x4 pf[4]; int pfn = 0, pfR0 = 0;
    for (int un = u_lo; un < u_hi; ++un) {
        int b, h, rp, rows;
        if (un < 2048) { b = un >> 9; h = (un >> 6) & 7; rp = un & 63; rows = 128; } else { const int v = un - 2048; b = 4 + (v >> 8); h = (v >> 5) & 7; rp = v & 31; rows = 64; }
        const int gb = batch_base(b), T = rows * 64, r0 = 2 * rp;
        const int rsA = min(max(r0 - 4, 0), rows - 8), needHi = min(rsA + 8, rows - 1);
        if (b != pb || h != ph) {
            __syncthreads();
            { u32x4 kvv[9], vvv[9];
#pragma unroll
              for (int j = 0; j < 9; ++j) { const int R = min(rsA + j, needHi);
                kvv[j] = *(const u32x4*)(Kb + (size_t)(gb + R * 64 + sr) * 512 + h * 64 + sch * 8);
                vvv[j] = *(const u32x4*)(VT + (size_t)512 * gb + (size_t)(h * 64 + sr) * T + R * 64 + sch * 8); }
#pragma unroll
              for (int j = 0; j < 9; ++j) { const int sl = min(rsA + j, needHi) % 9;
                *(LAS u32x4*)(lds + A_KS + sl * 8192 + sr * 128 + ((sch ^ (sr & 7)) * 16)) = kvv[j];
                *(LAS u32x4*)(lds + A_VS + sl * 8192 + sr * 128 + ((sch ^ ((sr >> 1) & 7)) * 16)) = vvv[j]; } }
            if (tid < 128) { const int r = tid >> 3, ch = tid & 7; *(LAS u32x4*)(lds + A_KM + r * 128 + ((ch ^ (r & 7)) * 16)) = *(const u32x4*)((const bf16_t*)(ws + KMETA_OFF) + r * 512 + h * 64 + ch * 8); }
            else if (tid < 256) { const int q = tid - 128; *(LAS u32x4*)(lds + A_VM + q * 16) = *(const u32x4*)((const bf16_t*)(ws + VMETAT_OFF) + h * 64 * 16 + q * 8); }
            for (int i = tid; i < 15 * 64; i += 512) { const int ro = i >> 6, x = (i & 63) - 16; ((LAS float*)(lds + A_BS))[i] = (x >= 0 && x <= 30) ? p.rel_bias[(h * 15 + ro) * 31 + x] : 0.f; }
            if (tid < 16) ((LAS float*)(lds + A_MB))[tid] = p.meta_bias[h * 16 + tid];
            pb = b; ph = h; hiR = needHi;
        } else {
#pragma unroll
            for (int j = 0; j < 2; ++j) if (j < pfn) { const int sl = (pfR0 + j) % 9;
                *(LAS u32x4*)(lds + A_KS + sl * 8192 + sr * 128 + ((sch ^ (sr & 7)) * 16)) = pf[2 * j];
                *(LAS u32x4*)(lds + A_VS + sl * 8192 + sr * 128 + ((sch ^ ((sr >> 1) & 7)) * 16)) = pf[2 * j + 1]; }
            hiR = needHi;
        }
        __syncthreads();
        pfn = 0;
        if (un + 1 < u_hi) { const int un2 = un + 1; int b2, h2, rp2;
            if (un2 < 2048) { b2 = un2 >> 9; h2 = (un2 >> 6) & 7; rp2 = un2 & 63; } else { const int v = un2 - 2048; b2 = 4 + (v >> 8); h2 = (v >> 5) & 7; rp2 = v & 31; }
            if (b2 == b && h2 == h) { const int rsA2 = min(max(2 * rp2 - 4, 0), rows - 8), nh2 = min(rsA2 + 8, rows - 1); pfR0 = hiR + 1; pfn = nh2 - hiR;
#pragma unroll
                for (int j = 0; j < 2; ++j) if (j < pfn) { const int R = pfR0 + j;
                    pf[2 * j] = *(const u32x4*)(Kb + (size_t)(gb + R * 64 + sr) * 512 + h * 64 + sch * 8);
                    pf[2 * j + 1] = *(const u32x4*)(VT + (size_t)512 * gb + (size_t)(h * 64 + sr) * T + R * 64 + sch * 8); } } }
        const int r = r0 + (wid >> 2), c0 = 16 * (wid & 3), kc0 = min(max(c0 - 8, 0), 32);
        const int rs = min(max(r - 4, 0), rows - 8);
        int slot[8];
        { const int s0 = rs % 9;
#pragma unroll
          for (int w = 0; w < 8; ++w) slot[w] = (s0 + w >= 9) ? s0 + w - 9 : s0 + w; }
        const int c = c0 + li, cs = min(max(c - 8, 0), 48);
        const size_t qrow = (size_t)(gb + r * 64 + c);
        bf16x8 qf[2];
        qf[0] = *(const bf16x8*)(Qb + qrow * 512 + h * 64 + 8 * g); qf[1] = *(const bf16x8*)(Qb + qrow * 512 + h * 64 + 32 + 8 * g);
        f32x4 sa[8][2]; f32x4 sm_;
        {
            const int kr0 = kc0 + li;
#pragma unroll
            for (int w = 0; w < 8; ++w)
#pragma unroll
                for (int j = 0; j < 2; ++j) { const int kr = kr0 + 16 * j; const LAS unsigned char* rowp = lds + A_KS + slot[w] * 8192 + kr * 128;
                    const bf16x8 a0 = *(const LAS bf16x8*)(rowp + ((g ^ (kr & 7)) * 16)), a1 = *(const LAS bf16x8*)(rowp + (((g + 4) ^ (kr & 7)) * 16));
                    f32x4 z = (f32x4){0.f, 0.f, 0.f, 0.f};
                    z = __builtin_amdgcn_mfma_f32_16x16x32_bf16(a0, qf[0], z, 0, 0, 0); sa[w][j] = __builtin_amdgcn_mfma_f32_16x16x32_bf16(a1, qf[1], z, 0, 0, 0); }
            const LAS unsigned char* rowp = lds + A_KM + li * 128;
            const bf16x8 a0 = *(const LAS bf16x8*)(rowp + ((g ^ (li & 7)) * 16)), a1 = *(const LAS bf16x8*)(rowp + (((g + 4) ^ (li & 7)) * 16));
            f32x4 z = (f32x4){0.f, 0.f, 0.f, 0.f};
            z = __builtin_amdgcn_mfma_f32_16x16x32_bf16(a0, qf[0], z, 0, 0, 0); sm_ = __builtin_amdgcn_mfma_f32_16x16x32_bf16(a1, qf[1], z, 0, 0, 0);
        }
        const int dl = kc0 + 4 * g - cs;
        const LAS float* bsp = (const LAS float*)(lds + A_BS) + (rs - r + 7) * 64 + (kc0 + 4 * g - c + 31);
        float mx = -1e30f;
#pragma unroll
        for (int w = 0; w < 8; ++w)
#pragma unroll
            for (int j = 0; j < 2; ++j)
#pragma unroll
                for (int e = 0; e < 4; ++e) { const bool ok = (unsigned)(dl + 16 * j + e) < 16u; const float bv = bsp[w * 64 + 16 * j + e];
                    float sv = sa[w][j][e] + bv; sv = ok ? sv : -1e30f; sa[w][j][e] = sv; mx = fmaxf(mx, sv); }
#pragma unroll
        for (int e = 0; e < 4; ++e) { sm_[e] += ((const LAS float*)(lds + A_MB))[4 * g + e]; mx = fmaxf(mx, sm_[e]); }
        mx = fmaxf(mx, __shfl_xor(mx, 16)); mx = fmaxf(mx, __shfl_xor(mx, 32));
        const float mxl = mx * 1.44269504f; float sum = 0.f;
#pragma unroll
        for (int w = 0; w < 8; ++w)
#pragma unroll
            for (int j = 0; j < 2; ++j)
#pragma unroll
                for (int e = 0; e < 4; ++e) { const float pe = __builtin_amdgcn_exp2f(sa[w][j][e] * 1.44269504f - mxl); sa[w][j][e] = pe; sum += pe; }
#pragma unroll
        for (int e = 0; e < 4; ++e) { const float pe = __builtin_amdgcn_exp2f(sm_[e] * 1.44269504f - mxl); sm_[e] = pe; sum += pe; }
        sum += __shfl_xor(sum, 16); sum += __shfl_xor(sum, 32);
        const float rsum = 1.0f / sum;
        f32x4 o[4];
#pragma unroll
        for (int dt = 0; dt < 4; ++dt) o[dt] = (f32x4){0.f, 0.f, 0.f, 0.f};
        const int c8 = (kc0 >> 2) + g;
#pragma unroll
        for (int w = 0; w < 8; ++w) { u32x4 pw; pw.x = cvt_pk_bf16(sa[w][0][0], sa[w][0][1]); pw.y = cvt_pk_bf16(sa[w][0][2], sa[w][0][3]); pw.z = cvt_pk_bf16(sa[w][1][0], sa[w][1][1]); pw.w = cvt_pk_bf16(sa[w][1][2], sa[w][1][3]);
            const bf16x8 pbv = __builtin_bit_cast(bf16x8, pw);
#pragma unroll
            for (int dt = 0; dt < 4; ++dt) { const int d = 16 * dt + li, sw = 2 * ((d >> 1) & 7); const LAS unsigned char* rowp = lds + A_VS + slot[w] * 8192 + d * 128;
                const u32x2 lo = *(const LAS u32x2*)(rowp + ((c8 ^ sw) * 8)), hi = *(const LAS u32x2*)(rowp + (((c8 + 4) ^ sw) * 8));
                u32x4 av; av.x = lo.x; av.y = lo.y; av.z = hi.x; av.w = hi.y;
                o[dt] = __builtin_amdgcn_mfma_f32_16x16x32_bf16(__builtin_bit_cast(bf16x8, av), pbv, o[dt], 0, 0, 0); } }
        { u32x4 pw; pw.x = cvt_pk_bf16(sm_[0], sm_[1]); pw.y = cvt_pk_bf16(sm_[2], sm_[3]); pw.z = 0u; pw.w = 0u; const bf16x8 pbv = __builtin_bit_cast(bf16x8, pw);
#pragma unroll
            for (int dt = 0; dt < 4; ++dt) { const int d = 16 * dt + li; const u32x2 lo = *(const LAS u32x2*)(lds + A_VM + d * 32 + g * 8);
                u32x4 av; av.x = lo.x; av.y = lo.y; av.z = 0u; av.w = 0u;
                o[dt] = __builtin_amdgcn_mfma_f32_16x16x32_bf16(__builtin_bit_cast(bf16x8, av), pbv, o[dt], 0, 0, 0); } }
#pragma unroll
        for (int dt = 0; dt < 4; ++dt) { u32x2 w; w.x = cvt_pk_bf16(o[dt][0] * rsum, o[dt][1] * rsum); w.y = cvt_pk_bf16(o[dt][2] * rsum, o[dt][3] * rsum);
            *(u32x2*)(att + qrow * 512 + h * 64 + 16 * dt + 4 * g) = w; }
        __syncthreads();
    }
}
__device__ __forceinline__ void dft_prep(const Params& p) {
    const int tid = threadIdx.x, G = gridDim.x, bx = blockIdx.x; unsigned char* ws = p.ws;
    {
        const int gt = bx * 512 + tid, NGT = G * 512;
        constexpr int IPP = 4 * 512 * (KPP / 8), IPS = 4 * 512 * (KPS / 8);
        for (int it = gt; it < IPP + IPS; it += NGT) {
            int b, ch, j, N, KP; size_t ub, eb;
            if (it < IPP) { b = it / (512 * (KPP / 8)); const int q = it % (512 * (KPP / 8)); ch = q / (KPP / 8); j = q % (KPP / 8); N = NP; KP = KPP; ub = ((size_t)b * 512 + ch) * NP; eb = ((size_t)b * 512 + ch) * KPP; }
            else { const int v = it - IPP; b = v / (512 * (KPS / 8)); const int q = v % (512 * (KPS / 8)); ch = q / (KPS / 8); j = q % (KPS / 8); N = NS; KP = KPS;
                ub = (size_t)4 * 512 * NP + ((size_t)b * 512 + ch) * NS; eb = (size_t)4 * 512 * KPP + ((size_t)b * 512 + ch) * KPS; }
            (void)KP;
            const bf16_t* ut = (const bf16_t*)(ws + UT_OFF) + ub; const int HN = N / 2, k0 = 8 * j;
            float ev[8], ov[8];
            if (k0 < HN) { const u32x4 f = *(const u32x4*)(ut + k0); const u32x4 rv = *(const u32x4*)(ut + N - k0 - 8);
                const float fw[8] = {bf_lo(f.x), bf_hi(f.x), bf_lo(f.y), bf_hi(f.y), bf_lo(f.z), bf_hi(f.z), bf_lo(f.w), bf_hi(f.w)};
                const float rr[8] = {bf_lo(rv.x), bf_hi(rv.x), bf_lo(rv.y), bf_hi(rv.y), bf_lo(rv.z), bf_hi(rv.z), bf_lo(rv.w), bf_hi(rv.w)};
                const float r0v = (k0 > 0) ? __uint_as_float((unsigned)ut[N - k0] << 16) : 0.f;
#pragma unroll
                for (int e = 0; e < 8; ++e) { const float rvv = (e == 0) ? r0v : rr[8 - e]; ev[e] = fw[e] + rvv; ov[e] = fw[e] - rvv; }
                if (k0 == 0) { ev[0] = fw[0]; ov[0] = 0.f; } }
            else {
#pragma unroll
                for (int e = 0; e < 8; ++e) { ev[e] = 0.f; ov[e] = 0.f; }
                if (k0 == HN) ev[0] = __uint_as_float((unsigned)ut[HN] << 16); }
            u32x4 we, wo; we.x = cvt_pk_bf16(ev[0], ev[1]); we.y = cvt_pk_bf16(ev[2], ev[3]); we.z = cvt_pk_bf16(ev[4], ev[5]); we.w = cvt_pk_bf16(ev[6], ev[7]);
            wo.x = cvt_pk_bf16(ov[0], ov[1]); wo.y = cvt_pk_bf16(ov[2], ov[3]); wo.z = cvt_pk_bf16(ov[4], ov[5]); wo.w = cvt_pk_bf16(ov[6], ov[7]);
            *(u32x4*)((bf16_t*)(ws + UE_OFF) + eb + k0) = we; *(u32x4*)((bf16_t*)(ws + UO_OFF) + eb + k0) = wo;
        }
    }
}

#define XB_TMO      128
#define XB_XCNT(j)  (256  + 64 * (j))
#define XB_XSUB(j)  (1280 + 64 * (j))
#define XB_XGEN(j)  (2304 + 64 * (j))
#define XB_TOP      3328
#define XB_TOPGEN   3392
#define XCD_BAR_WORDS 3456
#define XB_SPIN_CAP (1u << 18)

__device__ __forceinline__ unsigned xb_ld(unsigned* p)              { return __hip_atomic_load(p, __ATOMIC_RELAXED, __HIP_MEMORY_SCOPE_AGENT); }
__device__ __forceinline__ unsigned xb_add(unsigned* p, unsigned v) { return __hip_atomic_fetch_add(p, v, __ATOMIC_RELAXED, __HIP_MEMORY_SCOPE_AGENT); }
__device__ __forceinline__ unsigned xb_xcc_id() { return (unsigned)__builtin_amdgcn_s_getreg((3 << 11) | 20) & 0xFu; }
#define XB_SPIN(cond, bar) do { unsigned _sp = 0; while (cond) { __builtin_amdgcn_s_sleep(1); \
    if ((++_sp & 255u) == 0u) { if (xb_ld(&(bar)[XB_TMO])) break; if (_sp > XB_SPIN_CAP) { atomicAdd(&(bar)[XB_TMO], 1u); break; } } } } while (0)

struct XcdBarrier {
    unsigned* bar; unsigned x;
    volatile LAS unsigned* st;
};

__device__ __forceinline__ XcdBarrier xcd_barrier_post(unsigned* bar, volatile LAS unsigned* st) {
    XcdBarrier b; b.bar = bar; b.x = xb_xcc_id(); b.st = st;
    if (threadIdx.x == 0) (void)xb_add(&bar[XB_XCNT(b.x)], 1u);
    return b;
}
__device__ __forceinline__ void xcd_barrier_complete(unsigned* bar, unsigned x, unsigned& nloc, unsigned& nx) {
    const unsigned G = gridDim.x * gridDim.y * gridDim.z;
    unsigned sum, cnt, mine, sp = 0u;
    for (;;) {
        sum = 0u; cnt = 0u; mine = 0u;
#pragma unroll
        for (unsigned j = 0; j < 16; ++j) { const unsigned c = xb_ld(&bar[XB_XCNT(j)]); sum += c; cnt += (c > 0u) ? 1u : 0u; mine = (j == x) ? c : mine; }
        if (sum == G) break;
        __builtin_amdgcn_s_sleep(1);
        if ((++sp & 255u) == 0u) { if (xb_ld(&bar[XB_TMO])) break; if (sp > XB_SPIN_CAP) { atomicAdd(&bar[XB_TMO], 1u); break; } }
    }
    nloc = mine > 0u ? mine : 1u; nx = cnt > 0u ? cnt : 1u;
}

__device__ __forceinline__ void xcd_barrier(const XcdBarrier& b) {
    asm volatile("s_waitcnt vmcnt(0)" ::: "memory");
    __syncthreads();
    if (threadIdx.x == 0) {
        unsigned* bar = b.bar;
        __builtin_amdgcn_s_waitcnt(0);
        unsigned nloc = b.st[0], nx = b.st[1];
        if (nloc == 0u) { xcd_barrier_complete(bar, b.x, nloc, nx); b.st[0] = nloc; b.st[1] = nx; }
        const unsigned old = xb_add(&bar[XB_XSUB(b.x)], 1u);
        const unsigned gen = old / nloc;
        if (old + 1u == (gen + 1u) * nloc) {
            __builtin_amdgcn_fence(__ATOMIC_RELEASE, "agent");
            asm volatile("s_waitcnt vmcnt(0)" ::: "memory");
            const unsigned og = xb_add(&bar[XB_TOP], 1u);
            const unsigned tg = og / nx;
            if (og + 1u == (tg + 1u) * nx) xb_add(&bar[XB_TOPGEN], 1u);
            else XB_SPIN(xb_ld(&bar[XB_TOPGEN]) == tg, bar);
            __builtin_amdgcn_fence(__ATOMIC_ACQUIRE, "agent");
            xb_add(&bar[XB_XGEN(b.x)], 1u);
            asm volatile("s_waitcnt vmcnt(0)" ::: "memory");
        } else {
            XB_SPIN(xb_ld(&bar[XB_XGEN(b.x)]) == gen, bar);
            __builtin_amdgcn_fence(__ATOMIC_ACQUIRE, "agent");
            asm volatile("s_waitcnt vmcnt(0)" ::: "memory");
        }
    }
    __syncthreads();
}


#ifndef STG_W6
#define STG_W6 0
#endif
__device__ __forceinline__ void phase_stagger(int w_ticks) {
    if (w_ticks > 0) { const int bx = blockIdx.x, rank = (bx & 7) * (gridDim.x >> 3) + (bx >> 3);
        const unsigned long long t1 = __builtin_amdgcn_s_memrealtime() + (unsigned long long)((long)w_ticks * rank / gridDim.x);
        while (__builtin_amdgcn_s_memrealtime() < t1) __builtin_amdgcn_s_sleep(8); }
}
__global__ void __launch_bounds__(512, 2) mega_fwd(Params p) {
    extern __shared__ __attribute__((aligned(16))) unsigned char lds_raw[];
    LAS unsigned char* lds = (LAS unsigned char*)lds_raw;
    const int lo = p.ph_lo, hi = p.ph_hi, G = gridDim.x, bx = blockIdx.x;
    unsigned char* ws = p.ws;
    unsigned long long tsa_ = 0, tsb_ = 0;
#define TSA(k) do { if (TS_PHASE == (k)) tsa_ = __builtin_amdgcn_s_memrealtime(); } while (0)
#define TSB(k) do { if (TS_PHASE == (k)) tsb_ = __builtin_amdgcn_s_memrealtime(); } while (0)
#define IN(k) (lo <= (k) && (k) < hi)
    volatile LAS unsigned* bst = (volatile LAS unsigned*)(lds + LDS_BYTES - 64);
    if (threadIdx.x < 2) bst[threadIdx.x] = 0u;
    __syncthreads();
    if (bx == 0) { for (int i = threadIdx.x; i < 4096; i += 512) __hip_atomic_store((unsigned*)ws + i, 0u, __ATOMIC_RELAXED, __HIP_MEMORY_SCOPE_AGENT); }
    if (hi - lo > 1) cg::this_grid().sync();
    XcdBarrier xbar = xcd_barrier_post((unsigned*)ws, bst);
#define SEAM(k) do { if (IN(k) && IN((k) + 1)) { xcd_barrier(xbar); } } while (0)
#define REPS(k) for (int rep_ = 0; rep_ < ((REP_PHASE == (k)) ? 2 : 1); ++rep_)
#define REPSYNC(k) do { if (REP_PHASE == (k) && rep_ == 0) cg::this_grid().sync(); } while (0)
    TSA(0);
    if (IN(0)) REPS(0) { p0_prologue<0>(p, lds, bx, G); __syncthreads(); REPSYNC(0); }
    SEAM(0); TSB(0);
    TSA(1);
    if (IN(1)) REPS(1) {
        { SchedRect<1> S{}; S.A0 = (const char*)(ws + XB_OFF); S.B0 = (const char*)(ws + WINA_OFF); S.pa0 = 2048; S.nt0 = 16; S.nM = MT / 256; S.nN = 12; S.G = G; S.c = bx;
          EpiP1a E{ws, p.out}; pg8::gemm_phase<false>(lds, S, E); }
        { SchedRect<1> S{}; S.A0 = (const char*)(ws + XB_OFF); S.B0 = (const char*)(ws + WINB_OFF); S.pa0 = 2048; S.nt0 = 16; S.nM = MT / 256; S.nN = 4; S.G = G; S.c = bx;
          EpiP1b E{ws}; pg8::gemm_phase<true>(lds, S, E); }
        REPSYNC(1);
    }
    SEAM(1); TSB(1);
    TSA(2);
    if (IN(2)) REPS(2) { p0_prologue<1>(p, lds, bx, G); dft_prep(p); __syncthreads(); REPSYNC(2); }
    SEAM(2); TSB(2);
    TSA(3);
    if (IN(3)) REPS(3) { SchedDft S{(const char*)ws, G, bx}; EpiDft E{ws}; pg8::gemm_phase<false>(lds, S, E);
        int a_lo, a_hi;
        if (G == 256) {
            if (bx < 16) { a_lo = bx * 6; a_hi = a_lo + 6; } else if (bx < 80) { a_lo = 96 + (bx - 16) * 13; a_hi = a_lo + 13; } else if (bx < 160) { a_lo = 928 + (bx - 80) * 12; a_hi = a_lo + 12; }
            else { p0_prologue<2>(p, lds, bx - 160, 96); if (bx < 224) { a_lo = 1888 + (bx - 160) * 10; a_hi = a_lo + 10; } else { a_lo = 2528 + (bx - 224) * 17; a_hi = a_lo + 17; } }
        } else { p0_prologue<2>(p, lds, bx, G); const int per = (3072 + G - 1) / G; a_lo = bx * per; a_hi = min(a_lo + per, 3072); }
        __syncthreads();
        attn_units(p, lds, a_lo, a_hi);
        __syncthreads();
        REPSYNC(3); }
    SEAM(3); TSB(3);
    TSA(4);
    if (IN(4)) REPS(4) {
        SchedMerge S{(const char*)ws, G, bx};
        EpiMerge E{ws, p.out}; pg8::gemm_phase<false>(lds, S, E); REPSYNC(4);
    }
    SEAM(4); TSB(4);
    TSA(5);
    if (IN(5)) {
        SchedRect<1> S{}; S.A0 = (const char*)(ws + MIX_OFF); S.B0 = (const char*)(ws + WOUT_OFF); S.pa0 = 2048; S.nt0 = 16; S.nM = MT / 256; S.nN = 4; S.G = G; S.c = bx;
        EpiRes5 E{p.xp, p.xs, (bf16_t*)(ws + X1B_OFF), (float*)(ws + SS1_OFF)}; pg8::gemm_phase<false>(lds, S, E);
    }
    SEAM(5); TSB(5);
    TSA(6);
    if (IN(6)) REPS(6) {
        phase_stagger(STG_W6);
        SchedRect<1> S{}; S.A0 = (const char*)(ws + X1B_OFF); S.B0 = (const char*)(ws + WUP_OFF); S.pa0 = 2048; S.nt0 = 16; S.nM = MT / 256; S.nN = 16; S.G = G; S.c = bx;
        EpiUp E{(bf16_t*)(ws + H_OFF), (const float*)(ws + SS1_OFF)}; pg8::gemm_phase<false>(lds, S, E); REPSYNC(6);
    }
    SEAM(6); TSB(6);
    TSA(7);
    if (IN(7)) {
        SchedRect<1> S{}; S.A0 = (const char*)(ws + H_OFF); S.B0 = (const char*)(ws + WDN_OFF); S.pa0 = 8192; S.nt0 = 64; S.nM = MT / 256; S.nN = 4; S.G = G; S.c = bx;
        EpiRes7 E{(bf16_t*)(ws + X1B_OFF), (float*)(ws + SS2_OFF)}; pg8::gemm_phase<false>(lds, S, E);
    }
    SEAM(7); TSB(7);
    TSA(8);
    if (IN(8)) {
        const int tid = threadIdx.x, lane = tid & 63, wid = tid >> 6; const float* ss2 = (const float*)(ws + SS2_OFF);
        f32x4 gf[2][2];
#pragma unroll
        for (int j = 0; j < 2; ++j) { gf[j][0] = *(const f32x4*)(p.g_final + 512 * j + lane * 8); gf[j][1] = *(const f32x4*)(p.g_final + 512 * j + lane * 8 + 4); }
        for (int g0 = bx * 8 + wid; g0 < MT; g0 += 2 * G * 8) {
            u32x4 v[2][2]; float rinv[2];
#pragma unroll
            for (int q = 0; q < 2; ++q) { const int g = g0 + q * G * 8; if (g < MT) { const bf16_t* xr = (const bf16_t*)(ws + X1B_OFF) + (size_t)g * 1024;
                    v[q][0] = *(const u32x4*)(xr + lane * 8); v[q][1] = *(const u32x4*)(xr + 512 + lane * 8); rinv[q] = rsqrtf(ss2[g] * (1.0f / 1024.0f) + RMS_EPS); } }
#pragma unroll
            for (int q = 0; q < 2; ++q) { const int g = g0 + q * G * 8; if (g < MT) { float* o = p.out + (size_t)g * 1024;
#pragma unroll
                    for (int j = 0; j < 2; ++j) { const u32x4 b = v[q][j]; f32x4 o0, o1;
                        o0[0] = bf_lo(b.x); o0[1] = bf_hi(b.x); o0[2] = bf_lo(b.y); o0[3] = bf_hi(b.y); o1[0] = bf_lo(b.z); o1[1] = bf_hi(b.z); o1[2] = bf_lo(b.w); o1[3] = bf_hi(b.w);
                        *(f32x4*)(o + 512 * j + lane * 8) = o0 * rinv[q] * gf[j][0]; *(f32x4*)(o + 512 * j + lane * 8 + 4) = o1 * rinv[q] * gf[j][1]; } } }
        }
    }
    TSB(8);
    if (TS_PHASE >= 0 && bx == 0) { const unsigned long long t1 = __builtin_amdgcn_s_memrealtime() + (tsb_ - tsa_); while (__builtin_amdgcn_s_memrealtime() < t1) __builtin_amdgcn_s_sleep(8); }
#undef IN
#undef SEAM
}

extern "C" void kernel_launch(void* const* d_in, const int* in_sizes, int n_in, void* d_out, int out_size, void* d_ws, size_t ws_size, hipStream_t stream) {
    static int grid = 0;
    if (grid == 0) {
        if (n_in != 14 || out_size != MT * D || ws_size < WS_NEED) { fprintf(stderr, "kernel_launch: unexpected shapes (n_in %d, out %d, ws %zu)\n", n_in, out_size, ws_size); grid = -1; return; }
        int dev = 0, cus = 0, per_cu = 0;
        hipGetDevice(&dev); hipDeviceGetAttribute(&cus, hipDeviceAttributeMultiprocessorCount, dev);
        if (hipFuncSetAttribute((const void*)mega_fwd, hipFuncAttributeMaxDynamicSharedMemorySize, LDS_BYTES) != hipSuccess) { fprintf(stderr, "kernel_launch: hipFuncSetAttribute failed\n"); grid = -1; return; }
        if (hipOccupancyMaxActiveBlocksPerMultiprocessor(&per_cu, (const void*)mega_fwd, 512, LDS_BYTES) != hipSuccess || per_cu < 1) per_cu = 1;
        (void)hipGetLastError();
        grid = cus * per_cu;
    }
    if (grid < 0) return;
    Params p{};
    p.xp = (const float*)d_in[0]; p.xs = (const float*)d_in[1]; p.meta = (const float*)d_in[2]; p.w_in = (const float*)d_in[3]; p.rel_bias = (const float*)d_in[4]; p.meta_bias = (const float*)d_in[5];
    p.w_na = (const float*)d_in[6]; p.w_fn = (const float*)d_in[7]; p.w_out = (const float*)d_in[8]; p.g_mix = (const float*)d_in[9]; p.g_mlp = (const float*)d_in[10]; p.w_up = (const float*)d_in[11];
    p.w_down = (const float*)d_in[12]; p.g_final = (const float*)d_in[13]; p.out = (float*)d_out; p.ws = (unsigned char*)d_ws;
#if MK_PER_PHASE
    for (int ph = 0; ph < 9; ++ph) { p.ph_lo = ph; p.ph_hi = ph + 1; hipLaunchKernelGGL(mega_fwd, dim3(grid), dim3(512), LDS_BYTES, stream, p); }
#else
    p.ph_lo = 0; p.ph_hi = 9;
    void* args[] = {&p};
    hipError_t e = hipLaunchCooperativeKernel((const void*)mega_fwd, dim3(grid), dim3(512), args, LDS_BYTES, stream);
    if (e != hipSuccess) fprintf(stderr, "cooperative launch failed: %s (grid %d)\n", hipGetErrorString(e), grid);
#endif
}
```

```cpp
#include <hip/hip_runtime.h>
#include <hip/hip_cooperative_groups.h>
#include <cstdio>
#include <cstdint>
namespace cg = cooperative_groups;

#ifndef MK_PER_PHASE
#define MK_PER_PHASE 0
#endif

#ifndef TS_PHASE
#define TS_PHASE -1
#endif
#ifndef P0REP
#define P0REP -1
#endif
#ifndef EPI2
#define EPI2 -1
#endif
#ifndef REP_PHASE
#define REP_PHASE -1
#endif
#define LAS __attribute__((address_space(3)))
typedef unsigned short bf16_t;
typedef short bf16x8 __attribute__((ext_vector_type(8)));
typedef float f32x4 __attribute__((ext_vector_type(4)));
typedef float f32x2 __attribute__((ext_vector_type(2)));
typedef unsigned u32x4 __attribute__((ext_vector_type(4)));
typedef unsigned u32x2 __attribute__((ext_vector_type(2)));

constexpr int D = 1024, TP = 8192, TS = 4096, MT = 4 * TP + 4 * TS;
constexpr int NP = TP + 16, NS = TS + 16;
constexpr int KPP = 4224, KPS = 2176;
constexpr int MRP = 4352, MRS = 2304;
constexpr float RMS_EPS = 1e-6f;
constexpr size_t MiB = 1u << 20;
constexpr size_t SS1_OFF = 64 * 1024, SS2_OFF = 256 * 1024, KMETA_OFF = 512 * 1024, VMETAT_OFF = 528 * 1024;
constexpr size_t WINA_OFF = 1 * MiB, WINB_OFF = 7 * MiB, WUP_OFF = 9 * MiB, WDN_OFF = 17 * MiB, WOUT_OFF = 25 * MiB, WNA_OFF = 27 * MiB, WFN_OFF = 28 * MiB;
constexpr size_t XB_OFF = 30 * MiB;
constexpr size_t CP_OFF = 126 * MiB, SP_OFF = CP_OFF + (size_t)MRP * KPP * 2, CS_OFF = SP_OFF + (size_t)MRP * KPP * 2, SSM_OFF = CS_OFF + (size_t)MRS * KPS * 2;
constexpr size_t Q_OFF = 234 * MiB, K_OFF = 282 * MiB, VT_OFF = 330 * MiB, UT_OFF = 378 * MiB;
constexpr size_t ATT_OFF = 30 * MiB, UE_OFF = 427 * MiB, UO_OFF = 452 * MiB;
constexpr size_t PB_OFF = 78 * MiB, QB_OFF = 378 * MiB, MIX_OFF = 126 * MiB, X1B_OFF = 414 * MiB, H_OFF = 30 * MiB;
constexpr size_t WS_NEED = 510 * MiB;
static_assert(SSM_OFF + (size_t)MRS * KPS * 2 <= 234 * MiB, "dft matrices");
static_assert(UT_OFF + (size_t)512 * 2 * (4 * NP + 4 * NS) <= UE_OFF, "ut");
constexpr int LDS_BYTES = 160 * 1024;

__device__ __forceinline__ unsigned cvt_pk_bf16(float lo, float hi) { unsigned r; asm volatile("v_cvt_pk_bf16_f32 %0, %1, %2" : "=v"(r) : "v"(lo), "v"(hi)); return r; }
__device__ __forceinline__ float bf_lo(unsigned w) { return __uint_as_float(w << 16); }
__device__ __forceinline__ float bf_hi(unsigned w) { return __uint_as_float(w & 0xffff0000u); }
__device__ __forceinline__ float wave_sum(float v) {
#pragma unroll
    for (int o = 1; o < 64; o <<= 1) v += __shfl_xor(v, o);
    return v;
}
__device__ __forceinline__ int batch_base(int b) { return b < 4 ? b * TP : 4 * TP + (b - 4) * TS; }

struct Params {
    const float* xp; const float* xs; const float* meta; const float* w_in; const float* rel_bias; const float* meta_bias;
    const float* w_na; const float* w_fn; const float* w_out; const float* g_mix; const float* g_mlp; const float* w_up; const float* w_down; const float* g_final;
    float* out; unsigned char* ws; int ph_lo, ph_hi;
};

namespace pg8 {
constexpr int BM = 256, BK = 64, HALF = 128, HTB = HALF * BK * 2, STAGE_BYTES = 8 * HTB;
__device__ __forceinline__ int lds_byte(int r, int c) { const int st = (r >> 4) * 2 + (c >> 5), rr = r & 15, cc = c & 31, ob = rr * 64 + cc * 2; return st * 1024 + (ob ^ (((ob >> 9) & 1) << 5)); }
__device__ __forceinline__ void stage_rc(int b, int& R, int& C) { const int st = b / 1024, sb = b % 1024, swz = sb ^ (((sb >> 9) & 1) << 5); R = (st >> 1) * 16 + swz / 64; C = (st & 1) * 32 + (swz % 64) / 2; }
__device__ __forceinline__ int perm32(int rho) { const int n = rho >> 4, i = rho & 15; return 8 * (i >> 2) + 4 * n + (i & 3); }

struct Unit { const char* A; const char* B; int pa, pb, nt, pm, pn, aux; };

__device__ __forceinline__ bool rect_tile(long L, int nM, int nN, int& pm, int& pn) {
    const int nwg = nM * nN; if (L >= nwg) return false;
    int wgid = (int)L; { const int q = nwg / 8, r = nwg % 8, xcd = wgid % 8, off = wgid / 8; wgid = (xcd < r ? xcd * (q + 1) : r * (q + 1) + (xcd - r) * q) + off; }
    const int nig = 8 * nN, gid = wgid / nig, fm = gid * 8, gsz = (nM - fm) < 8 ? (nM - fm) : 8;
    pm = fm + ((wgid % nig) % gsz); pn = (wgid % nig) / gsz; return true;
}

template <bool TRANS, class Epi, class Sched>
__device__ __forceinline__ void gemm_phase(LAS unsigned char* lds, const Sched& S, const Epi& E) {
    const int tid = threadIdx.x, wid = __builtin_amdgcn_readfirstlane(tid >> 6), lane = tid & 63, wr = wid >> 2, wc = wid & 3, fr = lane & 15, fq = lane >> 4;
    int RA[2], RB[2], CB[2];
#pragma unroll
    for (int i = 0; i < 2; ++i) { int R, C; stage_rc(tid * 16 + i * 8192, R, C); RA[i] = R; RB[i] = Epi::PERM ? ((R & ~31) + perm32(R & 31)) : R; CB[i] = C * 2; }
    const unsigned ldsw = (unsigned)wid * 1024u;
    const int aoff = lds_byte(wr * 64 + fr, fq * 8), boff = lds_byte(wc * 32 + fr, fq * 8);
#define PG8_SA(b, h) (((b) * 2 + (h)) * HTB)
#define PG8_SB(b, h) ((4 + (b) * 2 + (h)) * HTB)
#define PG8_STAGE(bufoff, gbase, pitch, RR) do { _Pragma("unroll") for (int _i = 0; _i < 2; ++_i) \
        __builtin_amdgcn_global_load_lds((const unsigned*)((const char*)(gbase) + (unsigned)((RR)[_i] * (pitch) + CB[_i])), (LAS unsigned*)(lds + (bufoff) + ldsw + _i * 8192), 16, 0, 0); } while (0)
#define PG8_LDA(dst, b, h) do { _Pragma("unroll") for (int m = 0; m < 4; ++m) _Pragma("unroll") for (int k = 0; k < 2; ++k) dst[m][k] = *(const LAS bf16x8*)(lds + PG8_SA(b, h) + aoff + m * 2048 + k * 1024); } while (0)
#define PG8_LDB(dst, b, h) do { _Pragma("unroll") for (int n = 0; n < 2; ++n) _Pragma("unroll") for (int k = 0; k < 2; ++k) dst[n][k] = *(const LAS bf16x8*)(lds + PG8_SB(b, h) + boff + n * 2048 + k * 1024); } while (0)
#define PG8_MMA(ai, bj, At, Bt) do { __builtin_amdgcn_s_setprio(1); _Pragma("unroll") for (int m = 0; m < 4; ++m) _Pragma("unroll") for (int n = 0; n < 2; ++n) _Pragma("unroll") for (int k = 0; k < 2; ++k) \
        acc[ai][bj][m][n] = TRANS ? __builtin_amdgcn_mfma_f32_16x16x32_bf16(At[m][k], Bt[n][k], acc[ai][bj][m][n], 0, 0, 0) \
                                  : __builtin_amdgcn_mfma_f32_16x16x32_bf16(Bt[n][k], At[m][k], acc[ai][bj][m][n], 0, 0, 0); __builtin_amdgcn_s_setprio(0); } while (0)
#define PG8_WAIT_V(n) asm volatile("s_waitcnt vmcnt(" #n ")" ::: "memory")
#define PG8_WAIT_L(n) asm volatile("s_waitcnt lgkmcnt(" #n ")" ::: "memory")
#define PG8_BAR __builtin_amdgcn_s_barrier()
#define PG8_SCHED __builtin_amdgcn_sched_barrier(0)
    Unit cur, nxt; int ui = 0;
    if (!S.next(0, cur)) return;
    f32x4 acc[2][2][4][2];
#pragma unroll
    for (int a = 0; a < 2; ++a)
#pragma unroll
        for (int b = 0; b < 2; ++b)
#pragma unroll
            for (int m = 0; m < 4; ++m)
#pragma unroll
                for (int n = 0; n < 2; ++n) acc[a][b][m][n] = (f32x4){0.f, 0.f, 0.f, 0.f};
    bf16x8 At[4][2], B0[2][2], B1[2][2];
    const char* cA = cur.A; const char* cB = cur.B; int cpa = cur.pa, cpb = cur.pb;
    {
        const size_t hA = (size_t)HALF * cpa, hB = (size_t)HALF * cpb;
        PG8_STAGE(PG8_SB(0, 0), cB, cpb, RB); PG8_STAGE(PG8_SB(0, 1), cB + hB, cpb, RB); PG8_STAGE(PG8_SA(0, 0), cA, cpa, RA); PG8_STAGE(PG8_SA(0, 1), cA + hA, cpa, RA);
        if (wr == 1) PG8_BAR;
        PG8_WAIT_V(2); PG8_BAR;
        PG8_STAGE(PG8_SB(1, 0), cB + 128, cpb, RB); PG8_STAGE(PG8_SA(1, 0), cA + 128, cpa, RA); PG8_STAGE(PG8_SB(1, 1), cB + hB + 128, cpb, RB);
        PG8_WAIT_V(6); PG8_BAR;
    }
    for (;;) {
        const bool has_next = S.next(ui + 1, nxt);
        const char* nA = has_next ? nxt.A : cA; const char* nB = has_next ? nxt.B : cB; const int npa = has_next ? nxt.pa : cpa, npb = has_next ? nxt.pb : cpb;
        const int nt = cur.nt; const size_t hA = (size_t)HALF * cpa;
        for (int t = 0; t < nt; t += 2) {
            const bool last = (t == nt - 2);
            const char* a1 = cA + (size_t)(t + 1) * 128;
            const char* a2 = last ? nA : cA + (size_t)(t + 2) * 128; const char* b2 = last ? nB : cB + (size_t)(t + 2) * 128;
            const int pa2 = last ? npa : cpa, pb2 = last ? npb : cpb; const size_t hA2 = (size_t)HALF * pa2, hB2 = (size_t)HALF * pb2;
            const char* a3 = a2 + 128; const char* b3 = b2 + 128;
            PG8_LDB(B0, 0, 0); PG8_LDB(B1, 0, 1); PG8_SCHED; PG8_LDA(At, 0, 0); PG8_STAGE(PG8_SA(1, 1), a1 + hA, cpa, RA);
            PG8_WAIT_V(8); PG8_WAIT_L(0); PG8_BAR; PG8_MMA(0, 0, At, B0); PG8_MMA(0, 1, At, B1); PG8_BAR; PG8_SCHED;
            PG8_LDA(At, 0, 1); PG8_STAGE(PG8_SB(0, 0), b2, pb2, RB); PG8_STAGE(PG8_SB(0, 1), b2 + hB2, pb2, RB); PG8_STAGE(PG8_SA(0, 0), a2, pa2, RA);
            PG8_WAIT_V(8); PG8_WAIT_L(0); PG8_BAR; PG8_MMA(1, 0, At, B0); PG8_MMA(1, 1, At, B1); PG8_BAR; PG8_SCHED;
            PG8_LDB(B0, 1, 0); PG8_LDB(B1, 1, 1); PG8_SCHED; PG8_LDA(At, 1, 0); PG8_STAGE(PG8_SA(0, 1), a2 + hA2, pa2, RA);
            PG8_WAIT_V(8); PG8_WAIT_L(0); PG8_BAR; PG8_MMA(0, 0, At, B0); PG8_MMA(0, 1, At, B1); PG8_BAR; PG8_SCHED;
            PG8_LDA(At, 1, 1); PG8_STAGE(PG8_SB(1, 0), b3, pb2, RB); PG8_STAGE(PG8_SB(1, 1), b3 + hB2, pb2, RB); PG8_STAGE(PG8_SA(1, 0), a3, pa2, RA);
            PG8_WAIT_V(8); PG8_WAIT_L(0); PG8_BAR; PG8_MMA(1, 0, At, B0); PG8_MMA(1, 1, At, B1); PG8_BAR; PG8_SCHED;
        }
        if (wr == 0) PG8_BAR;
        if (Epi::TWICE) (void)E(acc, cur, wr, wc, fr, fq);
        const bool keep = E(acc, cur, wr, wc, fr, fq);
        if (!has_next) break;
        if (!keep) {
#pragma unroll
            for (int a = 0; a < 2; ++a)
#pragma unroll
                for (int b = 0; b < 2; ++b)
#pragma unroll
                    for (int m = 0; m < 4; ++m)
#pragma unroll
                        for (int n = 0; n < 2; ++n) acc[a][b][m][n] = (f32x4){0.f, 0.f, 0.f, 0.f};
        }
        cur = nxt; cA = nA; cB = nB; cpa = npa; cpb = npb; ++ui;
        if (wr == 1) PG8_BAR;
    }
    PG8_WAIT_V(0);
    PG8_BAR;
#undef PG8_SA
#undef PG8_SB
#undef PG8_STAGE
#undef PG8_LDA
#undef PG8_LDB
#undef PG8_MMA
#undef PG8_WAIT_V
#undef PG8_WAIT_L
#undef PG8_BAR
#undef PG8_SCHED
}
}
using pg8::Unit;

template <int NSUB> struct SchedRect {
    const char* A0; const char* B0; const char* A1; const char* B1; int pa0, nt0, pa1, nt1; int nM, nN, G, c;
    __device__ __forceinline__ bool next(int i, Unit& u) const {
        const int ti = i / NSUB, s = i % NSUB; int pm, pn;
        if (!pg8::rect_tile((long)ti * G + c, nM, nN, pm, pn)) return false;
        const int pa = (NSUB > 1 && s) ? pa1 : pa0;
        u.pa = pa; u.pb = pa; u.nt = (NSUB > 1 && s) ? nt1 : nt0; u.pm = pm; u.pn = pn; u.aux = s;
        u.A = ((NSUB > 1 && s) ? A1 : A0) + (size_t)pm * 256 * pa; u.B = ((NSUB > 1 && s) ? B1 : B0) + (size_t)pn * 256 * pa; return true;
    }
};

struct SchedMerge {
    const char* ws; int G, c;
    __device__ __forceinline__ bool next(int i, Unit& u) const {
        const int ti = i / 3, s = i % 3; int pm, pn;
        if (!pg8::rect_tile((long)ti * G + c, MT / 256, 4, pm, pn)) return false;
        u.pa = 1024; u.nt = 8; u.pm = pm; u.pn = pn; u.aux = s;
        if (s == 0) { u.A = ws + ATT_OFF + (size_t)pm * 256 * 1024; u.B = ws + WNA_OFF + (size_t)pn * 256 * 1024; u.pb = 1024; }
        else { u.A = ws + (s == 1 ? PB_OFF : QB_OFF) + (size_t)pm * 256 * 1024; u.B = ws + WFN_OFF + (size_t)pn * 256 * 2048 + (s == 2 ? 1024 : 0); u.pb = 2048; }
        return true;
    }
};
struct SchedDft {
    const char* ws; int G, c;
    __device__ __forceinline__ bool next(int i, Unit& u) const {
        const long L = (long)i * G + c; if (L >= 416) return false;
        int pm, b, pn;
        if (L < 272) {
            if (L < 256) { const int x = (int)L & 7, s = (int)L >> 3; pm = 8 * (x >> 2) + (s & 7); b = s >> 3; pn = x & 3; }
            else { const int e = (int)L - 256; pm = 16; b = e >> 2; pn = e & 3; }
            u.pa = KPP * 2; u.pb = KPP * 2; u.nt = KPP / 64;
            u.A = ws + (pn < 2 ? CP_OFF : SP_OFF) + (size_t)pm * 256 * KPP * 2;
            u.B = ws + (pn < 2 ? UE_OFF : UO_OFF) + ((size_t)b * 512 + (pn & 1) * 256) * KPP * 2;
        } else {
            const int l = (int)L - 272, x = l & 7, s = l >> 3; pn = x & 3; pm = s % 9; b = 4 + 2 * (s / 9) + (x >> 2);
            u.pa = KPS * 2; u.pb = KPS * 2; u.nt = KPS / 64;
            u.A = ws + (pn < 2 ? CS_OFF : SSM_OFF) + (size_t)pm * 256 * KPS * 2;
            u.B = ws + (pn < 2 ? UE_OFF : UO_OFF) + (size_t)4 * 512 * KPP * 2 + ((size_t)(b - 4) * 512 + (pn & 1) * 256) * KPS * 2;
        }
        u.pm = pm; u.pn = pn; u.aux = b; return true;
    }
};

__device__ __forceinline__ float sigmoidf_(float v) { return __builtin_amdgcn_rcpf(1.0f + __builtin_amdgcn_exp2f(-1.44269504f * v)); }
typedef f32x4 Acc[2][2][4][2];

struct EpiP1a {
    static constexpr bool PERM = true, TWICE = (EPI2 == 1);
    unsigned char* ws; float* gates;
    __device__ __forceinline__ bool operator()(Acc& acc, const Unit& u, int wr, int wc, int fr, int fq) const {
        asm volatile("" : "+v"(fr), "+v"(fq));
        const int row0 = u.pm * 256 + wr * 64 + fr;
        if (u.pn < 4) {
            bf16_t* base = (bf16_t*)(ws + (u.pn < 2 ? Q_OFF : K_OFF)); const int col0 = (u.pn & 1) * 256 + wc * 32 + 8 * fq;
#pragma unroll
            for (int ai = 0; ai < 2; ++ai)
#pragma unroll
                for (int m = 0; m < 4; ++m) { bf16_t* rowp = base + (size_t)(row0 + ai * 128 + m * 16) * 512 + col0;
#pragma unroll
                    for (int bj = 0; bj < 2; ++bj) { const f32x4 v0 = acc[ai][bj][m][0], v1 = acc[ai][bj][m][1];
                        u32x4 w; w.x = cvt_pk_bf16(v0[0], v0[1]); w.y = cvt_pk_bf16(v0[2], v0[3]); w.z = cvt_pk_bf16(v1[0], v1[1]); w.w = cvt_pk_bf16(v1[2], v1[3]);
                        *(u32x4*)(rowp + bj * 128) = w; } }
        } else {
            bf16_t* Rb = (bf16_t*)gates; bf16_t* Sb = Rb + (size_t)MT * 1024; const int col0 = (u.pn - 4) * 128 + wc * 32 + 8 * fq;
#pragma unroll
            for (int ai = 0; ai < 2; ++ai)
#pragma unroll
                for (int m = 0; m < 4; ++m) { const size_t off = (size_t)(row0 + ai * 128 + m * 16) * 1024 + col0; float rr[8], s2[8];
#pragma unroll
                    for (int n = 0; n < 2; ++n)
#pragma unroll
                        for (int e = 0; e < 4; ++e) { const float e1 = __builtin_amdgcn_exp2f(fminf(-1.44269504f * acc[ai][0][m][n][e], 60.f)), e2 = __builtin_amdgcn_exp2f(fminf(-1.44269504f * acc[ai][1][m][n][e], 60.f));
                            const float d1 = 1.0f + e1, d2 = 1.0f + e2, t = __builtin_amdgcn_rcpf(d1 * d2);
                            s2[4 * n + e] = t * d1; rr[4 * n + e] = d2 * d2 * t; }
                    u32x4 w; w.x = cvt_pk_bf16(rr[0], rr[1]); w.y = cvt_pk_bf16(rr[2], rr[3]); w.z = cvt_pk_bf16(rr[4], rr[5]); w.w = cvt_pk_bf16(rr[6], rr[7]);
                    *(u32x4*)(Rb + off) = w;
                    w.x = cvt_pk_bf16(s2[0], s2[1]); w.y = cvt_pk_bf16(s2[2], s2[3]); w.z = cvt_pk_bf16(s2[4], s2[5]); w.w = cvt_pk_bf16(s2[6], s2[7]);
                    *(u32x4*)(Sb + off) = w; }
        }
        return false;
    }
};
struct EpiP1b {
    static constexpr bool PERM = false, TWICE = (EPI2 == 1);
    unsigned char* ws;
    __device__ __forceinline__ bool operator()(Acc& acc, const Unit& u, int wr, int wc, int fr, int fq) const {
        asm volatile("" : "+v"(fr), "+v"(fq));
        const int g0 = u.pm * 256; const int b = g0 < 4 * TP ? g0 / TP : 4 + (g0 - 4 * TP) / TS; const int gb = batch_base(b), T = b < 4 ? TP : TS, N = T + 16;
        bf16_t* base; size_t pitch; int coff;
        if (u.pn < 2) { base = (bf16_t*)(ws + VT_OFF) + (size_t)512 * gb; pitch = T; coff = u.pn * 256; }
        else { base = (bf16_t*)(ws + UT_OFF) + (b < 4 ? (size_t)b * 512 * NP : (size_t)4 * 512 * NP + (size_t)(b - 4) * 512 * NS) + 16; pitch = N; coff = (u.pn - 2) * 256; }
        const int t0 = g0 - gb + wr * 64 + 4 * fq, c0 = coff + wc * 32 + fr;
#pragma unroll
        for (int ai = 0; ai < 2; ++ai)
#pragma unroll
            for (int bj = 0; bj < 2; ++bj)
#pragma unroll
                for (int m = 0; m < 4; ++m)
#pragma unroll
                    for (int n = 0; n < 2; ++n) { const f32x4 v = acc[ai][bj][m][n]; u32x2 w; w.x = cvt_pk_bf16(v[0], v[1]); w.y = cvt_pk_bf16(v[2], v[3]);
                        *(u32x2*)(base + (size_t)(c0 + bj * 128 + n * 16) * pitch + t0 + ai * 128 + m * 16) = w; }
        return false;
    }
};
struct EpiDft {
    static constexpr bool PERM = true, TWICE = (EPI2 == 3);
    unsigned char* ws;
    __device__ __forceinline__ bool operator()(Acc& acc, const Unit& u, int wr, int wc, int fr, int fq) const {
        asm volatile("" : "+v"(fr), "+v"(fq));
        const int b = u.aux, gb = batch_base(b), N = (b < 4 ? TP : TS) + 16, HN = N / 2;
        bf16_t* base = (bf16_t*)(ws + (u.pn < 2 ? PB_OFF : QB_OFF)) + (size_t)gb * 512 + (u.pn & 1) * 256 + wc * 32 + 8 * fq;
        const float sg = u.pn >= 2 ? -1.f : 1.f;
#pragma unroll
        for (int ai = 0; ai < 2; ++ai)
#pragma unroll
            for (int m = 0; m < 4; ++m) { const int np = u.pm * 256 + ai * 128 + wr * 64 + m * 16 + fr + 1;
                if (np <= HN) {
#pragma unroll
                    for (int bj = 0; bj < 2; ++bj) { const f32x4 v0 = acc[ai][bj][m][0], v1 = acc[ai][bj][m][1];
                        if (np >= 16) { u32x4 w; w.x = cvt_pk_bf16(v0[0], v0[1]); w.y = cvt_pk_bf16(v0[2], v0[3]); w.z = cvt_pk_bf16(v1[0], v1[1]); w.w = cvt_pk_bf16(v1[2], v1[3]);
                            *(u32x4*)(base + (size_t)(np - 16) * 512 + bj * 128) = w; }
                        if (np != HN) { u32x4 w; w.x = cvt_pk_bf16(sg * v0[0], sg * v0[1]); w.y = cvt_pk_bf16(sg * v0[2], sg * v0[3]); w.z = cvt_pk_bf16(sg * v1[0], sg * v1[1]); w.w = cvt_pk_bf16(sg * v1[2], sg * v1[3]);
                            *(u32x4*)(base + (size_t)(N - np - 16) * 512 + bj * 128) = w; } } } }
        return false;
    }
};
struct EpiMerge {
    static constexpr bool PERM = true, TWICE = false;
    unsigned char* ws; const float* gates;
    __device__ __forceinline__ bool operator()(Acc& acc, const Unit& u, int wr, int wc, int fr, int fq) const {
        if (u.aux == 1) return true;
        asm volatile("" : "+v"(fr), "+v"(fq));
        const bf16_t* Gs = (const bf16_t*)gates + (u.aux == 0 ? (size_t)0 : (size_t)MT * 1024);
        const int row0 = u.pm * 256 + wr * 64 + fr, col0 = u.pn * 256 + wc * 32 + 8 * fq;
        bf16_t* mix = (bf16_t*)(ws + MIX_OFF);
        u32x4 g2[4][2];
#pragma unroll
        for (int q = 0; q < 3; ++q)
#pragma unroll
            for (int bj = 0; bj < 2; ++bj) g2[q][bj] = *(const u32x4*)(Gs + (size_t)(row0 + q * 16) * 1024 + col0 + bj * 128);
#pragma unroll
        for (int idx = 0; idx < 8; ++idx) { const int ai = idx >> 2, m = idx & 3; const size_t off = (size_t)(row0 + ai * 128 + m * 16) * 1024 + col0;
            if (idx < 5) { const int ai2 = (idx + 3) >> 2, m2 = (idx + 3) & 3; const size_t off2 = (size_t)(row0 + ai2 * 128 + m2 * 16) * 1024 + col0;
#pragma unroll
                for (int bj = 0; bj < 2; ++bj) g2[(idx + 3) & 3][bj] = *(const u32x4*)(Gs + off2 + bj * 128); }
#pragma unroll
            for (int bj = 0; bj < 2; ++bj) { const u32x4 w2 = g2[idx & 3][bj];
                const float sc[8] = {bf_lo(w2.x), bf_hi(w2.x), bf_lo(w2.y), bf_hi(w2.y), bf_lo(w2.z), bf_hi(w2.z), bf_lo(w2.w), bf_hi(w2.w)};
#pragma unroll
                for (int e = 0; e < 4; ++e) { acc[ai][bj][m][0][e] *= sc[e]; acc[ai][bj][m][1][e] *= sc[4 + e]; }
                if (u.aux == 2) { const f32x4 v0 = acc[ai][bj][m][0], v1 = acc[ai][bj][m][1]; u32x4 w;
                    w.x = cvt_pk_bf16(v0[0], v0[1]); w.y = cvt_pk_bf16(v0[2], v0[3]); w.z = cvt_pk_bf16(v1[0], v1[1]); w.w = cvt_pk_bf16(v1[2], v1[3]);
                    *(u32x4*)(mix + off + bj * 128) = w; } } }
        return u.aux == 0;
    }
};
struct EpiRes5 {
    static constexpr bool PERM = true, TWICE = false;
    const float* bp; const float* bs; bf16_t* ob; float* ss;
    __device__ __forceinline__ bool operator()(Acc& acc, const Unit& u, int wr, int wc, int fr, int fq) const {
        asm volatile("" : "+v"(fr), "+v"(fq));
        const int g0 = u.pm * 256; const float* base = g0 < 4 * TP ? bp + (size_t)g0 * 1024 : bs + (size_t)(g0 - 4 * TP) * 1024;
        const int lr0 = wr * 64 + fr, col0 = u.pn * 256 + wc * 32 + 8 * fq;
        f32x4 pre[3][2][2];
#pragma unroll
        for (int q = 0; q < 2; ++q)
#pragma unroll
            for (int bj = 0; bj < 2; ++bj)
#pragma unroll
                for (int n = 0; n < 2; ++n) pre[q][bj][n] = *(const f32x4*)(base + (size_t)(lr0 + q * 16) * 1024 + col0 + bj * 128 + n * 4);
#pragma unroll
        for (int idx = 0; idx < 8; ++idx) { const int ai = idx >> 2, m = idx & 3; const int lr = lr0 + ai * 128 + m * 16; float s = 0.f;
            if (idx < 6) { const int lr2 = lr0 + ((idx + 2) >> 2) * 128 + ((idx + 2) & 3) * 16;
#pragma unroll
                for (int bj = 0; bj < 2; ++bj)
#pragma unroll
                    for (int n = 0; n < 2; ++n) pre[(idx + 2) % 3][bj][n] = *(const f32x4*)(base + (size_t)lr2 * 1024 + col0 + bj * 128 + n * 4); }
#pragma unroll
            for (int bj = 0; bj < 2; ++bj) { const f32x4 o0 = pre[idx % 3][bj][0] + acc[ai][bj][m][0], o1 = pre[idx % 3][bj][1] + acc[ai][bj][m][1];
                s += ((o0[0] * o0[0] + o0[1] * o0[1]) + (o0[2] * o0[2] + o0[3] * o0[3])) + ((o1[0] * o1[0] + o1[1] * o1[1]) + (o1[2] * o1[2] + o1[3] * o1[3]));
                u32x4 w; w.x = cvt_pk_bf16(o0[0], o0[1]); w.y = cvt_pk_bf16(o0[2], o0[3]); w.z = cvt_pk_bf16(o1[0], o1[1]); w.w = cvt_pk_bf16(o1[2], o1[3]);
                *(u32x4*)(ob + (size_t)(g0 + lr) * 1024 + col0 + bj * 128) = w; }
            s += __shfl_xor(s, 16); s += __shfl_xor(s, 32);
            if (fq == 0) atomicAdd(ss + g0 + lr, s); }
        return false;
    }
};
struct EpiRes7 {
    static constexpr bool PERM = true, TWICE = false;
    bf16_t* xb; float* ss;
    __device__ __forceinline__ bool operator()(Acc& acc, const Unit& u, int wr, int wc, int fr, int fq) const {
        asm volatile("" : "+v"(fr), "+v"(fq));
        const int row0 = u.pm * 256 + wr * 64 + fr, col0 = u.pn * 256 + wc * 32 + 8 * fq;
        u32x4 pre[4][2];
#pragma unroll
        for (int q = 0; q < 3; ++q)
#pragma unroll
            for (int bj = 0; bj < 2; ++bj) pre[q][bj] = *(const u32x4*)(xb + (size_t)(row0 + q * 16) * 1024 + col0 + bj * 128);
#pragma unroll
        for (int idx = 0; idx < 8; ++idx) { const int ai = idx >> 2, m = idx & 3; const int row = row0 + ai * 128 + m * 16; float s = 0.f;
            if (idx < 5) { const int row2 = row0 + ((idx + 3) >> 2) * 128 + ((idx + 3) & 3) * 16;
#pragma unroll
                for (int bj = 0; bj < 2; ++bj) pre[(idx + 3) & 3][bj] = *(const u32x4*)(xb + (size_t)row2 * 1024 + col0 + bj * 128); }
#pragma unroll
            for (int bj = 0; bj < 2; ++bj) { const u32x4 b = pre[idx & 3][bj]; const f32x4 a0 = acc[ai][bj][m][0], a1 = acc[ai][bj][m][1];
                const float o[8] = {bf_lo(b.x) + a0[0], bf_hi(b.x) + a0[1], bf_lo(b.y) + a0[2], bf_hi(b.y) + a0[3], bf_lo(b.z) + a1[0], bf_hi(b.z) + a1[1], bf_lo(b.w) + a1[2], bf_hi(b.w) + a1[3]};
#pragma unroll
                for (int e = 0; e < 8; ++e) s += o[e] * o[e];
                u32x4 w; w.x = cvt_pk_bf16(o[0], o[1]); w.y = cvt_pk_bf16(o[2], o[3]); w.z = cvt_pk_bf16(o[4], o[5]); w.w = cvt_pk_bf16(o[6], o[7]);
                *(u32x4*)(xb + (size_t)row * 1024 + col0 + bj * 128) = w; }
            s += __shfl_xor(s, 16); s += __shfl_xor(s, 32);
            if (fq == 0) atomicAdd(ss + row, s); }
        return false;
    }
};
struct EpiRes7F {
    static constexpr bool PERM = true, TWICE = false;
    const bf16_t* xb; float* ss; unsigned* cnt; const float* gfin; float* out;
    __device__ __forceinline__ bool operator()(Acc& acc, const Unit& u, int wr, int wc, int fr, int fq) const {
        asm volatile("" : "+v"(fr), "+v"(fq));
        const int row0 = u.pm * 256 + wr * 64 + fr, col0 = u.pn * 256 + wc * 32 + 8 * fq;
        u32x4 pre[4][2];
#pragma unroll
        for (int q = 0; q < 3; ++q)
#pragma unroll
            for (int bj = 0; bj < 2; ++bj) pre[q][bj] = *(const u32x4*)(xb + (size_t)(row0 + q * 16) * 1024 + col0 + bj * 128);
#pragma unroll
        for (int idx = 0; idx < 8; ++idx) { const int ai = idx >> 2, m = idx & 3; const int row = row0 + ai * 128 + m * 16; float s = 0.f;
            if (idx < 5) { const int row2 = row0 + ((idx + 3) >> 2) * 128 + ((idx + 3) & 3) * 16;
#pragma unroll
                for (int bj = 0; bj < 2; ++bj) pre[(idx + 3) & 3][bj] = *(const u32x4*)(xb + (size_t)row2 * 1024 + col0 + bj * 128); }
#pragma unroll
            for (int bj = 0; bj < 2; ++bj) { const u32x4 b = pre[idx & 3][bj]; f32x4& a0 = acc[ai][bj][m][0]; f32x4& a1 = acc[ai][bj][m][1];
                a0[0] += bf_lo(b.x); a0[1] += bf_hi(b.x); a0[2] += bf_lo(b.y); a0[3] += bf_hi(b.y); a1[0] += bf_lo(b.z); a1[1] += bf_hi(b.z); a1[2] += bf_lo(b.w); a1[3] += bf_hi(b.w);
#pragma unroll
                for (int e = 0; e < 4; ++e) s += a0[e] * a0[e] + a1[e] * a1[e]; }
            s += __shfl_xor(s, 16); s += __shfl_xor(s, 32);
            if (fq == 0) atomicAdd(ss + row, s); }
        asm volatile("s_waitcnt vmcnt(0)" ::: "memory");
        __builtin_amdgcn_s_barrier();
        if (threadIdx.x == 0) { unsigned* c = cnt + u.pm; __hip_atomic_fetch_add(c, 1u, __ATOMIC_RELAXED, __HIP_MEMORY_SCOPE_AGENT);
            unsigned sp = 0; while (__hip_atomic_load(c, __ATOMIC_RELAXED, __HIP_MEMORY_SCOPE_AGENT) < 4u && ++sp < (1u << 22)) __builtin_amdgcn_s_sleep(2); }
        __builtin_amdgcn_s_barrier(); asm volatile("" ::: "memory");
        float rv[8];
#pragma unroll
        for (int idx = 0; idx < 8; ++idx) rv[idx] = __hip_atomic_load(ss + row0 + (idx >> 2) * 128 + (idx & 3) * 16, __ATOMIC_RELAXED, __HIP_MEMORY_SCOPE_AGENT);
        f32x4 gf[2][2];
#pragma unroll
        for (int bj = 0; bj < 2; ++bj) { gf[bj][0] = *(const f32x4*)(gfin + col0 + bj * 128); gf[bj][1] = *(const f32x4*)(gfin + col0 + bj * 128 + 4); }
#pragma unroll
        for (int idx = 0; idx < 8; ++idx) { const int ai = idx >> 2, m = idx & 3; const int row = row0 + ai * 128 + m * 16; const float rinv = rsqrtf(rv[idx] * (1.0f / 1024.0f) + RMS_EPS);
#pragma unroll
            for (int bj = 0; bj < 2; ++bj) { float* o = out + (size_t)row * 1024 + col0 + bj * 128;
                *(f32x4*)o = acc[ai][bj][m][0] * rinv * gf[bj][0]; *(f32x4*)(o + 4) = acc[ai][bj][m][1] * rinv * gf[bj][1]; } }
        return false;
    }
};
struct EpiUp {
    static constexpr bool PERM = true, TWICE = (EPI2 == 6);
    bf16_t* H; const float* ss;
    __device__ __forceinline__ bool operator()(Acc& acc, const Unit& u, int wr, int wc, int fr, int fq) const {
        asm volatile("" : "+v"(fr), "+v"(fq));
        const int row0 = u.pm * 256 + wr * 64 + fr, col0 = u.pn * 256 + wc * 32 + 8 * fq;
        float rv[8];
#pragma unroll
        for (int idx = 0; idx < 8; ++idx) rv[idx] = ss[row0 + (idx >> 2) * 128 + (idx & 3) * 16];
#pragma unroll
        for (int ai = 0; ai < 2; ++ai)
#pragma unroll
            for (int m = 0; m < 4; ++m) { const int row = row0 + ai * 128 + m * 16; const float rinv = rsqrtf(rv[ai * 4 + m] * (1.0f / 1024.0f) + RMS_EPS);
#pragma unroll
                for (int bj = 0; bj < 2; ++bj) { f32x4 v0 = acc[ai][bj][m][0], v1 = acc[ai][bj][m][1];
#pragma unroll
                    for (int e = 0; e < 4; ++e) { const float a = fmaxf(v0[e] * rinv, 0.f), b = fmaxf(v1[e] * rinv, 0.f); v0[e] = a * a; v1[e] = b * b; }
                    u32x4 w; w.x = cvt_pk_bf16(v0[0], v0[1]); w.y = cvt_pk_bf16(v0[2], v0[3]); w.z = cvt_pk_bf16(v1[0], v1[1]); w.w = cvt_pk_bf16(v1[2], v1[3]);
                    *(u32x4*)(H + (size_t)row * 4096 + col0 + bj * 128) = w; } }
        return false;
    }
};

__device__ __forceinline__ void p0_transpose_item(const float* W, int K, int N, bf16_t* WT, int out_row0, int n0, int k0, const float* sc, float mul, LAS float* scr, int lane) {
    float tv[32];
#pragma unroll
    for (int i = 0; i < 32; ++i) { const int kk = 2 * i + (lane >> 5); tv[i] = W[(size_t)(k0 + kk) * N + n0 + (lane & 31)]; }
#pragma unroll
    for (int i = 0; i < 32; ++i) { const int kk = 2 * i + (lane >> 5); const float s = sc ? sc[k0 + kk] * mul : mul; scr[kk * 33 + (lane & 31)] = tv[i] * s; }
    asm volatile("s_waitcnt lgkmcnt(0)" ::: "memory");
    const int c = lane & 7;
#pragma unroll
    for (int j = 0; j < 4; ++j) { const int n = (lane >> 3) + 8 * j; const LAS float* s = scr + (8 * c) * 33 + n;
        u32x4 o; o.x = cvt_pk_bf16(s[0 * 33], s[1 * 33]); o.y = cvt_pk_bf16(s[2 * 33], s[3 * 33]); o.z = cvt_pk_bf16(s[4 * 33], s[5 * 33]); o.w = cvt_pk_bf16(s[6 * 33], s[7 * 33]);
        *(u32x4*)(WT + (size_t)(out_row0 + n) * K + k0 + 8 * c) = o; }
    asm volatile("s_waitcnt lgkmcnt(0)" ::: "memory");
}

template <int PART> __device__ __forceinline__ void p0_prologue(const Params& p, LAS unsigned char* lds, int bx, int G) {
    const int tid = threadIdx.x, lane = tid & 63, wid = tid >> 6;
    const int gw = bx * 8 + wid, NGW = G * 8, gt = bx * 512 + tid, NGT = G * 512;
    unsigned char* ws = p.ws;
    if (PART == 0) for (int i = gt; i < MT; i += NGT) { ((float*)(ws + SS1_OFF))[i] = 0.f; ((float*)(ws + SS2_OFF))[i] = 0.f; }
    for (int r0_ = 0; r0_ < (P0REP == 0 ? 2 : 1); ++r0_)
    if (PART == 0 && bx < 24) {
        LAS float* hm = (LAS float*)lds;
        LAS float* red = (LAS float*)(lds + 65536);
        for (int r = wid * 2; r < wid * 2 + 2; ++r) { float v[16]; float s = 0.f;
#pragma unroll
            for (int j = 0; j < 16; ++j) { v[j] = p.meta[r * 1024 + lane + 64 * j]; s += v[j] * v[j]; }
            const float rinv = rsqrtf(wave_sum(s) * (1.0f / 1024.0f) + RMS_EPS);
#pragma unroll
            for (int j = 0; j < 16; ++j) hm[r * 1024 + lane + 64 * j] = v[j] * rinv * p.g_mix[lane + 64 * j]; }
        __syncthreads();
        const int n = 512 + bx * 64 + lane; float a[16];
#pragma unroll
        for (int r = 0; r < 16; ++r) a[r] = 0.f;
        for (int k0 = wid * 128; k0 < wid * 128 + 128; k0 += 16) { float w[16];
#pragma unroll
            for (int q = 0; q < 16; ++q) w[q] = p.w_in[(size_t)(k0 + q) * 4096 + n];
#pragma unroll
            for (int q = 0; q < 16; ++q)
#pragma unroll
                for (int r = 0; r < 16; ++r) a[r] += hm[r * 1024 + k0 + q] * w[q]; }
#pragma unroll
        for (int r = 0; r < 16; ++r) red[(wid * 16 + r) * 64 + lane] = a[r];
        __syncthreads();
        for (int o = tid; o < 1024; o += 512) { const int r = o >> 6, l = o & 63; float s = 0.f;
#pragma unroll
            for (int w = 0; w < 8; ++w) s += red[(w * 16 + r) * 64 + l];
            const int nn = 512 + bx * 64 + l; const bf16_t hv = (bf16_t)(cvt_pk_bf16(s, 0.f) & 0xffffu);
            if (nn < 1024) ((bf16_t*)(ws + KMETA_OFF))[r * 512 + nn - 512] = hv;
            else if (nn < 1536) ((bf16_t*)(ws + VMETAT_OFF))[(nn - 1024) * 16 + r] = hv;
            else { const int ch = nn - 1536;
                for (int b = 0; b < 8; ++b) { bf16_t* ut = (bf16_t*)(ws + UT_OFF) + (b < 4 ? (size_t)b * 512 * NP + (size_t)ch * NP : (size_t)4 * 512 * NP + (size_t)(b - 4) * 512 * NS + (size_t)ch * NS); ut[r] = hv; } } }
        __syncthreads();
    }
    for (int r1_ = 0; r1_ < (P0REP == 1 ? 2 : 1); ++r1_)
    if (PART == 0 || PART == 2) {
        LAS float* scr = (LAS float*)(lds + wid * 8448);
        constexpr int I_IN = 16 * 128, I_UP = 16 * 128, I_DN = 64 * 32, I_OUT = 16 * 32, I_NA = 8 * 32, NIT = I_IN + I_UP + I_DN + I_OUT + I_NA;
        for (int it = (PART == 0 ? 0 : I_IN) + gw; it < (PART == 0 ? I_IN : NIT); it += NGW) {
            int r = it;
            if (r < I_IN) { const int kb = r / 128, nb = r % 128, n0 = nb * 32; bf16_t* dst; int orow; float mul = 1.f;
                if (n0 < 512) { dst = (bf16_t*)(ws + WINA_OFF); orow = n0; mul = 0.125f; } else if (n0 < 1024) { dst = (bf16_t*)(ws + WINA_OFF); orow = n0; }
                else if (n0 < 2048) { dst = (bf16_t*)(ws + WINB_OFF); orow = n0 - 1024; }
                else { const int isfn = n0 >= 3072, gc = n0 - (isfn ? 3072 : 2048); dst = (bf16_t*)(ws + WINA_OFF); orow = 1024 + 256 * (gc >> 7) + 128 * isfn + (gc & 127); }
                p0_transpose_item(p.w_in, 1024, 4096, dst, orow, n0, kb * 64, p.g_mix, mul, scr, lane); continue; } r -= I_IN;
            if (r < I_UP) { const int kb = r / 128, nb = r % 128; p0_transpose_item(p.w_up, 1024, 4096, (bf16_t*)(ws + WUP_OFF), nb * 32, nb * 32, kb * 64, p.g_mlp, 1.f, scr, lane); continue; } r -= I_UP;
            if (r < I_DN) { const int kb = r / 32, nb = r % 32; p0_transpose_item(p.w_down, 4096, 1024, (bf16_t*)(ws + WDN_OFF), nb * 32, nb * 32, kb * 64, nullptr, 1.f, scr, lane); continue; } r -= I_DN;
            if (r < I_OUT) { const int kb = r / 32, nb = r % 32; p0_transpose_item(p.w_out, 1024, 1024, (bf16_t*)(ws + WOUT_OFF), nb * 32, nb * 32, kb * 64, nullptr, 1.f, scr, lane); continue; } r -= I_OUT;
            { const int kb = r / 32, nb = r % 32; p0_transpose_item(p.w_na, 512, 1024, (bf16_t*)(ws + WNA_OFF), nb * 32, nb * 32, kb * 64, nullptr, 1.f, scr, lane); }
        }
    }
    for (int r2_ = 0; r2_ < (P0REP == 2 ? 2 : 1); ++r2_)
    if (PART == 2) for (int tw = gw; tw < 64 * 4 * 2; tw += NGW) {
        const int twu = __builtin_amdgcn_readfirstlane(tw); const int c = (twu & 1) * 64 + lane, g = (twu >> 1) & 3, d0 = (twu >> 3) * 16;
        float ac[16], as[16];
#pragma unroll
        for (int q = 0; q < 16; ++q) { ac[q] = 0.f; as[q] = 0.f; }
        const float* wf = p.w_fn + (size_t)g * 128 * 1024 + d0;
#pragma unroll 2
        for (int cp = 0; cp < 128; ++cp) { const float tr = (float)((c * cp) & 127) * (1.0f / 128.0f); const float co = __builtin_amdgcn_cosf(tr), si = __builtin_amdgcn_sinf(tr);
            f32x4 w[4];
#pragma unroll
            for (int q = 0; q < 4; ++q) w[q] = *(const __attribute__((address_space(4))) f32x4*)(unsigned long long)(wf + (size_t)cp * 1024 + 4 * q);
#pragma unroll
            for (int q = 0; q < 16; ++q) { ac[q] += co * w[q >> 2][q & 3]; as[q] -= si * w[q >> 2][q & 3]; } }
        bf16_t* o = (bf16_t*)(ws + WFN_OFF) + (size_t)d0 * 1024 + g * 128 + c;
#pragma unroll
        for (int q = 0; q < 16; ++q) { o[(size_t)q * 1024] = (bf16_t)(cvt_pk_bf16(ac[q], 0.f) & 0xffffu); o[(size_t)q * 1024 + 512] = (bf16_t)(cvt_pk_bf16(as[q], 0.f) & 0xffffu); } }
    for (int r3_ = 0; r3_ < (P0REP == 3 ? 2 : 1); ++r3_)
    if (PART == 1) {
        constexpr int IP = MRP * (KPP / 8), IS = MRS * (KPS / 8);
        for (int it = gt; it < IP + IS; it += NGT) {
            int i, j, N, KP; bf16_t* cm; bf16_t* sm;
            if (it < IP) { i = it / (KPP / 8); j = it % (KPP / 8); N = NP; KP = KPP; cm = (bf16_t*)(ws + CP_OFF); sm = (bf16_t*)(ws + SP_OFF); }
            else { const int q = it - IP; i = q / (KPS / 8); j = q % (KPS / 8); N = NS; KP = KPS; cm = (bf16_t*)(ws + CS_OFF); sm = (bf16_t*)(ws + SSM_OFF); }
            const int np = i + 1, HN = N / 2; const float norm = rsqrtf(128.0f * (float)N), invN = 1.0f / (float)N;
            float cv[8], sv[8]; int mm; { const unsigned prod = (unsigned)np * (unsigned)(8 * j); unsigned q = (unsigned)((float)prod * invN); if (q > 0) --q; mm = (int)(prod - q * (unsigned)N); while (mm >= N) mm -= N; }
#pragma unroll
            for (int e = 0; e < 8; ++e) { const int k = 8 * j + e; const bool ok = (np <= HN) && (k <= HN); const float tr = (float)mm * invN;
                cv[e] = ok ? __builtin_amdgcn_cosf(tr) * norm : 0.f; sv[e] = ok ? __builtin_amdgcn_sinf(tr) * norm : 0.f; mm += np; if (mm >= N) mm -= N; }
            u32x4 wc_, ws_; wc_.x = cvt_pk_bf16(cv[0], cv[1]); wc_.y = cvt_pk_bf16(cv[2], cv[3]); wc_.z = cvt_pk_bf16(cv[4], cv[5]); wc_.w = cvt_pk_bf16(cv[6], cv[7]);
            ws_.x = cvt_pk_bf16(sv[0], sv[1]); ws_.y = cvt_pk_bf16(sv[2], sv[3]); ws_.z = cvt_pk_bf16(sv[4], sv[5]); ws_.w = cvt_pk_bf16(sv[6], sv[7]);
            *(u32x4*)(cm + (size_t)i * KP + 8 * j) = wc_; *(u32x4*)(sm + (size_t)i * KP + 8 * j) = ws_;
        }
    }
    if (PART == 0) {
        constexpr int NCH = MT / 4;
        const bool uneven = (G == 256); const int nm = 24 * 8, nn = 256 * 8 - nm;
        for (int itx = 0; ; ++itx) {
            int chunk;
            if (!uneven) chunk = gw + itx * NGW;
            else if (bx >= 24) { const int wp = gw - nm; chunk = itx < 6 ? itx * nn + wp : (itx == 6 && wp < NCH - 6 * nn - 4 * nm ? 6 * nn + 4 * nm + wp : NCH); }
            else chunk = itx < 4 ? 6 * nn + gw * 4 + itx : NCH;
            if (chunk >= NCH) break;
            f32x4 v[4][4];
#pragma unroll
            for (int q = 0; q < 4; ++q) { const int g = chunk * 4 + q; const float* xr = g < 4 * TP ? p.xp + (size_t)g * 1024 : p.xs + (size_t)(g - 4 * TP) * 1024;
#pragma unroll
                for (int j = 0; j < 4; ++j) v[q][j] = ((const f32x4*)xr)[lane + 64 * j]; }
#pragma unroll
            for (int q = 0; q < 4; ++q) { const int g = chunk * 4 + q; float s = 0.f;
#pragma unroll
                for (int j = 0; j < 4; ++j) s += (v[q][j][0] * v[q][j][0] + v[q][j][1] * v[q][j][1]) + (v[q][j][2] * v[q][j][2] + v[q][j][3] * v[q][j][3]);
                const float rinv = rsqrtf(wave_sum(s) * (1.0f / 1024.0f) + RMS_EPS);
                u32x2* o = (u32x2*)((bf16_t*)(ws + XB_OFF) + (size_t)g * 1024);
#pragma unroll
                for (int j = 0; j < 4; ++j) { u32x2 w; w.x = cvt_pk_bf16(v[q][j][0] * rinv, v[q][j][1] * rinv); w.y = cvt_pk_bf16(v[q][j][2] * rinv, v[q][j][3] * rinv); o[lane + 64 * j] = w; } }
        }
    }
}

constexpr int A_KS = 0, A_VS = 73728, A_KM = 147456, A_VM = 149504, A_BS = 151552, A_MB = 155392;
__device__ __forceinline__ void attn_units(const Params& p, LAS unsigned char* lds, const int u_lo, const int u_hi) {
    const int tid = threadIdx.x, lane = tid & 63, wid = __builtin_amdgcn_readfirstlane(tid >> 6), G = gridDim.x, bx = blockIdx.x;
    const int li = lane & 15, g = lane >> 4;
    unsigned char* ws = p.ws;
    const bf16_t* Qb = (const bf16_t*)(ws + Q_OFF); const bf16_t* Kb = (const bf16_t*)(ws + K_OFF); const bf16_t* VT = (const bf16_t*)(ws + VT_OFF);
    bf16_t* att = (bf16_t*)(ws + ATT_OFF);
    int pb = -1, ph = -1, hiR = -1;
    const int sr = tid >> 3, sch = tid & 7;
    u32x4 pf[4]; int pfn = 0, pfR0 = 0;
    for (int un = u_lo; un < u_hi; ++un) {
        int b, h, rp, rows;
        if (un < 2048) { b = un >> 9; h = (un >> 6) & 7; rp = un & 63; rows = 128; } else { const int v = un - 2048; b = 4 + (v >> 8); h = (v >> 5) & 7; rp = v & 31; rows = 64; }
        const int gb = batch_base(b), T = rows * 64, r0 = 2 * rp;
        const int rsA = min(max(r0 - 4, 0), rows - 8), needHi = min(rsA + 8, rows - 1);
        if (b != pb || h != ph) {
            __syncthreads();
            { u32x4 kvv[9], vvv[9];
#pragma unroll
              for (int j = 0; j < 9; ++j) { const int R = min(rsA + j, needHi);
                kvv[j] = *(const u32x4*)(Kb + (size_t)(gb + R * 64 + sr) * 512 + h * 64 + sch * 8);
                vvv[j] = *(const u32x4*)(VT + (size_t)512 * gb + (size_t)(h * 64 + sr) * T + R * 64 + sch * 8); }
#pragma unroll
              for (int j = 0; j < 9; ++j) { const int sl = min(rsA + j, needHi) % 9;
                *(LAS u32x4*)(lds + A_KS + sl * 8192 + sr * 128 + ((sch ^ (sr & 7)) * 16)) = kvv[j];
                *(LAS u32x4*)(lds + A_VS + sl * 8192 + sr * 128 + ((sch ^ ((sr >> 1) & 7)) * 16)) = vvv[j]; } }
            if (tid < 128) { const int r = tid >> 3, ch = tid & 7; *(LAS u32x4*)(lds + A_KM + r * 128 + ((ch ^ (r & 7)) * 16)) = *(const u32x4*)((const bf16_t*)(ws + KMETA_OFF) + r * 512 + h * 64 + ch * 8); }
            else if (tid < 256) { const int q = tid - 128; *(LAS u32x4*)(lds + A_VM + q * 16) = *(const u32x4*)((const bf16_t*)(ws + VMETAT_OFF) + h * 64 * 16 + q * 8); }
            for (int i = tid; i < 15 * 64; i += 512) { const int ro = i >> 6, x = (i & 63) - 16; ((LAS float*)(lds + A_BS))[i] = (x >= 0 && x <= 30) ? p.rel_bias[(h * 15 + ro) * 31 + x] : 0.f; }
            if (tid < 16) ((LAS float*)(lds + A_MB))[tid] = p.meta_bias[h * 16 + tid];
            pb = b; ph = h; hiR = needHi;
        } else {
#pragma unroll
            for (int j = 0; j < 2; ++j) if (j < pfn) { const int sl = (pfR0 + j) % 9;
                *(LAS u32x4*)(lds + A_KS + sl * 8192 + sr * 128 + ((sch ^ (sr & 7)) * 16)) = pf[2 * j];
                *(LAS u32x4*)(lds + A_VS + sl * 8192 + sr * 128 + ((sch ^ ((sr >> 1) & 7)) * 16)) = pf[2 * j + 1]; }
            hiR = needHi;
        }
        __syncthreads();
        pfn = 0;
        if (un + 1 < u_hi) { const int un2 = un + 1; int b2, h2, rp2;
            if (un2 < 2048) { b2 = un2 >> 9; h2 = (un2 >> 6) & 7; rp2 = un2 & 63; } else { const int v = un2 - 2048; b2 = 4 + (v >> 8); h2 = (v >> 5) & 7; rp2 = v & 31; }
            if (b2 == b && h2 == h) { const int rsA2 = min(max(2 * rp2 - 4, 0), rows - 8), nh2 = min(rsA2 + 8, rows - 1); pfR0 = hiR + 1; pfn = nh2 - hiR;
#pragma unroll
                for (int j = 0; j < 2; ++j) if (j < pfn) { const int R = pfR0 + j;
                    pf[2 * j] = *(const u32x4*)(Kb + (size_t)(gb + R * 64 + sr) * 512 + h * 64 + sch * 8);
                    pf[2 * j + 1] = *(const u32x4*)(VT + (size_t)512 * gb + (size_t)(h * 64 + sr) * T + R * 64 + sch * 8); } } }
        const int r = r0 + (wid >> 2), c0 = 16 * (wid & 3), kc0 = min(max(c0 - 8, 0), 32);
        const int rs = min(max(r - 4, 0), rows - 8);
        int slot[8];
        { const int s0 = rs % 9;
#pragma unroll
          for (int w = 0; w < 8; ++w) slot[w] = (s0 + w >= 9) ? s0 + w - 9 : s0 + w; }
        const int c = c0 + li, cs = min(max(c - 8, 0), 48);
        const size_t qrow = (size_t)(gb + r * 64 + c);
        bf16x8 qf[2];
        qf[0] = *(const bf16x8*)(Qb + qrow * 512 + h * 64 + 8 * g); qf[1] = *(const bf16x8*)(Qb + qrow * 512 + h * 64 + 32 + 8 * g);
        f32x4 sa[8][2]; f32x4 sm_;
        {
            const int kr0 = kc0 + li;
#pragma unroll
            for (int w = 0; w < 8; ++w)
#pragma unroll
                for (int j = 0; j < 2; ++j) { const int kr = kr0 + 16 * j; const LAS unsigned char* rowp = lds + A_KS + slot[w] * 8192 + kr * 128;
                    const bf16x8 a0 = *(const LAS bf16x8*)(rowp + ((g ^ (kr & 7)) * 16)), a1 = *(const LAS bf16x8*)(rowp + (((g + 4) ^ (kr & 7)) * 16));
                    f32x4 z = (f32x4){0.f, 0.f, 0.f, 0.f};
                    z = __builtin_amdgcn_mfma_f32_16x16x32_bf16(a0, qf[0], z, 0, 0, 0); sa[w][j] = __builtin_amdgcn_mfma_f32_16x16x32_bf16(a1, qf[1], z, 0, 0, 0); }
            const LAS unsigned char* rowp = lds + A_KM + li * 128;
            const bf16x8 a0 = *(const LAS bf16x8*)(rowp + ((g ^ (li & 7)) * 16)), a1 = *(const LAS bf16x8*)(rowp + (((g + 4) ^ (li & 7)) * 16));
            f32x4 z = (f32x4){0.f, 0.f, 0.f, 0.f};
            z = __builtin_amdgcn_mfma_f32_16x16x32_bf16(a0, qf[0], z, 0, 0, 0); sm_ = __builtin_amdgcn_mfma_f32_16x16x32_bf16(a1, qf[1], z, 0, 0, 0);
        }
        const int dl = kc0 + 4 * g - cs;
        const LAS float* bsp = (const LAS float*)(lds + A_BS) + (rs - r + 7) * 64 + (kc0 + 4 * g - c + 31);
        float mx = -1e30f;
#pragma unroll
        for (int w = 0; w < 8; ++w)
#pragma unroll
            for (int j = 0; j < 2; ++j)
#pragma unroll
                for (int e = 0; e < 4; ++e) { const bool ok = (unsigned)(dl + 16 * j + e) < 16u; const float bv = bsp[w * 64 + 16 * j + e];
                    float sv = sa[w][j][e] + bv; sv = ok ? sv : -1e30f; sa[w][j][e] = sv; mx = fmaxf(mx, sv); }
#pragma unroll
        for (int e = 0; e < 4; ++e) { sm_[e] += ((const LAS float*)(lds + A_MB))[4 * g + e]; mx = fmaxf(mx, sm_[e]); }
        mx = fmaxf(mx, __shfl_xor(mx, 16)); mx = fmaxf(mx, __shfl_xor(mx, 32));
        const float mxl = mx * 1.44269504f; float sum = 0.f;
#pragma unroll
        for (int w = 0; w < 8; ++w)
#pragma unroll
            for (int j = 0; j < 2; ++j)
#pragma unroll
                for (int e = 0; e < 4; ++e) { const float pe = __builtin_amdgcn_exp2f(sa[w][j][e] * 1.44269504f - mxl); sa[w][j][e] = pe; sum += pe; }
#pragma unroll
        for (int e = 0; e < 4; ++e) { const float pe = __builtin_amdgcn_exp2f(sm_[e] * 1.44269504f - mxl); sm_[e] = pe; sum += pe; }
        sum += __shfl_xor(sum, 16); sum += __shfl_xor(sum, 32);
        const float rsum = 1.0f / sum;
        f32x4 o[4];
#pragma unroll
        for (int dt = 0; dt < 4; ++dt) o[dt] = (f32x4){0.f, 0.f, 0.f, 0.f};
        const int c8 = (kc0 >> 2) + g;
#pragma unroll
        for (int w = 0; w < 8; ++w) { u32x4 pw; pw.x = cvt_pk_bf16(sa[w][0][0], sa[w][0][1]); pw.y = cvt_pk_bf16(sa[w][0][2], sa[w][0][3]); pw.z = cvt_pk_bf16(sa[w][1][0], sa[w][1][1]); pw.w = cvt_pk_bf16(sa[w][1][2], sa[w][1][3]);
            const bf16x8 pbv = __builtin_bit_cast(bf16x8, pw);
#pragma unroll
            for (int dt = 0; dt < 4; ++dt) { const int d = 16 * dt + li, sw = 2 * ((d >> 1) & 7); const LAS unsigned char* rowp = lds + A_VS + slot[w] * 8192 + d * 128;
                const u32x2 lo = *(const LAS u32x2*)(rowp + ((c8 ^ sw) * 8)), hi = *(const LAS u32x2*)(rowp + (((c8 + 4) ^ sw) * 8));
                u32x4 av; av.x = lo.x; av.y = lo.y; av.z = hi.x; av.w = hi.y;
                o[dt] = __builtin_amdgcn_mfma_f32_16x16x32_bf16(__builtin_bit_cast(bf16x8, av), pbv, o[dt], 0, 0, 0); } }
        { u32x4 pw; pw.x = cvt_pk_bf16(sm_[0], sm_[1]); pw.y = cvt_pk_bf16(sm_[2], sm_[3]); pw.z = 0u; pw.w = 0u; const bf16x8 pbv = __builtin_bit_cast(bf16x8, pw);
#pragma unroll
            for (int dt = 0; dt < 4; ++dt) { const int d = 16 * dt + li; const u32x2 lo = *(const LAS u32x2*)(lds + A_VM + d * 32 + g * 8);
                u32x4 av; av.x = lo.x; av.y = lo.y; av.z = 0u; av.w = 0u;
                o[dt] = __builtin_amdgcn_mfma_f32_16x16x32_bf16(__builtin_bit_cast(bf16x8, av), pbv, o[dt], 0, 0, 0); } }
#pragma unroll
        for (int dt = 0; dt < 4; ++dt) { u32x2 w; w.x = cvt_pk_bf16(o[dt][0] * rsum, o[dt][1] * rsum); w.y = cvt_pk_bf16(o[dt][2] * rsum, o[dt][3] * rsum);
            *(u32x2*)(att + qrow * 512 + h * 64 + 16 * dt + 4 * g) = w; }
        __syncthreads();
    }
}
__device__ __forceinline__ void dft_prep(const Params& p) {
    const int tid = threadIdx.x, G = gridDim.x, bx = blockIdx.x; unsigned char* ws = p.ws;
    {
        const int gt = bx * 512 + tid, NGT = G * 512;
        constexpr int IPP = 4 * 512 * (KPP / 8), IPS = 4 * 512 * (KPS / 8);
        for (int it = gt; it < IPP + IPS; it += NGT) {
            int b, ch, j, N, KP; size_t ub, eb;
            if (it < IPP) { b = it / (512 * (KPP / 8)); const int q = it % (512 * (KPP / 8)); ch = q / (KPP / 8); j = q % (KPP / 8); N = NP; KP = KPP; ub = ((size_t)b * 512 + ch) * NP; eb = ((size_t)b * 512 + ch) * KPP; }
            else { const int v = it - IPP; b = v / (512 * (KPS / 8)); const int q = v % (512 * (KPS / 8)); ch = q / (KPS / 8); j = q % (KPS / 8); N = NS; KP = KPS;
                ub = (size_t)4 * 512 * NP + ((size_t)b * 512 + ch) * NS; eb = (size_t)4 * 512 * KPP + ((size_t)b * 512 + ch) * KPS; }
            (void)KP;
            const bf16_t* ut = (const bf16_t*)(ws + UT_OFF) + ub; const int HN = N / 2, k0 = 8 * j;
            float ev[8], ov[8];
            if (k0 < HN) { const u32x4 f = *(const u32x4*)(ut + k0); const u32x4 rv = *(const u32x4*)(ut + N - k0 - 8);
                const float fw[8] = {bf_lo(f.x), bf_hi(f.x), bf_lo(f.y), bf_hi(f.y), bf_lo(f.z), bf_hi(f.z), bf_lo(f.w), bf_hi(f.w)};
                const float rr[8] = {bf_lo(rv.x), bf_hi(rv.x), bf_lo(rv.y), bf_hi(rv.y), bf_lo(rv.z), bf_hi(rv.z), bf_lo(rv.w), bf_hi(rv.w)};
                const float r0v = (k0 > 0) ? __uint_as_float((unsigned)ut[N - k0] << 16) : 0.f;
#pragma unroll
                for (int e = 0; e < 8; ++e) { const float rvv = (e == 0) ? r0v : rr[8 - e]; ev[e] = fw[e] + rvv; ov[e] = fw[e] - rvv; }
                if (k0 == 0) { ev[0] = fw[0]; ov[0] = 0.f; } }
            else {
#pragma unroll
                for (int e = 0; e < 8; ++e) { ev[e] = 0.f; ov[e] = 0.f; }
                if (k0 == HN) ev[0] = __uint_as_float((unsigned)ut[HN] << 16); }
            u32x4 we, wo; we.x = cvt_pk_bf16(ev[0], ev[1]); we.y = cvt_pk_bf16(ev[2], ev[3]); we.z = cvt_pk_bf16(ev[4], ev[5]); we.w = cvt_pk_bf16(ev[6], ev[7]);
            wo.x = cvt_pk_bf16(ov[0], ov[1]); wo.y = cvt_pk_bf16(ov[2], ov[3]); wo.z = cvt_pk_bf16(ov[4], ov[5]); wo.w = cvt_pk_bf16(ov[6], ov[7]);
            *(u32x4*)((bf16_t*)(ws + UE_OFF) + eb + k0) = we; *(u32x4*)((bf16_t*)(ws + UO_OFF) + eb + k0) = wo;
        }
    }
}

#define XB_TMO      128
#define XB_XCNT(j)  (256  + 64 * (j))
#define XB_XSUB(j)  (1280 + 64 * (j))
#define XB_XGEN(j)  (2304 + 64 * (j))
#define XB_TOP      3328
#define XB_TOPGEN   3392
#define XCD_BAR_WORDS 3456
#define XB_SPIN_CAP (1u << 18)

__device__ __forceinline__ unsigned xb_ld(unsigned* p)              { return __hip_atomic_load(p, __ATOMIC_RELAXED, __HIP_MEMORY_SCOPE_AGENT); }
__device__ __forceinline__ unsigned xb_add(unsigned* p, unsigned v) { return __hip_atomic_fetch_add(p, v, __ATOMIC_RELAXED, __HIP_MEMORY_SCOPE_AGENT); }
__device__ __forceinline__ unsigned xb_xcc_id() { return (unsigned)__builtin_amdgcn_s_getreg((3 << 11) | 20) & 0xFu; }
#define XB_SPIN(cond, bar) do { unsigned _sp = 0; while (cond) { __builtin_amdgcn_s_sleep(1); \
    if ((++_sp & 255u) == 0u) { if (xb_ld(&(bar)[XB_TMO])) break; if (_sp > XB_SPIN_CAP) { atomicAdd(&(bar)[XB_TMO], 1u); break; } } } } while (0)

struct XcdBarrier {
    unsigned* bar; unsigned x;
    volatile LAS unsigned* st;
};

__device__ __forceinline__ XcdBarrier xcd_barrier_post(unsigned* bar, volatile LAS unsigned* st) {
    XcdBarrier b; b.bar = bar; b.x = xb_xcc_id(); b.st = st;
    if (threadIdx.x == 0) (void)xb_add(&bar[XB_XCNT(b.x)], 1u);
    return b;
}
__device__ __forceinline__ void xcd_barrier_complete(unsigned* bar, unsigned x, unsigned& nloc, unsigned& nx) {
    const unsigned G = gridDim.x * gridDim.y * gridDim.z;
    unsigned sum, cnt, mine, sp = 0u;
    for (;;) {
        sum = 0u; cnt = 0u; mine = 0u;
#pragma unroll
        for (unsigned j = 0; j < 16; ++j) { const unsigned c = xb_ld(&bar[XB_XCNT(j)]); sum += c; cnt += (c > 0u) ? 1u : 0u; mine = (j == x) ? c : mine; }
        if (sum == G) break;
        __builtin_amdgcn_s_sleep(1);
        if ((++sp & 255u) == 0u) { if (xb_ld(&bar[XB_TMO])) break; if (sp > XB_SPIN_CAP) { atomicAdd(&bar[XB_TMO], 1u); break; } }
    }
    nloc = mine > 0u ? mine : 1u; nx = cnt > 0u ? cnt : 1u;
}

__device__ __forceinline__ void xcd_barrier(const XcdBarrier& b) {
    asm volatile("s_waitcnt vmcnt(0)" ::: "memory");
    __syncthreads();
    if (threadIdx.x == 0) {
        unsigned* bar = b.bar;
        __builtin_amdgcn_s_waitcnt(0);
        unsigned nloc = b.st[0], nx = b.st[1];
        if (nloc == 0u) { xcd_barrier_complete(bar, b.x, nloc, nx); b.st[0] = nloc; b.st[1] = nx; }
        const unsigned old = xb_add(&bar[XB_XSUB(b.x)], 1u);
        const unsigned gen = old / nloc;
        if (old + 1u == (gen + 1u) * nloc) {
            __builtin_amdgcn_fence(__ATOMIC_RELEASE, "agent");
            asm volatile("s_waitcnt vmcnt(0)" ::: "memory");
            const unsigned og = xb_add(&bar[XB_TOP], 1u);
            const unsigned tg = og / nx;
            if (og + 1u == (tg + 1u) * nx) xb_add(&bar[XB_TOPGEN], 1u);
            else XB_SPIN(xb_ld(&bar[XB_TOPGEN]) == tg, bar);
            __builtin_amdgcn_fence(__ATOMIC_ACQUIRE, "agent");
            xb_add(&bar[XB_XGEN(b.x)], 1u);
            asm volatile("s_waitcnt vmcnt(0)" ::: "memory");
        } else {
            XB_SPIN(xb_ld(&bar[XB_XGEN(b.x)]) == gen, bar);
            __builtin_amdgcn_fence(__ATOMIC_ACQUIRE, "agent");
            asm volatile("s_waitcnt vmcnt(0)" ::: "memory");
        }
    }
    __syncthreads();
}


#ifndef STG_W6
#define STG_W6 0
#endif
__device__ __forceinline__ void phase_stagger(int w_ticks) {
    if (w_ticks > 0) { const int bx = blockIdx.x, rank = (bx & 7) * (gridDim.x >> 3) + (bx >> 3);
        const unsigned long long t1 = __builtin_amdgcn_s_memrealtime() + (unsigned long long)((long)w_ticks * rank / gridDim.x);
        while (__builtin_amdgcn_s_memrealtime() < t1) __builtin_amdgcn_s_sleep(8); }
}
__global__ void __launch_bounds__(512, 2) mega_fwd(Params p) {
    extern __shared__ __attribute__((aligned(16))) unsigned char lds_raw[];
    LAS unsigned char* lds = (LAS unsigned char*)lds_raw;
    const int lo = p.ph_lo, hi = p.ph_hi, G = gridDim.x, bx = blockIdx.x;
    unsigned char* ws = p.ws;
    unsigned long long tsa_ = 0, tsb_ = 0;
#define TSA(k) do { if (TS_PHASE == (k)) tsa_ = __builtin_amdgcn_s_memrealtime(); } while (0)
#define TSB(k) do { if (TS_PHASE == (k)) tsb_ = __builtin_amdgcn_s_memrealtime(); } while (0)
#define IN(k) (lo <= (k) && (k) < hi)
    volatile LAS unsigned* bst = (volatile LAS unsigned*)(lds + LDS_BYTES - 64);
    if (threadIdx.x < 2) bst[threadIdx.x] = 0u;
    __syncthreads();
    if (bx == 0) { for (int i = threadIdx.x; i < 4096; i += 512) __hip_atomic_store((unsigned*)ws + i, 0u, __ATOMIC_RELAXED, __HIP_MEMORY_SCOPE_AGENT); }
    if (hi - lo > 1) cg::this_grid().sync();
    XcdBarrier xbar = xcd_barrier_post((unsigned*)ws, bst);
#define SEAM(k) do { if (IN(k) && IN((k) + 1)) { xcd_barrier(xbar); } } while (0)
#define REPS(k) for (int rep_ = 0; rep_ < ((REP_PHASE == (k)) ? 2 : 1); ++rep_)
#define REPSYNC(k) do { if (REP_PHASE == (k) && rep_ == 0) cg::this_grid().sync(); } while (0)
    TSA(0);
    if (IN(0)) REPS(0) { p0_prologue<0>(p, lds, bx, G); __syncthreads(); REPSYNC(0); }
    SEAM(0); TSB(0);
    TSA(1);
    if (IN(1)) REPS(1) {
        { SchedRect<1> S{}; S.A0 = (const char*)(ws + XB_OFF); S.B0 = (const char*)(ws + WINA_OFF); S.pa0 = 2048; S.nt0 = 16; S.nM = MT / 256; S.nN = 12; S.G = G; S.c = bx;
          EpiP1a E{ws, p.out}; pg8::gemm_phase<false>(lds, S, E); }
        { SchedRect<1> S{}; S.A0 = (const char*)(ws + XB_OFF); S.B0 = (const char*)(ws + WINB_OFF); S.pa0 = 2048; S.nt0 = 16; S.nM = MT / 256; S.nN = 4; S.G = G; S.c = bx;
          EpiP1b E{ws}; pg8::gemm_phase<true>(lds, S, E); }
        REPSYNC(1);
    }
    SEAM(1); TSB(1);
    TSA(2);
    if (IN(2)) REPS(2) { p0_prologue<1>(p, lds, bx, G); dft_prep(p); __syncthreads(); REPSYNC(2); }
    SEAM(2); TSB(2);
    TSA(3);
    if (IN(3)) REPS(3) { SchedDft S{(const char*)ws, G, bx}; EpiDft E{ws}; pg8::gemm_phase<false>(lds, S, E);
        int a_lo, a_hi;
        if (G == 256) {
            if (bx < 16) { a_lo = bx * 6; a_hi = a_lo + 6; } else if (bx < 80) { a_lo = 96 + (bx - 16) * 13; a_hi = a_lo + 13; } else if (bx < 160) { a_lo = 928 + (bx - 80) * 12; a_hi = a_lo + 12; }
            else { p0_prologue<2>(p, lds, bx - 160, 96); if (bx < 224) { a_lo = 1888 + (bx - 160) * 10; a_hi = a_lo + 10; } else { a_lo = 2528 + (bx - 224) * 17; a_hi = a_lo + 17; } }
        } else { p0_prologue<2>(p, lds, bx, G); const int per = (3072 + G - 1) / G; a_lo = bx * per; a_hi = min(a_lo + per, 3072); }
        __syncthreads();
        attn_units(p, lds, a_lo, a_hi);
        __syncthreads();
        REPSYNC(3); }
    SEAM(3); TSB(3);
    TSA(4);
    if (IN(4)) REPS(4) {
        SchedMerge S{(const char*)ws, G, bx};
        EpiMerge E{ws, p.out}; pg8::gemm_phase<false>(lds, S, E); REPSYNC(4);
    }
    SEAM(4); TSB(4);
    TSA(5);
    if (IN(5)) {
        SchedRect<1> S{}; S.A0 = (const char*)(ws + MIX_OFF); S.B0 = (const char*)(ws + WOUT_OFF); S.pa0 = 2048; S.nt0 = 16; S.nM = MT / 256; S.nN = 4; S.G = G; S.c = bx;
        EpiRes5 E{p.xp, p.xs, (bf16_t*)(ws + X1B_OFF), (float*)(ws + SS1_OFF)}; pg8::gemm_phase<false>(lds, S, E);
    }
    SEAM(5); TSB(5);
    TSA(6);
    if (IN(6)) REPS(6) {
        phase_stagger(STG_W6);
        SchedRect<1> S{}; S.A0 = (const char*)(ws + X1B_OFF); S.B0 = (const char*)(ws + WUP_OFF); S.pa0 = 2048; S.nt0 = 16; S.nM = MT / 256; S.nN = 16; S.G = G; S.c = bx;
        EpiUp E{(bf16_t*)(ws + H_OFF), (const float*)(ws + SS1_OFF)}; pg8::gemm_phase<false>(lds, S, E); REPSYNC(6);
    }
    SEAM(6); TSB(6);
    TSA(7);
    if (IN(7)) {
        SchedRect<1> S{}; S.A0 = (const char*)(ws + H_OFF); S.B0 = (const char*)(ws + WDN_OFF); S.pa0 = 8192; S.nt0 = 64; S.nM = MT / 256; S.nN = 4; S.G = G; S.c = bx;
        if (G == 256) { EpiRes7F E{(const bf16_t*)(ws + X1B_OFF), (float*)(ws + SS2_OFF), (unsigned*)ws + 3584, p.g_final, p.out}; pg8::gemm_phase<false>(lds, S, E); }
        else { EpiRes7 E{(bf16_t*)(ws + X1B_OFF), (float*)(ws + SS2_OFF)}; pg8::gemm_phase<false>(lds, S, E); }
    }
    if (G != 256) SEAM(7);
    TSB(7);
    TSA(8);
    if (IN(8) && G != 256) {
        const int tid = threadIdx.x, lane = tid & 63, wid = tid >> 6; const float* ss2 = (const float*)(ws + SS2_OFF);
        f32x4 gf[2][2];
#pragma unroll
        for (int j = 0; j < 2; ++j) { gf[j][0] = *(const f32x4*)(p.g_final + 512 * j + lane * 8); gf[j][1] = *(const f32x4*)(p.g_final + 512 * j + lane * 8 + 4); }
        for (int g0 = bx * 8 + wid; g0 < MT; g0 += 2 * G * 8) {
            u32x4 v[2][2]; float rinv[2];
#pragma unroll
            for (int q = 0; q < 2; ++q) { const int g = g0 + q * G * 8; if (g < MT) { const bf16_t* xr = (const bf16_t*)(ws + X1B_OFF) + (size_t)g * 1024;
                    v[q][0] = *(const u32x4*)(xr + lane * 8); v[q][1] = *(const u32x4*)(xr + 512 + lane * 8); rinv[q] = rsqrtf(ss2[g] * (1.0f / 1024.0f) + RMS_EPS); } }
#pragma unroll
            for (int q = 0; q < 2; ++q) { const int g = g0 + q * G * 8; if (g < MT) { float* o = p.out + (size_t)g * 1024;
#pragma unroll
                    for (int j = 0; j < 2; ++j) { const u32x4 b = v[q][j]; f32x4 o0, o1;
                        o0[0] = bf_lo(b.x); o0[1] = bf_hi(b.x); o0[2] = bf_lo(b.y); o0[3] = bf_hi(b.y); o1[0] = bf_lo(b.z); o1[1] = bf_hi(b.z); o1[2] = bf_lo(b.w); o1[3] = bf_hi(b.w);
                        *(f32x4*)(o + 512 * j + lane * 8) = o0 * rinv[q] * gf[j][0]; *(f32x4*)(o + 512 * j + lane * 8 + 4) = o1 * rinv[q] * gf[j][1]; } } }
        }
    }
    TSB(8);
    if (TS_PHASE >= 0 && bx == 0) { const unsigned long long t1 = __builtin_amdgcn_s_memrealtime() + (tsb_ - tsa_); while (__builtin_amdgcn_s_memrealtime() < t1) __builtin_amdgcn_s_sleep(8); }
#undef IN
#undef SEAM
}

extern "C" void kernel_launch(void* const* d_in, const int* in_sizes, int n_in, void* d_out, int out_size, void* d_ws, size_t ws_size, hipStream_t stream) {
    static int grid = 0;
    if (grid == 0) {
        if (n_in != 14 || out_size != MT * D || ws_size < WS_NEED) { fprintf(stderr, "kernel_launch: unexpected shapes (n_in %d, out %d, ws %zu)\n", n_in, out_size, ws_size); grid = -1; return; }
        int dev = 0, cus = 0, per_cu = 0;
        hipGetDevice(&dev); hipDeviceGetAttribute(&cus, hipDeviceAttributeMultiprocessorCount, dev);
        if (hipFuncSetAttribute((const void*)mega_fwd, hipFuncAttributeMaxDynamicSharedMemorySize, LDS_BYTES) != hipSuccess) { fprintf(stderr, "kernel_launch: hipFuncSetAttribute failed\n"); grid = -1; return; }
        if (hipOccupancyMaxActiveBlocksPerMultiprocessor(&per_cu, (const void*)mega_fwd, 512, LDS_BYTES) != hipSuccess || per_cu < 1) per_cu = 1;
        (void)hipGetLastError();
        grid = cus * per_cu;
    }
    if (grid < 0) return;
    Params p{};
    p.xp = (const float*)d_in[0]; p.xs = (const float*)d_in[1]; p.meta = (const float*)d_in[2]; p.w_in = (const float*)d_in[3]; p.rel_bias = (const float*)d_in[4]; p.meta_bias = (const float*)d_in[5];
    p.w_na = (const float*)d_in[6]; p.w_fn = (const float*)d_in[7]; p.w_out = (const float*)d_in[8]; p.g_mix = (const float*)d_in[9]; p.g_mlp = (const float*)d_in[10]; p.w_up = (const float*)d_in[11];
    p.w_down = (const float*)d_in[12]; p.g_final = (const float*)d_in[13]; p.out = (float*)d_out; p.ws = (unsigned char*)d_ws;
#if MK_PER_PHASE
    for (int ph = 0; ph < 9; ++ph) { p.ph_lo = ph; p.ph_hi = ph + 1; hipLaunchKernelGGL(mega_fwd, dim3(grid), dim3(512), LDS_BYTES, stream, p); }
#else
    p.ph_lo = 0; p.ph_hi = 9;
    void* args[] = {&p};
    hipError_t e = hipLaunchCooperativeKernel((const void*)mega_fwd, dim3(grid), dim3(512), args, LDS_BYTES, stream);
    if (e != hipSuccess) fprintf(stderr, "cooperative launch failed: %s (grid %d)\n", hipGetErrorString(e), grid);
#endif
}
```

```cpp
#include <hip/hip_runtime.h>
#include <hip/hip_cooperative_groups.h>
#include <cstdio>
#include <cstdint>
namespace cg = cooperative_groups;

#ifndef MK_PER_PHASE
#define MK_PER_PHASE 0
#endif

#ifndef TS_PHASE
#define TS_PHASE -1
#endif
#ifndef P0REP
#define P0REP -1
#endif
#ifndef EPI2
#define EPI2 -1
#endif
#ifndef REP_PHASE
#define REP_PHASE -1
#endif
#define LAS __attribute__((address_space(3)))
typedef unsigned short bf16_t;
typedef short bf16x8 __attribute__((ext_vector_type(8)));
typedef float f32x4 __attribute__((ext_vector_type(4)));
typedef float f32x2 __attribute__((ext_vector_type(2)));
typedef unsigned u32x4 __attribute__((ext_vector_type(4)));
typedef unsigned u32x2 __attribute__((ext_vector_type(2)));

constexpr int D = 1024, TP = 8192, TS = 4096, MT = 4 * TP + 4 * TS;
constexpr int NP = TP + 16, NS = TS + 16;
constexpr int KPP = 4224, KPS = 2176;
constexpr int MRP = 4352, MRS = 2304;
constexpr float RMS_EPS = 1e-6f;
constexpr size_t MiB = 1u << 20;
constexpr size_t SS1_OFF = 64 * 1024, SS2_OFF = 256 * 1024, KMETA_OFF = 512 * 1024, VMETAT_OFF = 528 * 1024;
constexpr size_t WINA_OFF = 1 * MiB, WINB_OFF = 7 * MiB, WUP_OFF = 9 * MiB, WDN_OFF = 17 * MiB, WOUT_OFF = 25 * MiB, WNA_OFF = 27 * MiB, WFN_OFF = 28 * MiB;
constexpr size_t XB_OFF = 30 * MiB;
constexpr size_t CP_OFF = 126 * MiB, SP_OFF = CP_OFF + (size_t)MRP * KPP * 2, CS_OFF = SP_OFF + (size_t)MRP * KPP * 2, SSM_OFF = CS_OFF + (size_t)MRS * KPS * 2;
constexpr size_t Q_OFF = 234 * MiB, K_OFF = 282 * MiB, VT_OFF = 330 * MiB, UT_OFF = 378 * MiB;
constexpr size_t ATT_OFF = 30 * MiB, UE_OFF = 427 * MiB, UO_OFF = 452 * MiB;
constexpr size_t PB_OFF = 78 * MiB, QB_OFF = 378 * MiB, MIX_OFF = 126 * MiB, X1B_OFF = 414 * MiB, H_OFF = 30 * MiB;
constexpr size_t WS_NEED = 510 * MiB;
static_assert(SSM_OFF + (size_t)MRS * KPS * 2 <= 234 * MiB, "dft matrices");
static_assert(UT_OFF + (size_t)512 * 2 * (4 * NP + 4 * NS) <= UE_OFF, "ut");
constexpr int LDS_BYTES = 160 * 1024;

__device__ __forceinline__ unsigned cvt_pk_bf16(float lo, float hi) { unsigned r; asm volatile("v_cvt_pk_bf16_f32 %0, %1, %2" : "=v"(r) : "v"(lo), "v"(hi)); return r; }
__device__ __forceinline__ float bf_lo(unsigned w) { return __uint_as_float(w << 16); }
__device__ __forceinline__ float bf_hi(unsigned w) { return __uint_as_float(w & 0xffff0000u); }
__device__ __forceinline__ float wave_sum(float v) {
#pragma unroll
    for (int o = 1; o < 64; o <<= 1) v += __shfl_xor(v, o);
    return v;
}
__device__ __forceinline__ int batch_base(int b) { return b < 4 ? b * TP : 4 * TP + (b - 4) * TS; }

struct Params {
    const float* xp; const float* xs; const float* meta; const float* w_in; const float* rel_bias; const float* meta_bias;
    const float* w_na; const float* w_fn; const float* w_out; const float* g_mix; const float* g_mlp; const float* w_up; const float* w_down; const float* g_final;
    float* out; unsigned char* ws; int ph_lo, ph_hi;
};

namespace pg8 {
constexpr int BM = 256, BK = 64, HALF = 128, HTB = HALF * BK * 2, STAGE_BYTES = 8 * HTB;
__device__ __forceinline__ int lds_byte(int r, int c) { const int st = (r >> 4) * 2 + (c >> 5), rr = r & 15, cc = c & 31, ob = rr * 64 + cc * 2; return st * 1024 + (ob ^ (((ob >> 9) & 1) << 5)); }
__device__ __forceinline__ void stage_rc(int b, int& R, int& C) { const int st = b / 1024, sb = b % 1024, swz = sb ^ (((sb >> 9) & 1) << 5); R = (st >> 1) * 16 + swz / 64; C = (st & 1) * 32 + (swz % 64) / 2; }
__device__ __forceinline__ int perm32(int rho) { const int n = rho >> 4, i = rho & 15; return 8 * (i >> 2) + 4 * n + (i & 3); }

struct Unit { const char* A; const char* B; int pa, pb, nt, pm, pn, aux; };

__device__ __forceinline__ bool rect_tile(long L, int nM, int nN, int& pm, int& pn) {
    const int nwg = nM * nN; if (L >= nwg) return false;
    int wgid = (int)L; { const int q = nwg / 8, r = nwg % 8, xcd = wgid % 8, off = wgid / 8; wgid = (xcd < r ? xcd * (q + 1) : r * (q + 1) + (xcd - r) * q) + off; }
    const int nig = 8 * nN, gid = wgid / nig, fm = gid * 8, gsz = (nM - fm) < 8 ? (nM - fm) : 8;
    pm = fm + ((wgid % nig) % gsz); pn = (wgid % nig) / gsz; return true;
}

template <bool TRANS, class Epi, class Sched>
__device__ __forceinline__ void gemm_phase(LAS unsigned char* lds, const Sched& S, const Epi& E) {
    const int tid = threadIdx.x, wid = __builtin_amdgcn_readfirstlane(tid >> 6), lane = tid & 63, wr = wid >> 2, wc = wid & 3, fr = lane & 15, fq = lane >> 4;
    int RA[2], RB[2], CB[2];
#pragma unroll
    for (int i = 0; i < 2; ++i) { int R, C; stage_rc(tid * 16 + i * 8192, R, C); RA[i] = R; RB[i] = Epi::PERM ? ((R & ~31) + perm32(R & 31)) : R; CB[i] = C * 2; }
    const unsigned ldsw = (unsigned)wid * 1024u;
    const int aoff = lds_byte(wr * 64 + fr, fq * 8), boff = lds_byte(wc * 32 + fr, fq * 8);
#define PG8_SA(b, h) (((b) * 2 + (h)) * HTB)
#define PG8_SB(b, h) ((4 + (b) * 2 + (h)) * HTB)
#define PG8_STAGE(bufoff, gbase, pitch, RR) do { _Pragma("unroll") for (int _i = 0; _i < 2; ++_i) \
        __builtin_amdgcn_global_load_lds((const unsigned*)((const char*)(gbase) + (unsigned)((RR)[_i] * (pitch) + CB[_i])), (LAS unsigned*)(lds + (bufoff) + ldsw + _i * 8192), 16, 0, 0); } while (0)
#define PG8_LDA(dst, b, h) do { _Pragma("unroll") for (int m = 0; m < 4; ++m) _Pragma("unroll") for (int k = 0; k < 2; ++k) dst[m][k] = *(const LAS bf16x8*)(lds + PG8_SA(b, h) + aoff + m * 2048 + k * 1024); } while (0)
#define PG8_LDB(dst, b, h) do { _Pragma("unroll") for (int n = 0; n < 2; ++n) _Pragma("unroll") for (int k = 0; k < 2; ++k) dst[n][k] = *(const LAS bf16x8*)(lds + PG8_SB(b, h) + boff + n * 2048 + k * 1024); } while (0)
#define PG8_MMA(ai, bj, At, Bt) do { __builtin_amdgcn_s_setprio(1); _Pragma("unroll") for (int m = 0; m < 4; ++m) _Pragma("unroll") for (int n = 0; n < 2; ++n) _Pragma("unroll") for (int k = 0; k < 2; ++k) \
        acc[ai][bj][m][n] = TRANS ? __builtin_amdgcn_mfma_f32_16x16x32_bf16(At[m][k], Bt[n][k], acc[ai][bj][m][n], 0, 0, 0) \
                                  : __builtin_amdgcn_mfma_f32_16x16x32_bf16(Bt[n][k], At[m][k], acc[ai][bj][m][n], 0, 0, 0); __builtin_amdgcn_s_setprio(0); } while (0)
#define PG8_WAIT_V(n) asm volatile("s_waitcnt vmcnt(" #n ")" ::: "memory")
#define PG8_WAIT_L(n) asm volatile("s_waitcnt lgkmcnt(" #n ")" ::: "memory")
#define PG8_BAR __builtin_amdgcn_s_barrier()
#define PG8_SCHED __builtin_amdgcn_sched_barrier(0)
    Unit cur, nxt; int ui = 0;
    if (!S.next(0, cur)) return;
    float pfv[8];
    if constexpr (Epi::PREF) E.prefetch(cur, wr, fr, pfv);
    f32x4 acc[2][2][4][2];
#pragma unroll
    for (int a = 0; a < 2; ++a)
#pragma unroll
        for (int b = 0; b < 2; ++b)
#pragma unroll
            for (int m = 0; m < 4; ++m)
#pragma unroll
                for (int n = 0; n < 2; ++n) acc[a][b][m][n] = (f32x4){0.f, 0.f, 0.f, 0.f};
    bf16x8 At[4][2], B0[2][2], B1[2][2];
    const char* cA = cur.A; const char* cB = cur.B; int cpa = cur.pa, cpb = cur.pb;
    {
        const size_t hA = (size_t)HALF * cpa, hB = (size_t)HALF * cpb;
        PG8_STAGE(PG8_SB(0, 0), cB, cpb, RB); PG8_STAGE(PG8_SB(0, 1), cB + hB, cpb, RB); PG8_STAGE(PG8_SA(0, 0), cA, cpa, RA); PG8_STAGE(PG8_SA(0, 1), cA + hA, cpa, RA);
        if (wr == 1) PG8_BAR;
        PG8_WAIT_V(2); PG8_BAR;
        PG8_STAGE(PG8_SB(1, 0), cB + 128, cpb, RB); PG8_STAGE(PG8_SA(1, 0), cA + 128, cpa, RA); PG8_STAGE(PG8_SB(1, 1), cB + hB + 128, cpb, RB);
        PG8_WAIT_V(6); PG8_BAR;
    }
    for (;;) {
        const bool has_next = S.next(ui + 1, nxt);
        const char* nA = has_next ? nxt.A : cA; const char* nB = has_next ? nxt.B : cB; const int npa = has_next ? nxt.pa : cpa, npb = has_next ? nxt.pb : cpb;
        const int nt = cur.nt; const size_t hA = (size_t)HALF * cpa;
        for (int t = 0; t < nt; t += 2) {
            const bool last = (t == nt - 2);
            const char* a1 = cA + (size_t)(t + 1) * 128;
            const char* a2 = last ? nA : cA + (size_t)(t + 2) * 128; const char* b2 = last ? nB : cB + (size_t)(t + 2) * 128;
            const int pa2 = last ? npa : cpa, pb2 = last ? npb : cpb; const size_t hA2 = (size_t)HALF * pa2, hB2 = (size_t)HALF * pb2;
            const char* a3 = a2 + 128; const char* b3 = b2 + 128;
            PG8_LDB(B0, 0, 0); PG8_LDB(B1, 0, 1); PG8_SCHED; PG8_LDA(At, 0, 0); PG8_STAGE(PG8_SA(1, 1), a1 + hA, cpa, RA);
            PG8_WAIT_V(8); PG8_WAIT_L(0); PG8_BAR; PG8_MMA(0, 0, At, B0); PG8_MMA(0, 1, At, B1); PG8_BAR; PG8_SCHED;
            PG8_LDA(At, 0, 1); PG8_STAGE(PG8_SB(0, 0), b2, pb2, RB); PG8_STAGE(PG8_SB(0, 1), b2 + hB2, pb2, RB); PG8_STAGE(PG8_SA(0, 0), a2, pa2, RA);
            PG8_WAIT_V(8); PG8_WAIT_L(0); PG8_BAR; PG8_MMA(1, 0, At, B0); PG8_MMA(1, 1, At, B1); PG8_BAR; PG8_SCHED;
            PG8_LDB(B0, 1, 0); PG8_LDB(B1, 1, 1); PG8_SCHED; PG8_LDA(At, 1, 0); PG8_STAGE(PG8_SA(0, 1), a2 + hA2, pa2, RA);
            PG8_WAIT_V(8); PG8_WAIT_L(0); PG8_BAR; PG8_MMA(0, 0, At, B0); PG8_MMA(0, 1, At, B1); PG8_BAR; PG8_SCHED;
            PG8_LDA(At, 1, 1); PG8_STAGE(PG8_SB(1, 0), b3, pb2, RB); PG8_STAGE(PG8_SB(1, 1), b3 + hB2, pb2, RB); PG8_STAGE(PG8_SA(1, 0), a3, pa2, RA);
            PG8_WAIT_V(8); PG8_WAIT_L(0); PG8_BAR; PG8_MMA(1, 0, At, B0); PG8_MMA(1, 1, At, B1); PG8_BAR; PG8_SCHED;
        }
        if (wr == 0) PG8_BAR;
        bool keep;
        if constexpr (Epi::PREF) keep = E.run(acc, cur, wr, wc, fr, fq, pfv);
        else { if (Epi::TWICE) (void)E(acc, cur, wr, wc, fr, fq); keep = E(acc, cur, wr, wc, fr, fq); }
        if (!has_next) break;
        if (!keep) {
#pragma unroll
            for (int a = 0; a < 2; ++a)
#pragma unroll
                for (int b = 0; b < 2; ++b)
#pragma unroll
                    for (int m = 0; m < 4; ++m)
#pragma unroll
                        for (int n = 0; n < 2; ++n) acc[a][b][m][n] = (f32x4){0.f, 0.f, 0.f, 0.f};
        }
        cur = nxt; cA = nA; cB = nB; cpa = npa; cpb = npb; ++ui;
        if constexpr (Epi::PREF) E.prefetch(cur, wr, fr, pfv);
        if (wr == 1) PG8_BAR;
    }
    PG8_WAIT_V(0);
    PG8_BAR;
#undef PG8_SA
#undef PG8_SB
#undef PG8_STAGE
#undef PG8_LDA
#undef PG8_LDB
#undef PG8_MMA
#undef PG8_WAIT_V
#undef PG8_WAIT_L
#undef PG8_BAR
#undef PG8_SCHED
}
}
using pg8::Unit;

template <int NSUB> struct SchedRect {
    const char* A0; const char* B0; const char* A1; const char* B1; int pa0, nt0, pa1, nt1; int nM, nN, G, c;
    __device__ __forceinline__ bool next(int i, Unit& u) const {
        const int ti = i / NSUB, s = i % NSUB; int pm, pn;
        if (!pg8::rect_tile((long)ti * G + c, nM, nN, pm, pn)) return false;
        const int pa = (NSUB > 1 && s) ? pa1 : pa0;
        u.pa = pa; u.pb = pa; u.nt = (NSUB > 1 && s) ? nt1 : nt0; u.pm = pm; u.pn = pn; u.aux = s;
        u.A = ((NSUB > 1 && s) ? A1 : A0) + (size_t)pm * 256 * pa; u.B = ((NSUB > 1 && s) ? B1 : B0) + (size_t)pn * 256 * pa; return true;
    }
};

struct SchedMerge {
    const char* ws; int G, c;
    __device__ __forceinline__ bool next(int i, Unit& u) const {
        const int ti = i / 3, s = i % 3; int pm, pn;
        if (!pg8::rect_tile((long)ti * G + c, MT / 256, 4, pm, pn)) return false;
        u.pa = 1024; u.nt = 8; u.pm = pm; u.pn = pn; u.aux = s;
        if (s == 0) { u.A = ws + ATT_OFF + (size_t)pm * 256 * 1024; u.B = ws + WNA_OFF + (size_t)pn * 256 * 1024; u.pb = 1024; }
        else { u.A = ws + (s == 1 ? PB_OFF : QB_OFF) + (size_t)pm * 256 * 1024; u.B = ws + WFN_OFF + (size_t)pn * 256 * 2048 + (s == 2 ? 1024 : 0); u.pb = 2048; }
        return true;
    }
};
struct SchedDft {
    const char* ws; int G, c;
    __device__ __forceinline__ bool next(int i, Unit& u) const {
        const long L = (long)i * G + c; if (L >= 416) return false;
        int pm, b, pn;
        if (L < 272) {
            if (L < 256) { const int x = (int)L & 7, s = (int)L >> 3; pm = 8 * (x >> 2) + (s & 7); b = s >> 3; pn = x & 3; }
            else { const int e = (int)L - 256; pm = 16; b = e >> 2; pn = e & 3; }
            u.pa = KPP * 2; u.pb = KPP * 2; u.nt = KPP / 64;
            u.A = ws + (pn < 2 ? CP_OFF : SP_OFF) + (size_t)pm * 256 * KPP * 2;
            u.B = ws + (pn < 2 ? UE_OFF : UO_OFF) + ((size_t)b * 512 + (pn & 1) * 256) * KPP * 2;
        } else {
            const int l = (int)L - 272, x = l & 7, s = l >> 3; pn = x & 3; pm = s % 9; b = 4 + 2 * (s / 9) + (x >> 2);
            u.pa = KPS * 2; u.pb = KPS * 2; u.nt = KPS / 64;
            u.A = ws + (pn < 2 ? CS_OFF : SSM_OFF) + (size_t)pm * 256 * KPS * 2;
            u.B = ws + (pn < 2 ? UE_OFF : UO_OFF) + (size_t)4 * 512 * KPP * 2 + ((size_t)(b - 4) * 512 + (pn & 1) * 256) * KPS * 2;
        }
        u.pm = pm; u.pn = pn; u.aux = b; return true;
    }
};

__device__ __forceinline__ float sigmoidf_(float v) { return __builtin_amdgcn_rcpf(1.0f + __builtin_amdgcn_exp2f(-1.44269504f * v)); }
typedef f32x4 Acc[2][2][4][2];

struct EpiP1a {
    static constexpr bool PERM = true, TWICE = (EPI2 == 1), PREF = false;
    unsigned char* ws; float* gates;
    __device__ __forceinline__ bool operator()(Acc& acc, const Unit& u, int wr, int wc, int fr, int fq) const {
        asm volatile("" : "+v"(fr), "+v"(fq));
        const int row0 = u.pm * 256 + wr * 64 + fr;
        if (u.pn < 4) {
            bf16_t* base = (bf16_t*)(ws + (u.pn < 2 ? Q_OFF : K_OFF)); const int col0 = (u.pn & 1) * 256 + wc * 32 + 8 * fq;
#pragma unroll
            for (int ai = 0; ai < 2; ++ai)
#pragma unroll
                for (int m = 0; m < 4; ++m) { bf16_t* rowp = base + (size_t)(row0 + ai * 128 + m * 16) * 512 + col0;
#pragma unroll
                    for (int bj = 0; bj < 2; ++bj) { const f32x4 v0 = acc[ai][bj][m][0], v1 = acc[ai][bj][m][1];
                        u32x4 w; w.x = cvt_pk_bf16(v0[0], v0[1]); w.y = cvt_pk_bf16(v0[2], v0[3]); w.z = cvt_pk_bf16(v1[0], v1[1]); w.w = cvt_pk_bf16(v1[2], v1[3]);
                        *(u32x4*)(rowp + bj * 128) = w; } }
        } else {
            bf16_t* Rb = (bf16_t*)gates; bf16_t* Sb = Rb + (size_t)MT * 1024; const int col0 = (u.pn - 4) * 128 + wc * 32 + 8 * fq;
#pragma unroll
            for (int ai = 0; ai < 2; ++ai)
#pragma unroll
                for (int m = 0; m < 4; ++m) { const size_t off = (size_t)(row0 + ai * 128 + m * 16) * 1024 + col0; float rr[8], s2[8];
#pragma unroll
                    for (int n = 0; n < 2; ++n)
#pragma unroll
                        for (int e = 0; e < 4; ++e) { const float e1 = __builtin_amdgcn_exp2f(fminf(-1.44269504f * acc[ai][0][m][n][e], 60.f)), e2 = __builtin_amdgcn_exp2f(fminf(-1.44269504f * acc[ai][1][m][n][e], 60.f));
                            const float d1 = 1.0f + e1, d2 = 1.0f + e2, t = __builtin_amdgcn_rcpf(d1 * d2);
                            s2[4 * n + e] = t * d1; rr[4 * n + e] = d2 * d2 * t; }
                    u32x4 w; w.x = cvt_pk_bf16(rr[0], rr[1]); w.y = cvt_pk_bf16(rr[2], rr[3]); w.z = cvt_pk_bf16(rr[4], rr[5]); w.w = cvt_pk_bf16(rr[6], rr[7]);
                    *(u32x4*)(Rb + off) = w;
                    w.x = cvt_pk_bf16(s2[0], s2[1]); w.y = cvt_pk_bf16(s2[2], s2[3]); w.z = cvt_pk_bf16(s2[4], s2[5]); w.w = cvt_pk_bf16(s2[6], s2[7]);
                    *(u32x4*)(Sb + off) = w; }
        }
        return false;
    }
};
struct EpiP1b {
    static constexpr bool PERM = false, TWICE = (EPI2 == 1), PREF = false;
    unsigned char* ws;
    __device__ __forceinline__ bool operator()(Acc& acc, const Unit& u, int wr, int wc, int fr, int fq) const {
        asm volatile("" : "+v"(fr), "+v"(fq));
        const int g0 = u.pm * 256; const int b = g0 < 4 * TP ? g0 / TP : 4 + (g0 - 4 * TP) / TS; const int gb = batch_base(b), T = b < 4 ? TP : TS, N = T + 16;
        bf16_t* base; size_t pitch; int coff;
        if (u.pn < 2) { base = (bf16_t*)(ws + VT_OFF) + (size_t)512 * gb; pitch = T; coff = u.pn * 256; }
        else { base = (bf16_t*)(ws + UT_OFF) + (b < 4 ? (size_t)b * 512 * NP : (size_t)4 * 512 * NP + (size_t)(b - 4) * 512 * NS) + 16; pitch = N; coff = (u.pn - 2) * 256; }
        const int t0 = g0 - gb + wr * 64 + 4 * fq, c0 = coff + wc * 32 + fr;
#pragma unroll
        for (int ai = 0; ai < 2; ++ai)
#pragma unroll
            for (int bj = 0; bj < 2; ++bj)
#pragma unroll
                for (int m = 0; m < 4; ++m)
#pragma unroll
                    for (int n = 0; n < 2; ++n) { const f32x4 v = acc[ai][bj][m][n]; u32x2 w; w.x = cvt_pk_bf16(v[0], v[1]); w.y = cvt_pk_bf16(v[2], v[3]);
                        *(u32x2*)(base + (size_t)(c0 + bj * 128 + n * 16) * pitch + t0 + ai * 128 + m * 16) = w; }
        return false;
    }
};
struct EpiDft {
    static constexpr bool PERM = true, TWICE = (EPI2 == 3), PREF = false;
    unsigned char* ws;
    __device__ __forceinline__ bool operator()(Acc& acc, const Unit& u, int wr, int wc, int fr, int fq) const {
        asm volatile("" : "+v"(fr), "+v"(fq));
        const int b = u.aux, gb = batch_base(b), N = (b < 4 ? TP : TS) + 16, HN = N / 2;
        bf16_t* base = (bf16_t*)(ws + (u.pn < 2 ? PB_OFF : QB_OFF)) + (size_t)gb * 512 + (u.pn & 1) * 256 + wc * 32 + 8 * fq;
        const float sg = u.pn >= 2 ? -1.f : 1.f;
#pragma unroll
        for (int ai = 0; ai < 2; ++ai)
#pragma unroll
            for (int m = 0; m < 4; ++m) { const int np = u.pm * 256 + ai * 128 + wr * 64 + m * 16 + fr + 1;
                if (np <= HN) {
#pragma unroll
                    for (int bj = 0; bj < 2; ++bj) { const f32x4 v0 = acc[ai][bj][m][0], v1 = acc[ai][bj][m][1];
                        if (np >= 16) { u32x4 w; w.x = cvt_pk_bf16(v0[0], v0[1]); w.y = cvt_pk_bf16(v0[2], v0[3]); w.z = cvt_pk_bf16(v1[0], v1[1]); w.w = cvt_pk_bf16(v1[2], v1[3]);
                            *(u32x4*)(base + (size_t)(np - 16) * 512 + bj * 128) = w; }
                        if (np != HN) { u32x4 w; w.x = cvt_pk_bf16(sg * v0[0], sg * v0[1]); w.y = cvt_pk_bf16(sg * v0[2], sg * v0[3]); w.z = cvt_pk_bf16(sg * v1[0], sg * v1[1]); w.w = cvt_pk_bf16(sg * v1[2], sg * v1[3]);
                            *(u32x4*)(base + (size_t)(N - np - 16) * 512 + bj * 128) = w; } } } }
        return false;
    }
};
struct EpiMerge {
    static constexpr bool PERM = true, TWICE = false, PREF = false;
    unsigned char* ws; const float* gates;
    __device__ __forceinline__ bool operator()(Acc& acc, const Unit& u, int wr, int wc, int fr, int fq) const {
        if (u.aux == 1) return true;
        asm volatile("" : "+v"(fr), "+v"(fq));
        const bf16_t* Gs = (const bf16_t*)gates + (u.aux == 0 ? (size_t)0 : (size_t)MT * 1024);
        const int row0 = u.pm * 256 + wr * 64 + fr, col0 = u.pn * 256 + wc * 32 + 8 * fq;
        bf16_t* mix = (bf16_t*)(ws + MIX_OFF);
        u32x4 g2[4][2];
#pragma unroll
        for (int q = 0; q < 3; ++q)
#pragma unroll
            for (int bj = 0; bj < 2; ++bj) g2[q][bj] = *(const u32x4*)(Gs + (size_t)(row0 + q * 16) * 1024 + col0 + bj * 128);
#pragma unroll
        for (int idx = 0; idx < 8; ++idx) { const int ai = idx >> 2, m = idx & 3; const size_t off = (size_t)(row0 + ai * 128 + m * 16) * 1024 + col0;
            if (idx < 5) { const int ai2 = (idx + 3) >> 2, m2 = (idx + 3) & 3; const size_t off2 = (size_t)(row0 + ai2 * 128 + m2 * 16) * 1024 + col0;
#pragma unroll
                for (int bj = 0; bj < 2; ++bj) g2[(idx + 3) & 3][bj] = *(const u32x4*)(Gs + off2 + bj * 128); }
#pragma unroll
            for (int bj = 0; bj < 2; ++bj) { const u32x4 w2 = g2[idx & 3][bj];
                const float sc[8] = {bf_lo(w2.x), bf_hi(w2.x), bf_lo(w2.y), bf_hi(w2.y), bf_lo(w2.z), bf_hi(w2.z), bf_lo(w2.w), bf_hi(w2.w)};
#pragma unroll
                for (int e = 0; e < 4; ++e) { acc[ai][bj][m][0][e] *= sc[e]; acc[ai][bj][m][1][e] *= sc[4 + e]; }
                if (u.aux == 2) { const f32x4 v0 = acc[ai][bj][m][0], v1 = acc[ai][bj][m][1]; u32x4 w;
                    w.x = cvt_pk_bf16(v0[0], v0[1]); w.y = cvt_pk_bf16(v0[2], v0[3]); w.z = cvt_pk_bf16(v1[0], v1[1]); w.w = cvt_pk_bf16(v1[2], v1[3]);
                    *(u32x4*)(mix + off + bj * 128) = w; } } }
        return u.aux == 0;
    }
};
struct EpiRes5 {
    static constexpr bool PERM = true, TWICE = false, PREF = false;
    const float* bp; const float* bs; bf16_t* ob; float* ss;
    __device__ __forceinline__ bool operator()(Acc& acc, const Unit& u, int wr, int wc, int fr, int fq) const {
        asm volatile("" : "+v"(fr), "+v"(fq));
        const int g0 = u.pm * 256; const float* base = g0 < 4 * TP ? bp + (size_t)g0 * 1024 : bs + (size_t)(g0 - 4 * TP) * 1024;
        const int lr0 = wr * 64 + fr, col0 = u.pn * 256 + wc * 32 + 8 * fq;
        f32x4 pre[3][2][2];
#pragma unroll
        for (int q = 0; q < 2; ++q)
#pragma unroll
            for (int bj = 0; bj < 2; ++bj)
#pragma unroll
                for (int n = 0; n < 2; ++n) pre[q][bj][n] = *(const f32x4*)(base + (size_t)(lr0 + q * 16) * 1024 + col0 + bj * 128 + n * 4);
#pragma unroll
        for (int idx = 0; idx < 8; ++idx) { const int ai = idx >> 2, m = idx & 3; const int lr = lr0 + ai * 128 + m * 16; float s = 0.f;
            if (idx < 6) { const int lr2 = lr0 + ((idx + 2) >> 2) * 128 + ((idx + 2) & 3) * 16;
#pragma unroll
                for (int bj = 0; bj < 2; ++bj)
#pragma unroll
                    for (int n = 0; n < 2; ++n) pre[(idx + 2) % 3][bj][n] = *(const f32x4*)(base + (size_t)lr2 * 1024 + col0 + bj * 128 + n * 4); }
#pragma unroll
            for (int bj = 0; bj < 2; ++bj) { const f32x4 o0 = pre[idx % 3][bj][0] + acc[ai][bj][m][0], o1 = pre[idx % 3][bj][1] + acc[ai][bj][m][1];
                s += ((o0[0] * o0[0] + o0[1] * o0[1]) + (o0[2] * o0[2] + o0[3] * o0[3])) + ((o1[0] * o1[0] + o1[1] * o1[1]) + (o1[2] * o1[2] + o1[3] * o1[3]));
                u32x4 w; w.x = cvt_pk_bf16(o0[0], o0[1]); w.y = cvt_pk_bf16(o0[2], o0[3]); w.z = cvt_pk_bf16(o1[0], o1[1]); w.w = cvt_pk_bf16(o1[2], o1[3]);
                *(u32x4*)(ob + (size_t)(g0 + lr) * 1024 + col0 + bj * 128) = w; }
            s += __shfl_xor(s, 16); s += __shfl_xor(s, 32);
            if (fq == 0) atomicAdd(ss + g0 + lr, s); }
        return false;
    }
};
struct EpiRes7 {
    static constexpr bool PERM = true, TWICE = false, PREF = false;
    bf16_t* xb; float* ss;
    __device__ __forceinline__ bool operator()(Acc& acc, const Unit& u, int wr, int wc, int fr, int fq) const {
        asm volatile("" : "+v"(fr), "+v"(fq));
        const int row0 = u.pm * 256 + wr * 64 + fr, col0 = u.pn * 256 + wc * 32 + 8 * fq;
        u32x4 pre[4][2];
#pragma unroll
        for (int q = 0; q < 3; ++q)
#pragma unroll
            for (int bj = 0; bj < 2; ++bj) pre[q][bj] = *(const u32x4*)(xb + (size_t)(row0 + q * 16) * 1024 + col0 + bj * 128);
#pragma unroll
        for (int idx = 0; idx < 8; ++idx) { const int ai = idx >> 2, m = idx & 3; const int row = row0 + ai * 128 + m * 16; float s = 0.f;
            if (idx < 5) { const int row2 = row0 + ((idx + 3) >> 2) * 128 + ((idx + 3) & 3) * 16;
#pragma unroll
                for (int bj = 0; bj < 2; ++bj) pre[(idx + 3) & 3][bj] = *(const u32x4*)(xb + (size_t)row2 * 1024 + col0 + bj * 128); }
#pragma unroll
            for (int bj = 0; bj < 2; ++bj) { const u32x4 b = pre[idx & 3][bj]; const f32x4 a0 = acc[ai][bj][m][0], a1 = acc[ai][bj][m][1];
                const float o[8] = {bf_lo(b.x) + a0[0], bf_hi(b.x) + a0[1], bf_lo(b.y) + a0[2], bf_hi(b.y) + a0[3], bf_lo(b.z) + a1[0], bf_hi(b.z) + a1[1], bf_lo(b.w) + a1[2], bf_hi(b.w) + a1[3]};
#pragma unroll
                for (int e = 0; e < 8; ++e) s += o[e] * o[e];
                u32x4 w; w.x = cvt_pk_bf16(o[0], o[1]); w.y = cvt_pk_bf16(o[2], o[3]); w.z = cvt_pk_bf16(o[4], o[5]); w.w = cvt_pk_bf16(o[6], o[7]);
                *(u32x4*)(xb + (size_t)row * 1024 + col0 + bj * 128) = w; }
            s += __shfl_xor(s, 16); s += __shfl_xor(s, 32);
            if (fq == 0) atomicAdd(ss + row, s); }
        return false;
    }
};
struct EpiRes7F {
    static constexpr bool PERM = true, TWICE = false, PREF = false;
    const bf16_t* xb; float* ss; unsigned* cnt; const float* gfin; float* out;
    __device__ __forceinline__ bool operator()(Acc& acc, const Unit& u, int wr, int wc, int fr, int fq) const {
        asm volatile("" : "+v"(fr), "+v"(fq));
        const int row0 = u.pm * 256 + wr * 64 + fr, col0 = u.pn * 256 + wc * 32 + 8 * fq;
        u32x4 pre[4][2];
#pragma unroll
        for (int q = 0; q < 3; ++q)
#pragma unroll
            for (int bj = 0; bj < 2; ++bj) pre[q][bj] = *(const u32x4*)(xb + (size_t)(row0 + q * 16) * 1024 + col0 + bj * 128);
#pragma unroll
        for (int idx = 0; idx < 8; ++idx) { const int ai = idx >> 2, m = idx & 3; const int row = row0 + ai * 128 + m * 16; float s = 0.f;
            if (idx < 5) { const int row2 = row0 + ((idx + 3) >> 2) * 128 + ((idx + 3) & 3) * 16;
#pragma unroll
                for (int bj = 0; bj < 2; ++bj) pre[(idx + 3) & 3][bj] = *(const u32x4*)(xb + (size_t)row2 * 1024 + col0 + bj * 128); }
#pragma unroll
            for (int bj = 0; bj < 2; ++bj) { const u32x4 b = pre[idx & 3][bj]; f32x4& a0 = acc[ai][bj][m][0]; f32x4& a1 = acc[ai][bj][m][1];
                a0[0] += bf_lo(b.x); a0[1] += bf_hi(b.x); a0[2] += bf_lo(b.y); a0[3] += bf_hi(b.y); a1[0] += bf_lo(b.z); a1[1] += bf_hi(b.z); a1[2] += bf_lo(b.w); a1[3] += bf_hi(b.w);
#pragma unroll
                for (int e = 0; e < 4; ++e) s += a0[e] * a0[e] + a1[e] * a1[e]; }
            s += __shfl_xor(s, 16); s += __shfl_xor(s, 32);
            if (fq == 0) atomicAdd(ss + row, s); }
        asm volatile("s_waitcnt vmcnt(0)" ::: "memory");
        __builtin_amdgcn_s_barrier();
        if (threadIdx.x == 0) { unsigned* c = cnt + u.pm; __hip_atomic_fetch_add(c, 1u, __ATOMIC_RELAXED, __HIP_MEMORY_SCOPE_AGENT);
            unsigned sp = 0; while (__hip_atomic_load(c, __ATOMIC_RELAXED, __HIP_MEMORY_SCOPE_AGENT) < 4u && ++sp < (1u << 22)) __builtin_amdgcn_s_sleep(2); }
        __builtin_amdgcn_s_barrier(); asm volatile("" ::: "memory");
        float rv[8];
#pragma unroll
        for (int idx = 0; idx < 8; ++idx) rv[idx] = __hip_atomic_load(ss + row0 + (idx >> 2) * 128 + (idx & 3) * 16, __ATOMIC_RELAXED, __HIP_MEMORY_SCOPE_AGENT);
        f32x4 gf[2][2];
#pragma unroll
        for (int bj = 0; bj < 2; ++bj) { gf[bj][0] = *(const f32x4*)(gfin + col0 + bj * 128); gf[bj][1] = *(const f32x4*)(gfin + col0 + bj * 128 + 4); }
#pragma unroll
        for (int idx = 0; idx < 8; ++idx) { const int ai = idx >> 2, m = idx & 3; const int row = row0 + ai * 128 + m * 16; const float rinv = rsqrtf(rv[idx] * (1.0f / 1024.0f) + RMS_EPS);
#pragma unroll
            for (int bj = 0; bj < 2; ++bj) { float* o = out + (size_t)row * 1024 + col0 + bj * 128;
                *(f32x4*)o = acc[ai][bj][m][0] * rinv * gf[bj][0]; *(f32x4*)(o + 4) = acc[ai][bj][m][1] * rinv * gf[bj][1]; } }
        return false;
    }
};
struct EpiUp {
    static constexpr bool PERM = true, TWICE = (EPI2 == 6), PREF = true;
    bf16_t* H; const float* ss;
    __device__ __forceinline__ void prefetch(const Unit& u, int wr, int fr, float (&rv)[8]) const {
        const int row0 = u.pm * 256 + wr * 64 + fr;
#pragma unroll
        for (int idx = 0; idx < 8; ++idx) rv[idx] = ss[row0 + (idx >> 2) * 128 + (idx & 3) * 16];
    }
    __device__ __forceinline__ bool run(Acc& acc, const Unit& u, int wr, int wc, int fr, int fq, const float (&rv)[8]) const {
        asm volatile("" : "+v"(fr), "+v"(fq));
        const int row0 = u.pm * 256 + wr * 64 + fr, col0 = u.pn * 256 + wc * 32 + 8 * fq;
#pragma unroll
        for (int ai = 0; ai < 2; ++ai)
#pragma unroll
            for (int m = 0; m < 4; ++m) { const int row = row0 + ai * 128 + m * 16; const float rinv = rsqrtf(rv[ai * 4 + m] * (1.0f / 1024.0f) + RMS_EPS);
#pragma unroll
                for (int bj = 0; bj < 2; ++bj) { f32x4 v0 = acc[ai][bj][m][0], v1 = acc[ai][bj][m][1];
#pragma unroll
                    for (int e = 0; e < 4; ++e) { const float a = fmaxf(v0[e] * rinv, 0.f), b = fmaxf(v1[e] * rinv, 0.f); v0[e] = a * a; v1[e] = b * b; }
                    u32x4 w; w.x = cvt_pk_bf16(v0[0], v0[1]); w.y = cvt_pk_bf16(v0[2], v0[3]); w.z = cvt_pk_bf16(v1[0], v1[1]); w.w = cvt_pk_bf16(v1[2], v1[3]);
                    *(u32x4*)(H + (size_t)row * 4096 + col0 + bj * 128) = w; } }
        return false;
    }
};

__device__ __forceinline__ void p0_transpose_item(const float* W, int K, int N, bf16_t* WT, int out_row0, int n0, int k0, const float* sc, float mul, LAS float* scr, int lane) {
    float tv[32];
#pragma unroll
    for (int i = 0; i < 32; ++i) { const int kk = 2 * i + (lane >> 5); tv[i] = W[(size_t)(k0 + kk) * N + n0 + (lane & 31)]; }
#pragma unroll
    for (int i = 0; i < 32; ++i) { const int kk = 2 * i + (lane >> 5); const float s = sc ? sc[k0 + kk] * mul : mul; scr[kk * 33 + (lane & 31)] = tv[i] * s; }
    asm volatile("s_waitcnt lgkmcnt(0)" ::: "memory");
    const int c = lane & 7;
#pragma unroll
    for (int j = 0; j < 4; ++j) { const int n = (lane >> 3) + 8 * j; const LAS float* s = scr + (8 * c) * 33 + n;
        u32x4 o; o.x = cvt_pk_bf16(s[0 * 33], s[1 * 33]); o.y = cvt_pk_bf16(s[2 * 33], s[3 * 33]); o.z = cvt_pk_bf16(s[4 * 33], s[5 * 33]); o.w = cvt_pk_bf16(s[6 * 33], s[7 * 33]);
        *(u32x4*)(WT + (size_t)(out_row0 + n) * K + k0 + 8 * c) = o; }
    asm volatile("s_waitcnt lgkmcnt(0)" ::: "memory");
}

template <int PART> __device__ __forceinline__ void p0_prologue(const Params& p, LAS unsigned char* lds, int bx, int G) {
    const int tid = threadIdx.x, lane = tid & 63, wid = tid >> 6;
    const int gw = bx * 8 + wid, NGW = G * 8, gt = bx * 512 + tid, NGT = G * 512;
    unsigned char* ws = p.ws;
    if (PART == 0) for (int i = gt; i < MT; i += NGT) { ((float*)(ws + SS1_OFF))[i] = 0.f; ((float*)(ws + SS2_OFF))[i] = 0.f; }
    for (int r0_ = 0; r0_ < (P0REP == 0 ? 2 : 1); ++r0_)
    if (PART == 0 && bx < 24) {
        LAS float* hm = (LAS float*)lds;
        LAS float* red = (LAS float*)(lds + 65536);
        for (int r = wid * 2; r < wid * 2 + 2; ++r) { float v[16]; float s = 0.f;
#pragma unroll
            for (int j = 0; j < 16; ++j) { v[j] = p.meta[r * 1024 + lane + 64 * j]; s += v[j] * v[j]; }
            const float rinv = rsqrtf(wave_sum(s) * (1.0f / 1024.0f) + RMS_EPS);
#pragma unroll
            for (int j = 0; j < 16; ++j) hm[r * 1024 + lane + 64 * j] = v[j] * rinv * p.g_mix[lane + 64 * j]; }
        __syncthreads();
        const int n = 512 + bx * 64 + lane; float a[16];
#pragma unroll
        for (int r = 0; r < 16; ++r) a[r] = 0.f;
        for (int k0 = wid * 128; k0 < wid * 128 + 128; k0 += 16) { float w[16];
#pragma unroll
            for (int q = 0; q < 16; ++q) w[q] = p.w_in[(size_t)(k0 + q) * 4096 + n];
#pragma unroll
            for (int q = 0; q < 16; ++q)
#pragma unroll
                for (int r = 0; r < 16; ++r) a[r] += hm[r * 1024 + k0 + q] * w[q]; }
#pragma unroll
        for (int r = 0; r < 16; ++r) red[(wid * 16 + r) * 64 + lane] = a[r];
        __syncthreads();
        for (int o = tid; o < 1024; o += 512) { const int r = o >> 6, l = o & 63; float s = 0.f;
#pragma unroll
            for (int w = 0; w < 8; ++w) s += red[(w * 16 + r) * 64 + l];
            const int nn = 512 + bx * 64 + l; const bf16_t hv = (bf16_t)(cvt_pk_bf16(s, 0.f) & 0xffffu);
            if (nn < 1024) ((bf16_t*)(ws + KMETA_OFF))[r * 512 + nn - 512] = hv;
            else if (nn < 1536) ((bf16_t*)(ws + VMETAT_OFF))[(nn - 1024) * 16 + r] = hv;
            else { const int ch = nn - 1536;
                for (int b = 0; b < 8; ++b) { bf16_t* ut = (bf16_t*)(ws + UT_OFF) + (b < 4 ? (size_t)b * 512 * NP + (size_t)ch * NP : (size_t)4 * 512 * NP + (size_t)(b - 4) * 512 * NS + (size_t)ch * NS); ut[r] = hv; } } }
        __syncthreads();
    }
    for (int r1_ = 0; r1_ < (P0REP == 1 ? 2 : 1); ++r1_)
    if (PART == 0 || PART == 2) {
        LAS float* scr = (LAS float*)(lds + wid * 8448);
        constexpr int I_IN = 16 * 128, I_UP = 16 * 128, I_DN = 64 * 32, I_OUT = 16 * 32, I_NA = 8 * 32, NIT = I_IN + I_UP + I_DN + I_OUT + I_NA;
        for (int it = (PART == 0 ? 0 : I_IN) + gw; it < (PART == 0 ? I_IN : NIT); it += NGW) {
            int r = it;
            if (r < I_IN) { const int kb = r / 128, nb = r % 128, n0 = nb * 32; bf16_t* dst; int orow; float mul = 1.f;
                if (n0 < 512) { dst = (bf16_t*)(ws + WINA_OFF); orow = n0; mul = 0.125f; } else if (n0 < 1024) { dst = (bf16_t*)(ws + WINA_OFF); orow = n0; }
                else if (n0 < 2048) { dst = (bf16_t*)(ws + WINB_OFF); orow = n0 - 1024; }
                else { const int isfn = n0 >= 3072, gc = n0 - (isfn ? 3072 : 2048); dst = (bf16_t*)(ws + WINA_OFF); orow = 1024 + 256 * (gc >> 7) + 128 * isfn + (gc & 127); }
                p0_transpose_item(p.w_in, 1024, 4096, dst, orow, n0, kb * 64, p.g_mix, mul, scr, lane); continue; } r -= I_IN;
            if (r < I_UP) { const int kb = r / 128, nb = r % 128; p0_transpose_item(p.w_up, 1024, 4096, (bf16_t*)(ws + WUP_OFF), nb * 32, nb * 32, kb * 64, p.g_mlp, 1.f, scr, lane); continue; } r -= I_UP;
            if (r < I_DN) { const int kb = r / 32, nb = r % 32; p0_transpose_item(p.w_down, 4096, 1024, (bf16_t*)(ws + WDN_OFF), nb * 32, nb * 32, kb * 64, nullptr, 1.f, scr, lane); continue; } r -= I_DN;
            if (r < I_OUT) { const int kb = r / 32, nb = r % 32; p0_transpose_item(p.w_out, 1024, 1024, (bf16_t*)(ws + WOUT_OFF), nb * 32, nb * 32, kb * 64, nullptr, 1.f, scr, lane); continue; } r -= I_OUT;
            { const int kb = r / 32, nb = r % 32; p0_transpose_item(p.w_na, 512, 1024, (bf16_t*)(ws + WNA_OFF), nb * 32, nb * 32, kb * 64, nullptr, 1.f, scr, lane); }
        }
    }
    for (int r2_ = 0; r2_ < (P0REP == 2 ? 2 : 1); ++r2_)
    if (PART == 2) for (int tw = gw; tw < 64 * 4 * 2; tw += NGW) {
        const int twu = __builtin_amdgcn_readfirstlane(tw); const int c = (twu & 1) * 64 + lane, g = (twu >> 1) & 3, d0 = (twu >> 3) * 16;
        float ac[16], as[16];
#pragma unroll
        for (int q = 0; q < 16; ++q) { ac[q] = 0.f; as[q] = 0.f; }
        const float* wf = p.w_fn + (size_t)g * 128 * 1024 + d0;
#pragma unroll 2
        for (int cp = 0; cp < 128; ++cp) { const float tr = (float)((c * cp) & 127) * (1.0f / 128.0f); const float co = __builtin_amdgcn_cosf(tr), si = __builtin_amdgcn_sinf(tr);
            f32x4 w[4];
#pragma unroll
            for (int q = 0; q < 4; ++q) w[q] = *(const __attribute__((address_space(4))) f32x4*)(unsigned long long)(wf + (size_t)cp * 1024 + 4 * q);
#pragma unroll
            for (int q = 0; q < 16; ++q) { ac[q] += co * w[q >> 2][q & 3]; as[q] -= si * w[q >> 2][q & 3]; } }
        bf16_t* o = (bf16_t*)(ws + WFN_OFF) + (size_t)d0 * 1024 + g * 128 + c;
#pragma unroll
        for (int q = 0; q < 16; ++q) { o[(size_t)q * 1024] = (bf16_t)(cvt_pk_bf16(ac[q], 0.f) & 0xffffu); o[(size_t)q * 1024 + 512] = (bf16_t)(cvt_pk_bf16(as[q], 0.f) & 0xffffu); } }
    for (int r3_ = 0; r3_ < (P0REP == 3 ? 2 : 1); ++r3_)
    if (PART == 1) {
        constexpr int IP = MRP * (KPP / 8), IS = MRS * (KPS / 8);
        for (int it = gt; it < IP + IS; it += NGT) {
            int i, j, N, KP; bf16_t* cm; bf16_t* sm;
            if (it < IP) { i = it / (KPP / 8); j = it % (KPP / 8); N = NP; KP = KPP; cm = (bf16_t*)(ws + CP_OFF); sm = (bf16_t*)(ws + SP_OFF); }
            else { const int q = it - IP; i = q / (KPS / 8); j = q % (KPS / 8); N = NS; KP = KPS; cm = (bf16_t*)(ws + CS_OFF); sm = (bf16_t*)(ws + SSM_OFF); }
            const int np = i + 1, HN = N / 2; const float norm = rsqrtf(128.0f * (float)N), invN = 1.0f / (float)N;
            float cv[8], sv[8]; int mm; { const unsigned prod = (unsigned)np * (unsigned)(8 * j); unsigned q = (unsigned)((float)prod * invN); if (q > 0) --q; mm = (int)(prod - q * (unsigned)N); while (mm >= N) mm -= N; }
#pragma unroll
            for (int e = 0; e < 8; ++e) { const int k = 8 * j + e; const bool ok = (np <= HN) && (k <= HN); const float tr = (float)mm * invN;
                cv[e] = ok ? __builtin_amdgcn_cosf(tr) * norm : 0.f; sv[e] = ok ? __builtin_amdgcn_sinf(tr) * norm : 0.f; mm += np; if (mm >= N) mm -= N; }
            u32x4 wc_, ws_; wc_.x = cvt_pk_bf16(cv[0], cv[1]); wc_.y = cvt_pk_bf16(cv[2], cv[3]); wc_.z = cvt_pk_bf16(cv[4], cv[5]); wc_.w = cvt_pk_bf16(cv[6], cv[7]);
            ws_.x = cvt_pk_bf16(sv[0], sv[1]); ws_.y = cvt_pk_bf16(sv[2], sv[3]); ws_.z = cvt_pk_bf16(sv[4], sv[5]); ws_.w = cvt_pk_bf16(sv[6], sv[7]);
            *(u32x4*)(cm + (size_t)i * KP + 8 * j) = wc_; *(u32x4*)(sm + (size_t)i * KP + 8 * j) = ws_;
        }
    }
    if (PART == 0) {
        constexpr int NCH = MT / 4;
        const bool uneven = (G == 256); const int nm = 24 * 8, nn = 256 * 8 - nm;
        for (int itx = 0; ; ++itx) {
            int chunk;
            if (!uneven) chunk = gw + itx * NGW;
            else if (bx >= 24) { const int wp = gw - nm; chunk = itx < 6 ? itx * nn + wp : (itx == 6 && wp < NCH - 6 * nn - 4 * nm ? 6 * nn + 4 * nm + wp : NCH); }
            else chunk = itx < 4 ? 6 * nn + gw * 4 + itx : NCH;
            if (chunk >= NCH) break;
            f32x4 v[4][4];
#pragma unroll
            for (int q = 0; q < 4; ++q) { const int g = chunk * 4 + q; const float* xr = g < 4 * TP ? p.xp + (size_t)g * 1024 : p.xs + (size_t)(g - 4 * TP) * 1024;
#pragma unroll
                for (int j = 0; j < 4; ++j) v[q][j] = ((const f32x4*)xr)[lane + 64 * j]; }
#pragma unroll
            for (int q = 0; q < 4; ++q) { const int g = chunk * 4 + q; float s = 0.f;
#pragma unroll
                for (int j = 0; j < 4; ++j) s += (v[q][j][0] * v[q][j][0] + v[q][j][1] * v[q][j][1]) + (v[q][j][2] * v[q][j][2] + v[q][j][3] * v[q][j][3]);
                const float rinv = rsqrtf(wave_sum(s) * (1.0f / 1024.0f) + RMS_EPS);
                u32x2* o = (u32x2*)((bf16_t*)(ws + XB_OFF) + (size_t)g * 1024);
#pragma unroll
                for (int j = 0; j < 4; ++j) { u32x2 w; w.x = cvt_pk_bf16(v[q][j][0] * rinv, v[q][j][1] * rinv); w.y = cvt_pk_bf16(v[q][j][2] * rinv, v[q][j][3] * rinv); o[lane + 64 * j] = w; } }
        }
    }
}

constexpr int A_KS = 0, A_VS = 73728, A_KM = 147456, A_VM = 149504, A_BS = 151552, A_MB = 155392;
__device__ __forceinline__ void attn_units(const Params& p, LAS unsigned char* lds, const int u_lo, const int u_hi) {
    const int tid = threadIdx.x, lane = tid & 63, wid = __builtin_amdgcn_readfirstlane(tid >> 6), G = gridDim.x, bx = blockIdx.x;
    const int li = lane & 15, g = lane >> 4;
    unsigned char* ws = p.ws;
    const bf16_t* Qb = (const bf16_t*)(ws + Q_OFF); const bf16_t* Kb = (const bf16_t*)(ws + K_OFF); const bf16_t* VT = (const bf16_t*)(ws + VT_OFF);
    bf16_t* att = (bf16_t*)(ws + ATT_OFF);
    int pb = -1, ph = -1, hiR = -1;
    const int sr = tid >> 3, sch = tid & 7;
    u32x4 pf[4]; int pfn = 0, pfR0 = 0;
    for (int un = u_lo; un < u_hi; ++un) {
        int b, h, rp, rows;
        if (un < 2048) { b = un >> 9; h = (un >> 6) & 7; rp = un & 63; rows = 128; } else { const int v = un - 2048; b = 4 + (v >> 8); h = (v >> 5) & 7; rp = v & 31; rows = 64; }
        const int gb = batch_base(b), T = rows * 64, r0 = 2 * rp;
        const int rsA = min(max(r0 - 4, 0), rows - 8), needHi = min(rsA + 8, rows - 1);
        if (b != pb || h != ph) {
            __syncthreads();
            { u32x4 kvv[9], vvv[9];
#pragma unroll
              for (int j = 0; j < 9; ++j) { const int R = min(rsA + j, needHi);
                kvv[j] = *(const u32x4*)(Kb + (size_t)(gb + R * 64 + sr) * 512 + h * 64 + sch * 8);
                vvv[j] = *(const u32x4*)(VT + (size_t)512 * gb + (size_t)(h * 64 + sr) * T + R * 64 + sch * 8); }
#pragma unroll
              for (int j = 0; j < 9; ++j) { const int sl = min(rsA + j, needHi) % 9;
                *(LAS u32x4*)(lds + A_KS + sl * 8192 + sr * 128 + ((sch ^ (sr & 7)) * 16)) = kvv[j];
                *(LAS u32x4*)(lds + A_VS + sl * 8192 + sr * 128 + ((sch ^ ((sr >> 1) & 7)) * 16)) = vvv[j]; } }
            if (tid < 128) { const int r = tid >> 3, ch = tid & 7; *(LAS u32x4*)(lds + A_KM + r * 128 + ((ch ^ (r & 7)) * 16)) = *(const u32x4*)((const bf16_t*)(ws + KMETA_OFF) + r * 512 + h * 64 + ch * 8); }
            else if (tid < 256) { const int q = tid - 128; *(LAS u32x4*)(lds + A_VM + q * 16) = *(const u32x4*)((const bf16_t*)(ws + VMETAT_OFF) + h * 64 * 16 + q * 8); }
            for (int i = tid; i < 15 * 64; i += 512) { const int ro = i >> 6, x = (i & 63) - 16; ((LAS float*)(lds + A_BS))[i] = (x >= 0 && x <= 30) ? p.rel_bias[(h * 15 + ro) * 31 + x] : 0.f; }
            if (tid < 16) ((LAS float*)(lds + A_MB))[tid] = p.meta_bias[h * 16 + tid];
            pb = b; ph = h; hiR = needHi;
        } else {
#pragma unroll
            for (int j = 0; j < 2; ++j) if (j < pfn) { const int sl = (pfR0 + j) % 9;
                *(LAS u32x4*)(lds + A_KS + sl * 8192 + sr * 128 + ((sch ^ (sr & 7)) * 16)) = pf[2 * j];
                *(LAS u32x4*)(lds + A_VS + sl * 8192 + sr * 128 + ((sch ^ ((sr >> 1) & 7)) * 16)) = pf[2 * j + 1]; }
            hiR = needHi;
        }
        __syncthreads();
        pfn = 0;
        if (un + 1 < u_hi) { const int un2 = un + 1; int b2, h2, rp2;
            if (un2 < 2048) { b2 = un2 >> 9; h2 = (un2 >> 6) & 7; rp2 = un2 & 63; } else { const int v = un2 - 2048; b2 = 4 + (v >> 8); h2 = (v >> 5) & 7; rp2 = v & 31; }
            if (b2 == b && h2 == h) { const int rsA2 = min(max(2 * rp2 - 4, 0), rows - 8), nh2 = min(rsA2 + 8, rows - 1); pfR0 = hiR + 1; pfn = nh2 - hiR;
#pragma unroll
                for (int j = 0; j < 2; ++j) if (j < pfn) { const int R = pfR0 + j;
                    pf[2 * j] = *(const u32x4*)(Kb + (size_t)(gb + R * 64 + sr) * 512 + h * 64 + sch * 8);
                    pf[2 * j + 1] = *(const u32x4*)(VT + (size_t)512 * gb + (size_t)(h * 64 + sr) * T + R * 64 + sch * 8); } } }
        const int r = r0 + (wid >> 2), c0 = 16 * (wid & 3), kc0 = min(max(c0 - 8, 0), 32);
        const int rs = min(max(r - 4, 0), rows - 8);
        int slot[8];
        { const int s0 = rs % 9;
#pragma unroll
          for (int w = 0; w < 8; ++w) slot[w] = (s0 + w >= 9) ? s0 + w - 9 : s0 + w; }
        const int c = c0 + li, cs = min(max(c - 8, 0), 48);
        const size_t qrow = (size_t)(gb + r * 64 + c);
        bf16x8 qf[2];
        qf[0] = *(const bf16x8*)(Qb + qrow * 512 + h * 64 + 8 * g); qf[1] = *(const bf16x8*)(Qb + qrow * 512 + h * 64 + 32 + 8 * g);
        f32x4 sa[8][2]; f32x4 sm_;
        {
            const int kr0 = kc0 + li;
#pragma unroll
            for (int w = 0; w < 8; ++w)
#pragma unroll
                for (int j = 0; j < 2; ++j) { const int kr = kr0 + 16 * j; const LAS unsigned char* rowp = lds + A_KS + slot[w] * 8192 + kr * 128;
                    const bf16x8 a0 = *(const LAS bf16x8*)(rowp + ((g ^ (kr & 7)) * 16)), a1 = *(const LAS bf16x8*)(rowp + (((g + 4) ^ (kr & 7)) * 16));
                    f32x4 z = (f32x4){0.f, 0.f, 0.f, 0.f};
                    z = __builtin_amdgcn_mfma_f32_16x16x32_bf16(a0, qf[0], z, 0, 0, 0); sa[w][j] = __builtin_amdgcn_mfma_f32_16x16x32_bf16(a1, qf[1], z, 0, 0, 0); }
            const LAS unsigned char* rowp = lds + A_KM + li * 128;
            const bf16x8 a0 = *(const LAS bf16x8*)(rowp + ((g ^ (li & 7)) * 16)), a1 = *(const LAS bf16x8*)(rowp + (((g + 4) ^ (li & 7)) * 16));
            f32x4 z = (f32x4){0.f, 0.f, 0.f, 0.f};
            z = __builtin_amdgcn_mfma_f32_16x16x32_bf16(a0, qf[0], z, 0, 0, 0); sm_ = __builtin_amdgcn_mfma_f32_16x16x32_bf16(a1, qf[1], z, 0, 0, 0);
        }
        const int dl = kc0 + 4 * g - cs;
        const LAS float* bsp = (const LAS float*)(lds + A_BS) + (rs - r + 7) * 64 + (kc0 + 4 * g - c + 31);
        float mx = -1e30f;
#pragma unroll
        for (int w = 0; w < 8; ++w)
#pragma unroll
            for (int j = 0; j < 2; ++j)
#pragma unroll
                for (int e = 0; e < 4; ++e) { const bool ok = (unsigned)(dl + 16 * j + e) < 16u; const float bv = bsp[w * 64 + 16 * j + e];
                    float sv = sa[w][j][e] + bv; sv = ok ? sv : -1e30f; sa[w][j][e] = sv; mx = fmaxf(mx, sv); }
#pragma unroll
        for (int e = 0; e < 4; ++e) { sm_[e] += ((const LAS float*)(lds + A_MB))[4 * g + e]; mx = fmaxf(mx, sm_[e]); }
        mx = fmaxf(mx, __shfl_xor(mx, 16)); mx = fmaxf(mx, __shfl_xor(mx, 32));
        const float mxl = mx * 1.44269504f; float sum = 0.f;
#pragma unroll
        for (int w = 0; w < 8; ++w)
#pragma unroll
            for (int j = 0; j < 2; ++j)
#pragma unroll
                for (int e = 0; e < 4; ++e) { const float pe = __builtin_amdgcn_exp2f(sa[w][j][e] * 1.44269504f - mxl); sa[w][j][e] = pe; sum += pe; }
#pragma unroll
        for (int e = 0; e < 4; ++e) { const float pe = __builtin_amdgcn_exp2f(sm_[e] * 1.44269504f - mxl); sm_[e] = pe; sum += pe; }
        sum += __shfl_xor(sum, 16); sum += __shfl_xor(sum, 32);
        const float rsum = 1.0f / sum;
        f32x4 o[4];
#pragma unroll
        for (int dt = 0; dt < 4; ++dt) o[dt] = (f32x4){0.f, 0.f, 0.f, 0.f};
        const int c8 = (kc0 >> 2) + g;
#pragma unroll
        for (int w = 0; w < 8; ++w) { u32x4 pw; pw.x = cvt_pk_bf16(sa[w][0][0], sa[w][0][1]); pw.y = cvt_pk_bf16(sa[w][0][2], sa[w][0][3]); pw.z = cvt_pk_bf16(sa[w][1][0], sa[w][1][1]); pw.w = cvt_pk_bf16(sa[w][1][2], sa[w][1][3]);
            const bf16x8 pbv = __builtin_bit_cast(bf16x8, pw);
#pragma unroll
            for (int dt = 0; dt < 4; ++dt) { const int d = 16 * dt + li, sw = 2 * ((d >> 1) & 7); const LAS unsigned char* rowp = lds + A_VS + slot[w] * 8192 + d * 128;
                const u32x2 lo = *(const LAS u32x2*)(rowp + ((c8 ^ sw) * 8)), hi = *(const LAS u32x2*)(rowp + (((c8 + 4) ^ sw) * 8));
                u32x4 av; av.x = lo.x; av.y = lo.y; av.z = hi.x; av.w = hi.y;
                o[dt] = __builtin_amdgcn_mfma_f32_16x16x32_bf16(__builtin_bit_cast(bf16x8, av), pbv, o[dt], 0, 0, 0); } }
        { u32x4 pw; pw.x = cvt_pk_bf16(sm_[0], sm_[1]); pw.y = cvt_pk_bf16(sm_[2], sm_[3]); pw.z = 0u; pw.w = 0u; const bf16x8 pbv = __builtin_bit_cast(bf16x8, pw);
#pragma unroll
            for (int dt = 0; dt < 4; ++dt) { const int d = 16 * dt + li; const u32x2 lo = *(const LAS u32x2*)(lds + A_VM + d * 32 + g * 8);
                u32x4 av; av.x = lo.x; av.y = lo.y; av.z = 0u; av.w = 0u;
                o[dt] = __builtin_amdgcn_mfma_f32_16x16x32_bf16(__builtin_bit_cast(bf16x8, av), pbv, o[dt], 0, 0, 0); } }
#pragma unroll
        for (int dt = 0; dt < 4; ++dt) { u32x2 w; w.x = cvt_pk_bf16(o[dt][0] * rsum, o[dt][1] * rsum); w.y = cvt_pk_bf16(o[dt][2] * rsum, o[dt][3] * rsum);
            *(u32x2*)(att + qrow * 512 + h * 64 + 16 * dt + 4 * g) = w; }
        __syncthreads();
    }
}
__device__ __forceinline__ void dft_prep(const Params& p) {
    const int tid = threadIdx.x, G = gridDim.x, bx = blockIdx.x; unsigned char* ws = p.ws;
    {
        const int gt = bx * 512 + tid, NGT = G * 512;
        constexpr int IPP = 4 * 512 * (KPP / 8), IPS = 4 * 512 * (KPS / 8);
        for (int it = gt; it < IPP + IPS; it += NGT) {
            int b, ch, j, N, KP; size_t ub, eb;
            if (it < IPP) { b = it / (512 * (KPP / 8)); const int q = it % (512 * (KPP / 8)); ch = q / (KPP / 8); j = q % (KPP / 8); N = NP; KP = KPP; ub = ((size_t)b * 512 + ch) * NP; eb = ((size_t)b * 512 + ch) * KPP; }
            else { const int v = it - IPP; b = v / (512 * (KPS / 8)); const int q = v % (512 * (KPS / 8)); ch = q / (KPS / 8); j = q % (KPS / 8); N = NS; KP = KPS;
                ub = (size_t)4 * 512 * NP + ((size_t)b * 512 + ch) * NS; eb = (size_t)4 * 512 * KPP + ((size_t)b * 512 + ch) * KPS; }
            (void)KP;
            const bf16_t* ut = (const bf16_t*)(ws + UT_OFF) + ub; const int HN = N / 2, k0 = 8 * j;
            float ev[8], ov[8];
            if (k0 < HN) { const u32x4 f = *(const u32x4*)(ut + k0); const u32x4 rv = *(const u32x4*)(ut + N - k0 - 8);
                const float fw[8] = {bf_lo(f.x), bf_hi(f.x), bf_lo(f.y), bf_hi(f.y), bf_lo(f.z), bf_hi(f.z), bf_lo(f.w), bf_hi(f.w)};
                const float rr[8] = {bf_lo(rv.x), bf_hi(rv.x), bf_lo(rv.y), bf_hi(rv.y), bf_lo(rv.z), bf_hi(rv.z), bf_lo(rv.w), bf_hi(rv.w)};
                const float r0v = (k0 > 0) ? __uint_as_float((unsigned)ut[N - k0] << 16) : 0.f;
#pragma unroll
                for (int e = 0; e < 8; ++e) { const float rvv = (e == 0) ? r0v : rr[8 - e]; ev[e] = fw[e] + rvv; ov[e] = fw[e] - rvv; }
                if (k0 == 0) { ev[0] = fw[0]; ov[0] = 0.f; } }
            else {
#pragma unroll
                for (int e = 0; e < 8; ++e) { ev[e] = 0.f; ov[e] = 0.f; }
                if (k0 == HN) ev[0] = __uint_as_float((unsigned)ut[HN] << 16); }
            u32x4 we, wo; we.x = cvt_pk_bf16(ev[0], ev[1]); we.y = cvt_pk_bf16(ev[2], ev[3]); we.z = cvt_pk_bf16(ev[4], ev[5]); we.w = cvt_pk_bf16(ev[6], ev[7]);
            wo.x = cvt_pk_bf16(ov[0], ov[1]); wo.y = cvt_pk_bf16(ov[2], ov[3]); wo.z = cvt_pk_bf16(ov[4], ov[5]); wo.w = cvt_pk_bf16(ov[6], ov[7]);
            *(u32x4*)((bf16_t*)(ws + UE_OFF) + eb + k0) = we; *(u32x4*)((bf16_t*)(ws + UO_OFF) + eb + k0) = wo;
        }
    }
}

#define XB_TMO      128
#define XB_XCNT(j)  (256  + 64 * (j))
#define XB_XSUB(j)  (1280 + 64 * (j))
#define XB_XGEN(j)  (2304 + 64 * (j))
#define XB_TOP      3328
#define XB_TOPGEN   3392
#define XCD_BAR_WORDS 3456
#define XB_SPIN_CAP (1u << 18)

__device__ __forceinline__ unsigned xb_ld(unsigned* p)              { return __hip_atomic_load(p, __ATOMIC_RELAXED, __HIP_MEMORY_SCOPE_AGENT); }
__device__ __forceinline__ unsigned xb_add(unsigned* p, unsigned v) { return __hip_atomic_fetch_add(p, v, __ATOMIC_RELAXED, __HIP_MEMORY_SCOPE_AGENT); }
__device__ __forceinline__ unsigned xb_xcc_id() { return (unsigned)__builtin_amdgcn_s_getreg((3 << 11) | 20) & 0xFu; }
#define XB_SPIN(cond, bar) do { unsigned _sp = 0; while (cond) { __builtin_amdgcn_s_sleep(1); \
    if ((++_sp & 255u) == 0u) { if (xb_ld(&(bar)[XB_TMO])) break; if (_sp > XB_SPIN_CAP) { atomicAdd(&(bar)[XB_TMO], 1u); break; } } } } while (0)

struct XcdBarrier {
    unsigned* bar; unsigned x;
    volatile LAS unsigned* st;
};

__device__ __forceinline__ XcdBarrier xcd_barrier_post(unsigned* bar, volatile LAS unsigned* st) {
    XcdBarrier b; b.bar = bar; b.x = xb_xcc_id(); b.st = st;
    if (threadIdx.x == 0) (void)xb_add(&bar[XB_XCNT(b.x)], 1u);
    return b;
}
__device__ __forceinline__ void xcd_barrier_complete(unsigned* bar, unsigned x, unsigned& nloc, unsigned& nx) {
    const unsigned G = gridDim.x * gridDim.y * gridDim.z;
    unsigned sum, cnt, mine, sp = 0u;
    for (;;) {
        sum = 0u; cnt = 0u; mine = 0u;
#pragma unroll
        for (unsigned j = 0; j < 16; ++j) { const unsigned c = xb_ld(&bar[XB_XCNT(j)]); sum += c; cnt += (c > 0u) ? 1u : 0u; mine = (j == x) ? c : mine; }
        if (sum == G) break;
        __builtin_amdgcn_s_sleep(1);
        if ((++sp & 255u) == 0u) { if (xb_ld(&bar[XB_TMO])) break; if (sp > XB_SPIN_CAP) { atomicAdd(&bar[XB_TMO], 1u); break; } }
    }
    nloc = mine > 0u ? mine : 1u; nx = cnt > 0u ? cnt : 1u;
}

__device__ __forceinline__ void xcd_barrier(const XcdBarrier& b) {
    asm volatile("s_waitcnt vmcnt(0)" ::: "memory");
    __syncthreads();
    if (threadIdx.x == 0) {
        unsigned* bar = b.bar;
        __builtin_amdgcn_s_waitcnt(0);
        unsigned nloc = b.st[0], nx = b.st[1];
        if (nloc == 0u) { xcd_barrier_complete(bar, b.x, nloc, nx); b.st[0] = nloc; b.st[1] = nx; }
        const unsigned old = xb_add(&bar[XB_XSUB(b.x)], 1u);
        const unsigned gen = old / nloc;
        if (old + 1u == (gen + 1u) * nloc) {
            __builtin_amdgcn_fence(__ATOMIC_RELEASE, "agent");
            asm volatile("s_waitcnt vmcnt(0)" ::: "memory");
            const unsigned og = xb_add(&bar[XB_TOP], 1u);
            const unsigned tg = og / nx;
            if (og + 1u == (tg + 1u) * nx) xb_add(&bar[XB_TOPGEN], 1u);
            else XB_SPIN(xb_ld(&bar[XB_TOPGEN]) == tg, bar);
            __builtin_amdgcn_fence(__ATOMIC_ACQUIRE, "agent");
            xb_add(&bar[XB_XGEN(b.x)], 1u);
            asm volatile("s_waitcnt vmcnt(0)" ::: "memory");
        } else {
            XB_SPIN(xb_ld(&bar[XB_XGEN(b.x)]) == gen, bar);
            __builtin_amdgcn_fence(__ATOMIC_ACQUIRE, "agent");
            asm volatile("s_waitcnt vmcnt(0)" ::: "memory");
        }
    }
    __syncthreads();
}


#ifndef STG_W6
#define STG_W6 0
#endif
__device__ __forceinline__ void phase_stagger(int w_ticks) {
    if (w_ticks > 0) { const int bx = blockIdx.x, rank = (bx & 7) * (gridDim.x >> 3) + (bx >> 3);
        const unsigned long long t1 = __builtin_amdgcn_s_memrealtime() + (unsigned long long)((long)w_ticks * rank / gridDim.x);
        while (__builtin_amdgcn_s_memrealtime() < t1) __builtin_amdgcn_s_sleep(8); }
}
__global__ void __launch_bounds__(512, 2) mega_fwd(Params p) {
    extern __shared__ __attribute__((aligned(16))) unsigned char lds_raw[];
    LAS unsigned char* lds = (LAS unsigned char*)lds_raw;
    const int lo = p.ph_lo, hi = p.ph_hi, G = gridDim.x, bx = blockIdx.x;
    unsigned char* ws = p.ws;
    unsigned long long tsa_ = 0, tsb_ = 0;
#define TSA(k) do { if (TS_PHASE == (k)) tsa_ = __builtin_amdgcn_s_memrealtime(); } while (0)
#define TSB(k) do { if (TS_PHASE == (k)) tsb_ = __builtin_amdgcn_s_memrealtime(); } while (0)
#define IN(k) (lo <= (k) && (k) < hi)
    volatile LAS unsigned* bst = (volatile LAS unsigned*)(lds + LDS_BYTES - 64);
    if (threadIdx.x < 2) bst[threadIdx.x] = 0u;
    __syncthreads();
    if (bx == 0) { for (int i = threadIdx.x; i < 4096; i += 512) __hip_atomic_store((unsigned*)ws + i, 0u, __ATOMIC_RELAXED, __HIP_MEMORY_SCOPE_AGENT); }
    if (hi - lo > 1) cg::this_grid().sync();
    XcdBarrier xbar = xcd_barrier_post((unsigned*)ws, bst);
#define SEAM(k) do { if (IN(k) && IN((k) + 1)) { xcd_barrier(xbar); } } while (0)
#define REPS(k) for (int rep_ = 0; rep_ < ((REP_PHASE == (k)) ? 2 : 1); ++rep_)
#define REPSYNC(k) do { if (REP_PHASE == (k) && rep_ == 0) cg::this_grid().sync(); } while (0)
    TSA(0);
    if (IN(0)) REPS(0) { p0_prologue<0>(p, lds, bx, G); __syncthreads(); REPSYNC(0); }
    SEAM(0); TSB(0);
    TSA(1);
    if (IN(1)) REPS(1) {
        { SchedRect<1> S{}; S.A0 = (const char*)(ws + XB_OFF); S.B0 = (const char*)(ws + WINA_OFF); S.pa0 = 2048; S.nt0 = 16; S.nM = MT / 256; S.nN = 12; S.G = G; S.c = bx;
          EpiP1a E{ws, p.out}; pg8::gemm_phase<false>(lds, S, E); }
        { SchedRect<1> S{}; S.A0 = (const char*)(ws + XB_OFF); S.B0 = (const char*)(ws + WINB_OFF); S.pa0 = 2048; S.nt0 = 16; S.nM = MT / 256; S.nN = 4; S.G = G; S.c = bx;
          EpiP1b E{ws}; pg8::gemm_phase<true>(lds, S, E); }
        REPSYNC(1);
    }
    SEAM(1); TSB(1);
    TSA(2);
    if (IN(2)) REPS(2) { p0_prologue<1>(p, lds, bx, G); dft_prep(p); __syncthreads(); REPSYNC(2); }
    SEAM(2); TSB(2);
    TSA(3);
    if (IN(3)) REPS(3) { SchedDft S{(const char*)ws, G, bx}; EpiDft E{ws}; pg8::gemm_phase<false>(lds, S, E);
        int a_lo, a_hi;
        if (G == 256) {
            if (bx < 16) { a_lo = bx * 6; a_hi = a_lo + 6; } else if (bx < 80) { a_lo = 96 + (bx - 16) * 13; a_hi = a_lo + 13; } else if (bx < 160) { a_lo = 928 + (bx - 80) * 12; a_hi = a_lo + 12; }
            else { p0_prologue<2>(p, lds, bx - 160, 96); if (bx < 224) { a_lo = 1888 + (bx - 160) * 10; a_hi = a_lo + 10; } else { a_lo = 2528 + (bx - 224) * 17; a_hi = a_lo + 17; } }
        } else { p0_prologue<2>(p, lds, bx, G); const int per = (3072 + G - 1) / G; a_lo = bx * per; a_hi = min(a_lo + per, 3072); }
        __syncthreads();
        attn_units(p, lds, a_lo, a_hi);
        __syncthreads();
        REPSYNC(3); }
    SEAM(3); TSB(3);
    TSA(4);
    if (IN(4)) REPS(4) {
        SchedMerge S{(const char*)ws, G, bx};
        EpiMerge E{ws, p.out}; pg8::gemm_phase<false>(lds, S, E); REPSYNC(4);
    }
    SEAM(4); TSB(4);
    TSA(5);
    if (IN(5)) {
        SchedRect<1> S{}; S.A0 = (const char*)(ws + MIX_OFF); S.B0 = (const char*)(ws + WOUT_OFF); S.pa0 = 2048; S.nt0 = 16; S.nM = MT / 256; S.nN = 4; S.G = G; S.c = bx;
        EpiRes5 E{p.xp, p.xs, (bf16_t*)(ws + X1B_OFF), (float*)(ws + SS1_OFF)}; pg8::gemm_phase<false>(lds, S, E);
    }
    SEAM(5); TSB(5);
    TSA(6);
    if (IN(6)) REPS(6) {
        phase_stagger(STG_W6);
        SchedRect<1> S{}; S.A0 = (const char*)(ws + X1B_OFF); S.B0 = (const char*)(ws + WUP_OFF); S.pa0 = 2048; S.nt0 = 16; S.nM = MT / 256; S.nN = 16; S.G = G; S.c = bx;
        EpiUp E{(bf16_t*)(ws + H_OFF), (const float*)(ws + SS1_OFF)}; pg8::gemm_phase<false>(lds, S, E); REPSYNC(6);
    }
    SEAM(6); TSB(6);
    TSA(7);
    if (IN(7)) {
        SchedRect<1> S{}; S.A0 = (const char*)(ws + H_OFF); S.B0 = (const char*)(ws + WDN_OFF); S.pa0 = 8192; S.nt0 = 64; S.nM = MT / 256; S.nN = 4; S.G = G; S.c = bx;
        if (G == 256) { EpiRes7F E{(const bf16_t*)(ws + X1B_OFF), (float*)(ws + SS2_OFF), (unsigned*)ws + 3584, p.g_final, p.out}; pg8::gemm_phase<false>(lds, S, E); }
        else { EpiRes7 E{(bf16_t*)(ws + X1B_OFF), (float*)(ws + SS2_OFF)}; pg8::gemm_phase<false>(lds, S, E); }
    }
    if (G != 256) SEAM(7);
    TSB(7);
    TSA(8);
    if (IN(8) && G != 256) {
        const int tid = threadIdx.x, lane = tid & 63, wid = tid >> 6; const float* ss2 = (const float*)(ws + SS2_OFF);
        f32x4 gf[2][2];
#pragma unroll
        for (int j = 0; j < 2; ++j) { gf[j][0] = *(const f32x4*)(p.g_final + 512 * j + lane * 8); gf[j][1] = *(const f32x4*)(p.g_final + 512 * j + lane * 8 + 4); }
        for (int g0 = bx * 8 + wid; g0 < MT; g0 += 2 * G * 8) {
            u32x4 v[2][2]; float rinv[2];
#pragma unroll
            for (int q = 0; q < 2; ++q) { const int g = g0 + q * G * 8; if (g < MT) { const bf16_t* xr = (const bf16_t*)(ws + X1B_OFF) + (size_t)g * 1024;
                    v[q][0] = *(const u32x4*)(xr + lane * 8); v[q][1] = *(const u32x4*)(xr + 512 + lane * 8); rinv[q] = rsqrtf(ss2[g] * (1.0f / 1024.0f) + RMS_EPS); } }
#pragma unroll
            for (int q = 0; q < 2; ++q) { const int g = g0 + q * G * 8; if (g < MT) { float* o = p.out + (size_t)g * 1024;
#pragma unroll
                    for (int j = 0; j < 2; ++j) { const u32x4 b = v[q][j]; f32x4 o0, o1;
                        o0[0] = bf_lo(b.x); o0[1] = bf_hi(b.x); o0[2] = bf_lo(b.y); o0[3] = bf_hi(b.y); o1[0] = bf_lo(b.z); o1[1] = bf_hi(b.z); o1[2] = bf_lo(b.w); o1[3] = bf_hi(b.w);
                        *(f32x4*)(o + 512 * j + lane * 8) = o0 * rinv[q] * gf[j][0]; *(f32x4*)(o + 512 * j + lane * 8 + 4) = o1 * rinv[q] * gf[j][1]; } } }
        }
    }
    TSB(8);
    if (TS_PHASE >= 0 && bx == 0) { const unsigned long long t1 = __builtin_amdgcn_s_memrealtime() + (tsb_ - tsa_); while (__builtin_amdgcn_s_memrealtime() < t1) __builtin_amdgcn_s_sleep(8); }
#undef IN
#undef SEAM
}

extern "C" void kernel_launch(void* const* d_in, const int* in_sizes, int n_in, void* d_out, int out_size, void* d_ws, size_t ws_size, hipStream_t stream) {
    static int grid = 0;
    if (grid == 0) {
        if (n_in != 14 || out_size != MT * D || ws_size < WS_NEED) { fprintf(stderr, "kernel_launch: unexpected shapes (n_in %d, out %d, ws %zu)\n", n_in, out_size, ws_size); grid = -1; return; }
        int dev = 0, cus = 0, per_cu = 0;
        hipGetDevice(&dev); hipDeviceGetAttribute(&cus, hipDeviceAttributeMultiprocessorCount, dev);
        if (hipFuncSetAttribute((const void*)mega_fwd, hipFuncAttributeMaxDynamicSharedMemorySize, LDS_BYTES) != hipSuccess) { fprintf(stderr, "kernel_launch: hipFuncSetAttribute failed\n"); grid = -1; return; }
        if (hipOccupancyMaxActiveBlocksPerMultiprocessor(&per_cu, (const void*)mega_fwd, 512, LDS_BYTES) != hipSuccess || per_cu < 1) per_cu = 1;
        (void)hipGetLastError();
        grid = cus * per_cu;
    }
    if (grid < 0) return;
    Params p{};
    p.xp = (const float*)d_in[0]; p.xs = (const float*)d_in[1]; p.meta = (const float*)d_in[2]; p.w_in = (const float*)d_in[3]; p.rel_bias = (const float*)d_in[4]; p.meta_bias = (const float*)d_in[5];
    p.w_na = (const float*)d_in[6]; p.w_fn = (const float*)d_in[7]; p.w_out = (const float*)d_in[8]; p.g_mix = (const float*)d_in[9]; p.g_mlp = (const float*)d_in[10]; p.w_up = (const float*)d_in[11];
    p.w_down = (const float*)d_in[12]; p.g_final = (const float*)d_in[13]; p.out = (float*)d_out; p.ws = (unsigned char*)d_ws;
#if MK_PER_PHASE
    for (int ph = 0; ph < 9; ++ph) { p.ph_lo = ph; p.ph_hi = ph + 1; hipLaunchKernelGGL(mega_fwd, dim3(grid), dim3(512), LDS_BYTES, stream, p); }
#else
    p.ph_lo = 0; p.ph_hi = 9;
    void* args[] = {&p};
    hipError_t e = hipLaunchCooperativeKernel((const void*)mega_fwd, dim3(grid), dim3(512), args, LDS_BYTES, stream);
    if (e != hipSuccess) fprintf(stderr, "cooperative launch failed: %s (grid %d)\n", hipGetErrorString(e), grid);
#endif
}
```

```cpp
#include <hip/hip_runtime.h>
#include <hip/hip_cooperative_groups.h>
#include <cstdio>
#include <cstdint>
namespace cg = cooperative_groups;

#ifndef MK_PER_PHASE
#define MK_PER_PHASE 0
#endif

#ifndef TS_PHASE
#define TS_PHASE -1
#endif
#ifndef P0REP
#define P0REP -1
#endif
#ifndef EPI2
#define EPI2 -1
#endif
#ifndef REP_PHASE
#define REP_PHASE -1
#endif
#define LAS __attribute__((address_space(3)))
typedef unsigned short bf16_t;
typedef short bf16x8 __attribute__((ext_vector_type(8)));
typedef float f32x4 __attribute__((ext_vector_type(4)));
typedef float f32x2 __attribute__((ext_vector_type(2)));
typedef unsigned u32x4 __attribute__((ext_vector_type(4)));
typedef unsigned u32x2 __attribute__((ext_vector_type(2)));

constexpr int D = 1024, TP = 8192, TS = 4096, MT = 4 * TP + 4 * TS;
constexpr int NP = TP + 16, NS = TS + 16;
constexpr int KPP = 4224, KPS = 2176;
constexpr int MRP = 4352, MRS = 2304;
constexpr float RMS_EPS = 1e-6f;
constexpr size_t MiB = 1u << 20;
constexpr size_t SS1_OFF = 64 * 1024, SS2_OFF = 256 * 1024, KMETA_OFF = 512 * 1024, VMETAT_OFF = 528 * 1024;
constexpr size_t WINA_OFF = 1 * MiB, WINB_OFF = 7 * MiB, WUP_OFF = 9 * MiB, WDN_OFF = 17 * MiB, WOUT_OFF = 25 * MiB, WNA_OFF = 27 * MiB, WFN_OFF = 28 * MiB;
constexpr size_t XB_OFF = 30 * MiB;
constexpr size_t CP_OFF = 126 * MiB, SP_OFF = CP_OFF + (size_t)MRP * KPP * 2, CS_OFF = SP_OFF + (size_t)MRP * KPP * 2, SSM_OFF = CS_OFF + (size_t)MRS * KPS * 2;
constexpr size_t Q_OFF = 234 * MiB, K_OFF = 282 * MiB, VT_OFF = 330 * MiB, UT_OFF = 378 * MiB;
constexpr size_t ATT_OFF = 30 * MiB, UE_OFF = 427 * MiB, UO_OFF = 452 * MiB;
constexpr size_t PB_OFF = 78 * MiB, QB_OFF = 378 * MiB, MIX_OFF = 126 * MiB, X1B_OFF = 414 * MiB, H_OFF = 30 * MiB;
constexpr size_t WS_NEED = 510 * MiB;
static_assert(SSM_OFF + (size_t)MRS * KPS * 2 <= 234 * MiB, "dft matrices");
static_assert(UT_OFF + (size_t)512 * 2 * (4 * NP + 4 * NS) <= UE_OFF, "ut");
constexpr int LDS_BYTES = 160 * 1024;

__device__ __forceinline__ unsigned cvt_pk_bf16(float lo, float hi) { unsigned r; asm volatile("v_cvt_pk_bf16_f32 %0, %1, %2" : "=v"(r) : "v"(lo), "v"(hi)); return r; }
__device__ __forceinline__ float bf_lo(unsigned w) { return __uint_as_float(w << 16); }
__device__ __forceinline__ float bf_hi(unsigned w) { return __uint_as_float(w & 0xffff0000u); }
__device__ __forceinline__ float wave_sum(float v) {
#pragma unroll
    for (int o = 1; o < 64; o <<= 1) v += __shfl_xor(v, o);
    return v;
}
__device__ __forceinline__ int batch_base(int b) { return b < 4 ? b * TP : 4 * TP + (b - 4) * TS; }

struct Params {
    const float* xp; const float* xs; const float* meta; const float* w_in; const float* rel_bias; const float* meta_bias;
    const float* w_na; const float* w_fn; const float* w_out; const float* g_mix; const float* g_mlp; const float* w_up; const float* w_down; const float* g_final;
    float* out; unsigned char* ws; int ph_lo, ph_hi;
};

namespace pg8 {
constexpr int BM = 256, BK = 64, HALF = 128, HTB = HALF * BK * 2, STAGE_BYTES = 8 * HTB;
__device__ __forceinline__ int lds_byte(int r, int c) { const int st = (r >> 4) * 2 + (c >> 5), rr = r & 15, cc = c & 31, ob = rr * 64 + cc * 2; return st * 1024 + (ob ^ (((ob >> 9) & 1) << 5)); }
__device__ __forceinline__ void stage_rc(int b, int& R, int& C) { const int st = b / 1024, sb = b % 1024, swz = sb ^ (((sb >> 9) & 1) << 5); R = (st >> 1) * 16 + swz / 64; C = (st & 1) * 32 + (swz % 64) / 2; }
__device__ __forceinline__ int perm32(int rho) { const int n = rho >> 4, i = rho & 15; return 8 * (i >> 2) + 4 * n + (i & 3); }

struct Unit { const char* A; const char* B; int pa, pb, nt, pm, pn, aux; };

__device__ __forceinline__ bool rect_tile(long L, int nM, int nN, int& pm, int& pn) {
    const int nwg = nM * nN; if (L >= nwg) return false;
    int wgid = (int)L; { const int q = nwg / 8, r = nwg % 8, xcd = wgid % 8, off = wgid / 8; wgid = (xcd < r ? xcd * (q + 1) : r * (q + 1) + (xcd - r) * q) + off; }
    const int nig = 8 * nN, gid = wgid / nig, fm = gid * 8, gsz = (nM - fm) < 8 ? (nM - fm) : 8;
    pm = fm + ((wgid % nig) % gsz); pn = (wgid % nig) / gsz; return true;
}

template <bool TRANS, class Epi, class Sched>
__device__ __forceinline__ void gemm_phase(LAS unsigned char* lds, const Sched& S, const Epi& E) {
    const int tid = threadIdx.x, wid = __builtin_amdgcn_readfirstlane(tid >> 6), lane = tid & 63, wr = wid >> 2, wc = wid & 3, fr = lane & 15, fq = lane >> 4;
    int RA[2], RB[2], CB[2];
#pragma unroll
    for (int i = 0; i < 2; ++i) { int R, C; stage_rc(tid * 16 + i * 8192, R, C); RA[i] = R; RB[i] = Epi::PERM ? ((R & ~31) + perm32(R & 31)) : R; CB[i] = C * 2; }
    const unsigned ldsw = (unsigned)wid * 1024u;
    const int aoff = lds_byte(wr * 64 + fr, fq * 8), boff = lds_byte(wc * 32 + fr, fq * 8);
#define PG8_SA(b, h) (((b) * 2 + (h)) * HTB)
#define PG8_SB(b, h) ((4 + (b) * 2 + (h)) * HTB)
#define PG8_STAGE(bufoff, gbase, pitch, RR) do { _Pragma("unroll") for (int _i = 0; _i < 2; ++_i) \
        __builtin_amdgcn_global_load_lds((const unsigned*)((const char*)(gbase) + (unsigned)((RR)[_i] * (pitch) + CB[_i])), (LAS unsigned*)(lds + (bufoff) + ldsw + _i * 8192), 16, 0, 0); } while (0)
#define PG8_LDA(dst, b, h) do { _Pragma("unroll") for (int m = 0; m < 4; ++m) _Pragma("unroll") for (int k = 0; k < 2; ++k) dst[m][k] = *(const LAS bf16x8*)(lds + PG8_SA(b, h) + aoff + m * 2048 + k * 1024); } while (0)
#define PG8_LDB(dst, b, h) do { _Pragma("unroll") for (int n = 0; n < 2; ++n) _Pragma("unroll") for (int k = 0; k < 2; ++k) dst[n][k] = *(const LAS bf16x8*)(lds + PG8_SB(b, h) + boff + n * 2048 + k * 1024); } while (0)
#define PG8_MMA(ai, bj, At, Bt) do { __builtin_amdgcn_s_setprio(1); _Pragma("unroll") for (int m = 0; m < 4; ++m) _Pragma("unroll") for (int n = 0; n < 2; ++n) _Pragma("unroll") for (int k = 0; k < 2; ++k) \
        acc[ai][bj][m][n] = TRANS ? __builtin_amdgcn_mfma_f32_16x16x32_bf16(At[m][k], Bt[n][k], acc[ai][bj][m][n], 0, 0, 0) \
                                  : __builtin_amdgcn_mfma_f32_16x16x32_bf16(Bt[n][k], At[m][k], acc[ai][bj][m][n], 0, 0, 0); __builtin_amdgcn_s_setprio(0); } while (0)
#define PG8_WAIT_V(n) asm volatile("s_waitcnt vmcnt(" #n ")" ::: "memory")
#define PG8_WAIT_L(n) asm volatile("s_waitcnt lgkmcnt(" #n ")" ::: "memory")
#define PG8_BAR __builtin_amdgcn_s_barrier()
#define PG8_SCHED __builtin_amdgcn_sched_barrier(0)
    Unit cur, nxt; int ui = 0;
    if (!S.next(0, cur)) return;
    float pfv[8];
    if constexpr (Epi::PREF) E.prefetch(cur, wr, fr, pfv);
    f32x4 acc[2][2][4][2];
#pragma unroll
    for (int a = 0; a < 2; ++a)
#pragma unroll
        for (int b = 0; b < 2; ++b)
#pragma unroll
            for (int m = 0; m < 4; ++m)
#pragma unroll
                for (int n = 0; n < 2; ++n) acc[a][b][m][n] = (f32x4){0.f, 0.f, 0.f, 0.f};
    bf16x8 At[4][2], B0[2][2], B1[2][2];
    const char* cA = cur.A; const char* cB = cur.B; int cpa = cur.pa, cpb = cur.pb;
    {
        const size_t hA = (size_t)HALF * cpa, hB = (size_t)HALF * cpb;
        PG8_STAGE(PG8_SB(0, 0), cB, cpb, RB); PG8_STAGE(PG8_SB(0, 1), cB + hB, cpb, RB); PG8_STAGE(PG8_SA(0, 0), cA, cpa, RA); PG8_STAGE(PG8_SA(0, 1), cA + hA, cpa, RA);
        if (wr == 1) PG8_BAR;
        PG8_WAIT_V(2); PG8_BAR;
        PG8_STAGE(PG8_SB(1, 0), cB + 128, cpb, RB); PG8_STAGE(PG8_SA(1, 0), cA + 128, cpa, RA); PG8_STAGE(PG8_SB(1, 1), cB + hB + 128, cpb, RB);
        PG8_WAIT_V(6); PG8_BAR;
    }
    for (;;) {
        const bool has_next = S.next(ui + 1, nxt);
        const char* nA = has_next ? nxt.A : cA; const char* nB = has_next ? nxt.B : cB; const int npa = has_next ? nxt.pa : cpa, npb = has_next ? nxt.pb : cpb;
        const int nt = cur.nt; const size_t hA = (size_t)HALF * cpa;
        for (int t = 0; t < nt; t += 2) {
            const bool last = (t == nt - 2);
            const char* a1 = cA + (size_t)(t + 1) * 128;
            const char* a2 = last ? nA : cA + (size_t)(t + 2) * 128; const char* b2 = last ? nB : cB + (size_t)(t + 2) * 128;
            const int pa2 = last ? npa : cpa, pb2 = last ? npb : cpb; const size_t hA2 = (size_t)HALF * pa2, hB2 = (size_t)HALF * pb2;
            const char* a3 = a2 + 128; const char* b3 = b2 + 128;
            PG8_LDB(B0, 0, 0); PG8_LDB(B1, 0, 1); PG8_SCHED; PG8_LDA(At, 0, 0); PG8_STAGE(PG8_SA(1, 1), a1 + hA, cpa, RA);
            PG8_WAIT_V(8); PG8_WAIT_L(0); PG8_BAR; PG8_MMA(0, 0, At, B0); PG8_MMA(0, 1, At, B1); PG8_BAR; PG8_SCHED;
            PG8_LDA(At, 0, 1); PG8_STAGE(PG8_SB(0, 0), b2, pb2, RB); PG8_STAGE(PG8_SB(0, 1), b2 + hB2, pb2, RB); PG8_STAGE(PG8_SA(0, 0), a2, pa2, RA);
            PG8_WAIT_V(8); PG8_WAIT_L(0); PG8_BAR; PG8_MMA(1, 0, At, B0); PG8_MMA(1, 1, At, B1); PG8_BAR; PG8_SCHED;
            PG8_LDB(B0, 1, 0); PG8_LDB(B1, 1, 1); PG8_SCHED; PG8_LDA(At, 1, 0); PG8_STAGE(PG8_SA(0, 1), a2 + hA2, pa2, RA);
            PG8_WAIT_V(8); PG8_WAIT_L(0); PG8_BAR; PG8_MMA(0, 0, At, B0); PG8_MMA(0, 1, At, B1); PG8_BAR; PG8_SCHED;
            PG8_LDA(At, 1, 1); PG8_STAGE(PG8_SB(1, 0), b3, pb2, RB); PG8_STAGE(PG8_SB(1, 1), b3 + hB2, pb2, RB); PG8_STAGE(PG8_SA(1, 0), a3, pa2, RA);
            PG8_WAIT_V(8); PG8_WAIT_L(0); PG8_BAR; PG8_MMA(1, 0, At, B0); PG8_MMA(1, 1, At, B1); PG8_BAR; PG8_SCHED;
        }
        if (wr == 0) PG8_BAR;
        bool keep;
        if constexpr (Epi::PREF) keep = E.run(acc, cur, wr, wc, fr, fq, pfv);
        else { if (Epi::TWICE) (void)E(acc, cur, wr, wc, fr, fq); keep = E(acc, cur, wr, wc, fr, fq); }
        if (!has_next) break;
        if (!keep) {
#pragma unroll
            for (int a = 0; a < 2; ++a)
#pragma unroll
                for (int b = 0; b < 2; ++b)
#pragma unroll
                    for (int m = 0; m < 4; ++m)
#pragma unroll
                        for (int n = 0; n < 2; ++n) acc[a][b][m][n] = (f32x4){0.f, 0.f, 0.f, 0.f};
        }
        cur = nxt; cA = nA; cB = nB; cpa = npa; cpb = npb; ++ui;
        if constexpr (Epi::PREF) E.prefetch(cur, wr, fr, pfv);
        if (wr == 1) PG8_BAR;
    }
    PG8_WAIT_V(0);
    PG8_BAR;
#undef PG8_SA
#undef PG8_SB
#undef PG8_STAGE
#undef PG8_LDA
#undef PG8_LDB
#undef PG8_MMA
#undef PG8_WAIT_V
#undef PG8_WAIT_L
#undef PG8_BAR
#undef PG8_SCHED
}
}
using pg8::Unit;

template <int NSUB> struct SchedRect {
    const char* A0; const char* B0; const char* A1; const char* B1; int pa0, nt0, pa1, nt1; int nM, nN, G, c;
    __device__ __forceinline__ bool next(int i, Unit& u) const {
        const int ti = i / NSUB, s = i % NSUB; int pm, pn;
        if (!pg8::rect_tile((long)ti * G + c, nM, nN, pm, pn)) return false;
        const int pa = (NSUB > 1 && s) ? pa1 : pa0;
        u.pa = pa; u.pb = pa; u.nt = (NSUB > 1 && s) ? nt1 : nt0; u.pm = pm; u.pn = pn; u.aux = s;
        u.A = ((NSUB > 1 && s) ? A1 : A0) + (size_t)pm * 256 * pa; u.B = ((NSUB > 1 && s) ? B1 : B0) + (size_t)pn * 256 * pa; return true;
    }
};

struct SchedMerge {
    const char* ws; int G, c;
    __device__ __forceinline__ bool next(int i, Unit& u) const {
        const int ti = i / 3, s = i % 3; int pm, pn;
        if (!pg8::rect_tile((long)ti * G + c, MT / 256, 4, pm, pn)) return false;
        u.pa = 1024; u.nt = 8; u.pm = pm; u.pn = pn; u.aux = s;
        if (s == 0) { u.A = ws + ATT_OFF + (size_t)pm * 256 * 1024; u.B = ws + WNA_OFF + (size_t)pn * 256 * 1024; u.pb = 1024; }
        else { u.A = ws + (s == 1 ? PB_OFF : QB_OFF) + (size_t)pm * 256 * 1024; u.B = ws + WFN_OFF + (size_t)pn * 256 * 2048 + (s == 2 ? 1024 : 0); u.pb = 2048; }
        return true;
    }
};
struct SchedDft {
    const char* ws; int G, c;
    __device__ __forceinline__ bool next(int i, Unit& u) const {
        const long L = (long)i * G + c; if (L >= 416) return false;
        int pm, b, pn;
        if (L < 272) {
            if (L < 256) { const int x = (int)L & 7, s = (int)L >> 3; pm = 8 * (x >> 2) + (s & 7); b = s >> 3; pn = x & 3; }
            else { const int e = (int)L - 256; pm = 16; b = e >> 2; pn = e & 3; }
            u.pa = KPP * 2; u.pb = KPP * 2; u.nt = KPP / 64;
            u.A = ws + (pn < 2 ? CP_OFF : SP_OFF) + (size_t)pm * 256 * KPP * 2;
            u.B = ws + (pn < 2 ? UE_OFF : UO_OFF) + ((size_t)b * 512 + (pn & 1) * 256) * KPP * 2;
        } else {
            const int l = (int)L - 272, x = l & 7, s = l >> 3; pn = x & 3; pm = s % 9; b = 4 + 2 * (s / 9) + (x >> 2);
            u.pa = KPS * 2; u.pb = KPS * 2; u.nt = KPS / 64;
            u.A = ws + (pn < 2 ? CS_OFF : SSM_OFF) + (size_t)pm * 256 * KPS * 2;
            u.B = ws + (pn < 2 ? UE_OFF : UO_OFF) + (size_t)4 * 512 * KPP * 2 + ((size_t)(b - 4) * 512 + (pn & 1) * 256) * KPS * 2;
        }
        u.pm = pm; u.pn = pn; u.aux = b; return true;
    }
};

__device__ __forceinline__ float sigmoidf_(float v) { return __builtin_amdgcn_rcpf(1.0f + __builtin_amdgcn_exp2f(-1.44269504f * v)); }
typedef f32x4 Acc[2][2][4][2];

struct EpiP1a {
    static constexpr bool PERM = true, TWICE = (EPI2 == 1), PREF = false;
    unsigned char* ws; float* gates;
    __device__ __forceinline__ bool operator()(Acc& acc, const Unit& u, int wr, int wc, int fr, int fq) const {
        asm volatile("" : "+v"(fr), "+v"(fq));
        const int row0 = u.pm * 256 + wr * 64 + fr;
        if (u.pn < 4) {
            bf16_t* base = (bf16_t*)(ws + (u.pn < 2 ? Q_OFF : K_OFF)); const int col0 = (u.pn & 1) * 256 + wc * 32 + 8 * fq;
#pragma unroll
            for (int ai = 0; ai < 2; ++ai)
#pragma unroll
                for (int m = 0; m < 4; ++m) { bf16_t* rowp = base + (size_t)(row0 + ai * 128 + m * 16) * 512 + col0;
#pragma unroll
                    for (int bj = 0; bj < 2; ++bj) { const f32x4 v0 = acc[ai][bj][m][0], v1 = acc[ai][bj][m][1];
                        u32x4 w; w.x = cvt_pk_bf16(v0[0], v0[1]); w.y = cvt_pk_bf16(v0[2], v0[3]); w.z = cvt_pk_bf16(v1[0], v1[1]); w.w = cvt_pk_bf16(v1[2], v1[3]);
                        *(u32x4*)(rowp + bj * 128) = w; } }
        } else {
            bf16_t* Rb = (bf16_t*)gates; bf16_t* Sb = Rb + (size_t)MT * 1024; const int col0 = (u.pn - 4) * 128 + wc * 32 + 8 * fq;
#pragma unroll
            for (int ai = 0; ai < 2; ++ai)
#pragma unroll
                for (int m = 0; m < 4; ++m) { const size_t off = (size_t)(row0 + ai * 128 + m * 16) * 1024 + col0; float rr[8], s2[8];
#pragma unroll
                    for (int n = 0; n < 2; ++n)
#pragma unroll
                        for (int e = 0; e < 4; ++e) { const float e1 = __builtin_amdgcn_exp2f(fminf(-1.44269504f * acc[ai][0][m][n][e], 60.f)), e2 = __builtin_amdgcn_exp2f(fminf(-1.44269504f * acc[ai][1][m][n][e], 60.f));
                            const float d1 = 1.0f + e1, d2 = 1.0f + e2, t = __builtin_amdgcn_rcpf(d1 * d2);
                            s2[4 * n + e] = t * d1; rr[4 * n + e] = d2 * d2 * t; }
                    u32x4 w; w.x = cvt_pk_bf16(rr[0], rr[1]); w.y = cvt_pk_bf16(rr[2], rr[3]); w.z = cvt_pk_bf16(rr[4], rr[5]); w.w = cvt_pk_bf16(rr[6], rr[7]);
                    *(u32x4*)(Rb + off) = w;
                    w.x = cvt_pk_bf16(s2[0], s2[1]); w.y = cvt_pk_bf16(s2[2], s2[3]); w.z = cvt_pk_bf16(s2[4], s2[5]); w.w = cvt_pk_bf16(s2[6], s2[7]);
                    *(u32x4*)(Sb + off) = w; }
        }
        return false;
    }
};
struct EpiP1b {
    static constexpr bool PERM = false, TWICE = (EPI2 == 1), PREF = false;
    unsigned char* ws;
    __device__ __forceinline__ bool operator()(Acc& acc, const Unit& u, int wr, int wc, int fr, int fq) const {
        asm volatile("" : "+v"(fr), "+v"(fq));
        const int g0 = u.pm * 256; const int b = g0 < 4 * TP ? g0 / TP : 4 + (g0 - 4 * TP) / TS; const int gb = batch_base(b), T = b < 4 ? TP : TS, N = T + 16;
        bf16_t* base; size_t pitch; int coff;
        if (u.pn < 2) { base = (bf16_t*)(ws + VT_OFF) + (size_t)512 * gb; pitch = T; coff = u.pn * 256; }
        else { base = (bf16_t*)(ws + UT_OFF) + (b < 4 ? (size_t)b * 512 * NP : (size_t)4 * 512 * NP + (size_t)(b - 4) * 512 * NS) + 16; pitch = N; coff = (u.pn - 2) * 256; }
        const int t0 = g0 - gb + wr * 64 + 4 * fq, c0 = coff + wc * 32 + fr;
#pragma unroll
        for (int ai = 0; ai < 2; ++ai)
#pragma unroll
            for (int bj = 0; bj < 2; ++bj)
#pragma unroll
                for (int m = 0; m < 4; ++m)
#pragma unroll
                    for (int n = 0; n < 2; ++n) { const f32x4 v = acc[ai][bj][m][n]; u32x2 w; w.x = cvt_pk_bf16(v[0], v[1]); w.y = cvt_pk_bf16(v[2], v[3]);
                        *(u32x2*)(base + (size_t)(c0 + bj * 128 + n * 16) * pitch + t0 + ai * 128 + m * 16) = w; }
        return false;
    }
};
struct EpiDft {
    static constexpr bool PERM = true, TWICE = (EPI2 == 3), PREF = false;
    unsigned char* ws;
    __device__ __forceinline__ bool operator()(Acc& acc, const Unit& u, int wr, int wc, int fr, int fq) const {
        asm volatile("" : "+v"(fr), "+v"(fq));
        const int b = u.aux, gb = batch_base(b), N = (b < 4 ? TP : TS) + 16, HN = N / 2;
        bf16_t* base = (bf16_t*)(ws + (u.pn < 2 ? PB_OFF : QB_OFF)) + (size_t)gb * 512 + (u.pn & 1) * 256 + wc * 32 + 8 * fq;
        const float sg = u.pn >= 2 ? -1.f : 1.f;
#pragma unroll
        for (int ai = 0; ai < 2; ++ai)
#pragma unroll
            for (int m = 0; m < 4; ++m) { const int np = u.pm * 256 + ai * 128 + wr * 64 + m * 16 + fr + 1;
                if (np <= HN) {
#pragma unroll
                    for (int bj = 0; bj < 2; ++bj) { const f32x4 v0 = acc[ai][bj][m][0], v1 = acc[ai][bj][m][1];
                        if (np >= 16) { u32x4 w; w.x = cvt_pk_bf16(v0[0], v0[1]); w.y = cvt_pk_bf16(v0[2], v0[3]); w.z = cvt_pk_bf16(v1[0], v1[1]); w.w = cvt_pk_bf16(v1[2], v1[3]);
                            *(u32x4*)(base + (size_t)(np - 16) * 512 + bj * 128) = w; }
                        if (np != HN) { u32x4 w; w.x = cvt_pk_bf16(sg * v0[0], sg * v0[1]); w.y = cvt_pk_bf16(sg * v0[2], sg * v0[3]); w.z = cvt_pk_bf16(sg * v1[0], sg * v1[1]); w.w = cvt_pk_bf16(sg * v1[2], sg * v1[3]);
                            *(u32x4*)(base + (size_t)(N - np - 16) * 512 + bj * 128) = w; } } } }
        return false;
    }
};
struct EpiMerge {
    static constexpr bool PERM = true, TWICE = false, PREF = false;
    unsigned char* ws; const float* gates;
    __device__ __forceinline__ bool operator()(Acc& acc, const Unit& u, int wr, int wc, int fr, int fq) const {
        if (u.aux == 1) return true;
        asm volatile("" : "+v"(fr), "+v"(fq));
        const bf16_t* Gs = (const bf16_t*)gates + (u.aux == 0 ? (size_t)0 : (size_t)MT * 1024);
        const int row0 = u.pm * 256 + wr * 64 + fr, col0 = u.pn * 256 + wc * 32 + 8 * fq;
        bf16_t* mix = (bf16_t*)(ws + MIX_OFF);
        u32x4 g2[4][2];
#pragma unroll
        for (int q = 0; q < 3; ++q)
#pragma unroll
            for (int bj = 0; bj < 2; ++bj) g2[q][bj] = *(const u32x4*)(Gs + (size_t)(row0 + q * 16) * 1024 + col0 + bj * 128);
#pragma unroll
        for (int idx = 0; idx < 8; ++idx) { const int ai = idx >> 2, m = idx & 3; const size_t off = (size_t)(row0 + ai * 128 + m * 16) * 1024 + col0;
            if (idx < 5) { const int ai2 = (idx + 3) >> 2, m2 = (idx + 3) & 3; const size_t off2 = (size_t)(row0 + ai2 * 128 + m2 * 16) * 1024 + col0;
#pragma unroll
                for (int bj = 0; bj < 2; ++bj) g2[(idx + 3) & 3][bj] = *(const u32x4*)(Gs + off2 + bj * 128); }
#pragma unroll
            for (int bj = 0; bj < 2; ++bj) { const u32x4 w2 = g2[idx & 3][bj];
                const float sc[8] = {bf_lo(w2.x), bf_hi(w2.x), bf_lo(w2.y), bf_hi(w2.y), bf_lo(w2.z), bf_hi(w2.z), bf_lo(w2.w), bf_hi(w2.w)};
#pragma unroll
                for (int e = 0; e < 4; ++e) { acc[ai][bj][m][0][e] *= sc[e]; acc[ai][bj][m][1][e] *= sc[4 + e]; }
                if (u.aux == 2) { const f32x4 v0 = acc[ai][bj][m][0], v1 = acc[ai][bj][m][1]; u32x4 w;
                    w.x = cvt_pk_bf16(v0[0], v0[1]); w.y = cvt_pk_bf16(v0[2], v0[3]); w.z = cvt_pk_bf16(v1[0], v1[1]); w.w = cvt_pk_bf16(v1[2], v1[3]);
                    *(u32x4*)(mix + off + bj * 128) = w; } } }
        return u.aux == 0;
    }
};
struct EpiRes5 {
    static constexpr bool PERM = true, TWICE = false, PREF = false;
    const float* bp; const float* bs; bf16_t* ob; float* ss;
    __device__ __forceinline__ bool operator()(Acc& acc, const Unit& u, int wr, int wc, int fr, int fq) const {
        asm volatile("" : "+v"(fr), "+v"(fq));
        const int g0 = u.pm * 256; const float* base = g0 < 4 * TP ? bp + (size_t)g0 * 1024 : bs + (size_t)(g0 - 4 * TP) * 1024;
        const int lr0 = wr * 64 + fr, col0 = u.pn * 256 + wc * 32 + 8 * fq;
        f32x4 pre[3][2][2];
#pragma unroll
        for (int q = 0; q < 2; ++q)
#pragma unroll
            for (int bj = 0; bj < 2; ++bj)
#pragma unroll
                for (int n = 0; n < 2; ++n) pre[q][bj][n] = *(const f32x4*)(base + (size_t)(lr0 + q * 16) * 1024 + col0 + bj * 128 + n * 4);
#pragma unroll
        for (int idx = 0; idx < 8; ++idx) { const int ai = idx >> 2, m = idx & 3; const int lr = lr0 + ai * 128 + m * 16; float s = 0.f;
            if (idx < 6) { const int lr2 = lr0 + ((idx + 2) >> 2) * 128 + ((idx + 2) & 3) * 16;
#pragma unroll
                for (int bj = 0; bj < 2; ++bj)
#pragma unroll
                    for (int n = 0; n < 2; ++n) pre[(idx + 2) % 3][bj][n] = *(const f32x4*)(base + (size_t)lr2 * 1024 + col0 + bj * 128 + n * 4); }
#pragma unroll
            for (int bj = 0; bj < 2; ++bj) { const f32x4 o0 = pre[idx % 3][bj][0] + acc[ai][bj][m][0], o1 = pre[idx % 3][bj][1] + acc[ai][bj][m][1];
                s += ((o0[0] * o0[0] + o0[1] * o0[1]) + (o0[2] * o0[2] + o0[3] * o0[3])) + ((o1[0] * o1[0] + o1[1] * o1[1]) + (o1[2] * o1[2] + o1[3] * o1[3]));
                u32x4 w; w.x = cvt_pk_bf16(o0[0], o0[1]); w.y = cvt_pk_bf16(o0[2], o0[3]); w.z = cvt_pk_bf16(o1[0], o1[1]); w.w = cvt_pk_bf16(o1[2], o1[3]);
                *(u32x4*)(ob + (size_t)(g0 + lr) * 1024 + col0 + bj * 128) = w; }
            s += __shfl_xor(s, 16); s += __shfl_xor(s, 32);
            if (fq == 0) atomicAdd(ss + g0 + lr, s); }
        return false;
    }
};
struct EpiRes7 {
    static constexpr bool PERM = true, TWICE = false, PREF = false;
    bf16_t* xb; float* ss;
    __device__ __forceinline__ bool operator()(Acc& acc, const Unit& u, int wr, int wc, int fr, int fq) const {
        asm volatile("" : "+v"(fr), "+v"(fq));
        const int row0 = u.pm * 256 + wr * 64 + fr, col0 = u.pn * 256 + wc * 32 + 8 * fq;
        u32x4 pre[4][2];
#pragma unroll
        for (int q = 0; q < 3; ++q)
#pragma unroll
            for (int bj = 0; bj < 2; ++bj) pre[q][bj] = *(const u32x4*)(xb + (size_t)(row0 + q * 16) * 1024 + col0 + bj * 128);
#pragma unroll
        for (int idx = 0; idx < 8; ++idx) { const int ai = idx >> 2, m = idx & 3; const int row = row0 + ai * 128 + m * 16; float s = 0.f;
            if (idx < 5) { const int row2 = row0 + ((idx + 3) >> 2) * 128 + ((idx + 3) & 3) * 16;
#pragma unroll
                for (int bj = 0; bj < 2; ++bj) pre[(idx + 3) & 3][bj] = *(const u32x4*)(xb + (size_t)row2 * 1024 + col0 + bj * 128); }
#pragma unroll
            for (int bj = 0; bj < 2; ++bj) { const u32x4 b = pre[idx & 3][bj]; const f32x4 a0 = acc[ai][bj][m][0], a1 = acc[ai][bj][m][1];
                const float o[8] = {bf_lo(b.x) + a0[0], bf_hi(b.x) + a0[1], bf_lo(b.y) + a0[2], bf_hi(b.y) + a0[3], bf_lo(b.z) + a1[0], bf_hi(b.z) + a1[1], bf_lo(b.w) + a1[2], bf_hi(b.w) + a1[3]};
#pragma unroll
                for (int e = 0; e < 8; ++e) s += o[e] * o[e];
                u32x4 w; w.x = cvt_pk_bf16(o[0], o[1]); w.y = cvt_pk_bf16(o[2], o[3]); w.z = cvt_pk_bf16(o[4], o[5]); w.w = cvt_pk_bf16(o[6], o[7]);
                *(u32x4*)(xb + (size_t)row * 1024 + col0 + bj * 128) = w; }
            s += __shfl_xor(s, 16); s += __shfl_xor(s, 32);
            if (fq == 0) atomicAdd(ss + row, s); }
        return false;
    }
};
struct EpiRes7F {
    static constexpr bool PERM = true, TWICE = false, PREF = false;
    const bf16_t* xb; float* ss; unsigned* cnt; const float* gfin; float* out;
    __device__ __forceinline__ bool operator()(Acc& acc, const Unit& u, int wr, int wc, int fr, int fq) const {
        asm volatile("" : "+v"(fr), "+v"(fq));
        const int row0 = u.pm * 256 + wr * 64 + fr, col0 = u.pn * 256 + wc * 32 + 8 * fq;
        u32x4 pre[4][2];
#pragma unroll
        for (int q = 0; q < 3; ++q)
#pragma unroll
            for (int bj = 0; bj < 2; ++bj) pre[q][bj] = *(const u32x4*)(xb + (size_t)(row0 + q * 16) * 1024 + col0 + bj * 128);
#pragma unroll
        for (int idx = 0; idx < 8; ++idx) { const int ai = idx >> 2, m = idx & 3; const int row = row0 + ai * 128 + m * 16; float s = 0.f;
            if (idx < 5) { const int row2 = row0 + ((idx + 3) >> 2) * 128 + ((idx + 3) & 3) * 16;
#pragma unroll
                for (int bj = 0; bj < 2; ++bj) pre[(idx + 3) & 3][bj] = *(const u32x4*)(xb + (size_t)row2 * 1024 + col0 + bj * 128); }
#pragma unroll
            for (int bj = 0; bj < 2; ++bj) { const u32x4 b = pre[idx & 3][bj]; f32x4& a0 = acc[ai][bj][m][0]; f32x4& a1 = acc[ai][bj][m][1];
                a0[0] += bf_lo(b.x); a0[1] += bf_hi(b.x); a0[2] += bf_lo(b.y); a0[3] += bf_hi(b.y); a1[0] += bf_lo(b.z); a1[1] += bf_hi(b.z); a1[2] += bf_lo(b.w); a1[3] += bf_hi(b.w);
#pragma unroll
                for (int e = 0; e < 4; ++e) s += a0[e] * a0[e] + a1[e] * a1[e]; }
            s += __shfl_xor(s, 16); s += __shfl_xor(s, 32);
            if (fq == 0) atomicAdd(ss + row, s); }
        asm volatile("s_waitcnt vmcnt(0)" ::: "memory");
        __builtin_amdgcn_s_barrier();
        if (threadIdx.x == 0) { unsigned* c = cnt + u.pm; __hip_atomic_fetch_add(c, 1u, __ATOMIC_RELAXED, __HIP_MEMORY_SCOPE_AGENT);
            unsigned sp = 0; while (__hip_atomic_load(c, __ATOMIC_RELAXED, __HIP_MEMORY_SCOPE_AGENT) < 4u && ++sp < (1u << 22)) __builtin_amdgcn_s_sleep(2); }
        __builtin_amdgcn_s_barrier(); asm volatile("" ::: "memory");
        float rv[8];
#pragma unroll
        for (int idx = 0; idx < 8; ++idx) rv[idx] = __hip_atomic_load(ss + row0 + (idx >> 2) * 128 + (idx & 3) * 16, __ATOMIC_RELAXED, __HIP_MEMORY_SCOPE_AGENT);
        f32x4 gf[2][2];
#pragma unroll
        for (int bj = 0; bj < 2; ++bj) { gf[bj][0] = *(const f32x4*)(gfin + col0 + bj * 128); gf[bj][1] = *(const f32x4*)(gfin + col0 + bj * 128 + 4); }
#pragma unroll
        for (int idx = 0; idx < 8; ++idx) { const int ai = idx >> 2, m = idx & 3; const int row = row0 + ai * 128 + m * 16; const float rinv = rsqrtf(rv[idx] * (1.0f / 1024.0f) + RMS_EPS);
#pragma unroll
            for (int bj = 0; bj < 2; ++bj) { float* o = out + (size_t)row * 1024 + col0 + bj * 128;
                *(f32x4*)o = acc[ai][bj][m][0] * rinv * gf[bj][0]; *(f32x4*)(o + 4) = acc[ai][bj][m][1] * rinv * gf[bj][1]; } }
        return false;
    }
};
struct EpiUp {
    static constexpr bool PERM = true, TWICE = (EPI2 == 6), PREF = true;
    bf16_t* H; const float* ss;
    __device__ __forceinline__ void prefetch(const Unit& u, int wr, int fr, float (&rv)[8]) const {
        const int row0 = u.pm * 256 + wr * 64 + fr;
#pragma unroll
        for (int idx = 0; idx < 8; ++idx) rv[idx] = ss[row0 + (idx >> 2) * 128 + (idx & 3) * 16];
    }
    __device__ __forceinline__ bool run(Acc& acc, const Unit& u, int wr, int wc, int fr, int fq, const float (&rv)[8]) const {
        asm volatile("" : "+v"(fr), "+v"(fq));
        const int row0 = u.pm * 256 + wr * 64 + fr, col0 = u.pn * 256 + wc * 32 + 8 * fq;
#pragma unroll
        for (int ai = 0; ai < 2; ++ai)
#pragma unroll
            for (int m = 0; m < 4; ++m) { const int row = row0 + ai * 128 + m * 16; const float rinv = rsqrtf(rv[ai * 4 + m] * (1.0f / 1024.0f) + RMS_EPS);
#pragma unroll
                for (int bj = 0; bj < 2; ++bj) { f32x4 v0 = acc[ai][bj][m][0], v1 = acc[ai][bj][m][1];
#pragma unroll
                    for (int e = 0; e < 4; ++e) { const float a = fmaxf(v0[e] * rinv, 0.f), b = fmaxf(v1[e] * rinv, 0.f); v0[e] = a * a; v1[e] = b * b; }
                    u32x4 w; w.x = cvt_pk_bf16(v0[0], v0[1]); w.y = cvt_pk_bf16(v0[2], v0[3]); w.z = cvt_pk_bf16(v1[0], v1[1]); w.w = cvt_pk_bf16(v1[2], v1[3]);
                    *(u32x4*)(H + (size_t)row * 4096 + col0 + bj * 128) = w; } }
        return false;
    }
};

__device__ __forceinline__ void p0_transpose_item(const float* W, int K, int N, bf16_t* WT, int out_row0, int n0, int k0, const float* sc, float mul, LAS float* scr, int lane) {
    float tv[32];
#pragma unroll
    for (int i = 0; i < 32; ++i) { const int kk = 2 * i + (lane >> 5); tv[i] = W[(size_t)(k0 + kk) * N + n0 + (lane & 31)]; }
#pragma unroll
    for (int i = 0; i < 32; ++i) { const int kk = 2 * i + (lane >> 5); const float s = sc ? sc[k0 + kk] * mul : mul; scr[kk * 33 + (lane & 31)] = tv[i] * s; }
    asm volatile("s_waitcnt lgkmcnt(0)" ::: "memory");
    const int c = lane & 7;
#pragma unroll
    for (int j = 0; j < 4; ++j) { const int n = (lane >> 3) + 8 * j; const LAS float* s = scr + (8 * c) * 33 + n;
        u32x4 o; o.x = cvt_pk_bf16(s[0 * 33], s[1 * 33]); o.y = cvt_pk_bf16(s[2 * 33], s[3 * 33]); o.z = cvt_pk_bf16(s[4 * 33], s[5 * 33]); o.w = cvt_pk_bf16(s[6 * 33], s[7 * 33]);
        *(u32x4*)(WT + (size_t)(out_row0 + n) * K + k0 + 8 * c) = o; }
    asm volatile("s_waitcnt lgkmcnt(0)" ::: "memory");
}

template <int PART> __device__ __forceinline__ void p0_prologue(const Params& p, LAS unsigned char* lds, int bx, int G) {
    const int tid = threadIdx.x, lane = tid & 63, wid = tid >> 6;
    const int gw = bx * 8 + wid, NGW = G * 8, gt = bx * 512 + tid, NGT = G * 512;
    unsigned char* ws = p.ws;
    if (PART == 0) for (int i = gt; i < MT; i += NGT) { ((float*)(ws + SS1_OFF))[i] = 0.f; ((float*)(ws + SS2_OFF))[i] = 0.f; }
    for (int r0_ = 0; r0_ < (P0REP == 0 ? 2 : 1); ++r0_)
    if (PART == 0 && bx < 24) {
        LAS float* hm = (LAS float*)lds;
        LAS float* red = (LAS float*)(lds + 65536);
        for (int r = wid * 2; r < wid * 2 + 2; ++r) { float v[16]; float s = 0.f;
#pragma unroll
            for (int j = 0; j < 16; ++j) { v[j] = p.meta[r * 1024 + lane + 64 * j]; s += v[j] * v[j]; }
            const float rinv = rsqrtf(wave_sum(s) * (1.0f / 1024.0f) + RMS_EPS);
#pragma unroll
            for (int j = 0; j < 16; ++j) hm[r * 1024 + lane + 64 * j] = v[j] * rinv * p.g_mix[lane + 64 * j]; }
        __syncthreads();
        const int n = 512 + bx * 64 + lane; float a[16];
#pragma unroll
        for (int r = 0; r < 16; ++r) a[r] = 0.f;
        for (int k0 = wid * 128; k0 < wid * 128 + 128; k0 += 16) { float w[16];
#pragma unroll
            for (int q = 0; q < 16; ++q) w[q] = p.w_in[(size_t)(k0 + q) * 4096 + n];
#pragma unroll
            for (int q = 0; q < 16; ++q)
#pragma unroll
                for (int r = 0; r < 16; ++r) a[r] += hm[r * 1024 + k0 + q] * w[q]; }
#pragma unroll
        for (int r = 0; r < 16; ++r) red[(wid * 16 + r) * 64 + lane] = a[r];
        __syncthreads();
        for (int o = tid; o < 1024; o += 512) { const int r = o >> 6, l = o & 63; float s = 0.f;
#pragma unroll
            for (int w = 0; w < 8; ++w) s += red[(w * 16 + r) * 64 + l];
            const int nn = 512 + bx * 64 + l; const bf16_t hv = (bf16_t)(cvt_pk_bf16(s, 0.f) & 0xffffu);
            if (nn < 1024) ((bf16_t*)(ws + KMETA_OFF))[r * 512 + nn - 512] = hv;
            else if (nn < 1536) ((bf16_t*)(ws + VMETAT_OFF))[(nn - 1024) * 16 + r] = hv;
            else { const int ch = nn - 1536;
                for (int b = 0; b < 8; ++b) { bf16_t* ut = (bf16_t*)(ws + UT_OFF) + (b < 4 ? (size_t)b * 512 * NP + (size_t)ch * NP : (size_t)4 * 512 * NP + (size_t)(b - 4) * 512 * NS + (size_t)ch * NS); ut[r] = hv; } } }
        __syncthreads();
    }
    for (int r1_ = 0; r1_ < (P0REP == 1 ? 2 : 1); ++r1_)
    if (PART == 0 || PART == 2) {
        LAS float* scr = (LAS float*)(lds + wid * 8448);
        constexpr int I_IN = 16 * 128, I_UP = 16 * 128, I_DN = 64 * 32, I_OUT = 16 * 32, I_NA = 8 * 32, NIT = I_IN + I_UP + I_DN + I_OUT + I_NA;
        for (int it = (PART == 0 ? 0 : I_IN) + gw; it < (PART == 0 ? I_IN : NIT); it += NGW) {
            int r = it;
            if (r < I_IN) { const int kb = r / 128, nb = r % 128, n0 = nb * 32; bf16_t* dst; int orow; float mul = 1.f;
                if (n0 < 512) { dst = (bf16_t*)(ws + WINA_OFF); orow = n0; mul = 0.125f; } else if (n0 < 1024) { dst = (bf16_t*)(ws + WINA_OFF); orow = n0; }
                else if (n0 < 2048) { dst = (bf16_t*)(ws + WINB_OFF); orow = n0 - 1024; }
                else { const int isfn = n0 >= 3072, gc = n0 - (isfn ? 3072 : 2048); dst = (bf16_t*)(ws + WINA_OFF); orow = 1024 + 256 * (gc >> 7) + 128 * isfn + (gc & 127); }
                p0_transpose_item(p.w_in, 1024, 4096, dst, orow, n0, kb * 64, p.g_mix, mul, scr, lane); continue; } r -= I_IN;
            if (r < I_UP) { const int kb = r / 128, nb = r % 128; p0_transpose_item(p.w_up, 1024, 4096, (bf16_t*)(ws + WUP_OFF), nb * 32, nb * 32, kb * 64, p.g_mlp, 1.f, scr, lane); continue; } r -= I_UP;
            if (r < I_DN) { const int kb = r / 32, nb = r % 32; p0_transpose_item(p.w_down, 4096, 1024, (bf16_t*)(ws + WDN_OFF), nb * 32, nb * 32, kb * 64, nullptr, 1.f, scr, lane); continue; } r -= I_DN;
            if (r < I_OUT) { const int kb = r / 32, nb = r % 32; p0_transpose_item(p.w_out, 1024, 1024, (bf16_t*)(ws + WOUT_OFF), nb * 32, nb * 32, kb * 64, nullptr, 1.f, scr, lane); continue; } r -= I_OUT;
            { const int kb = r / 32, nb = r % 32; p0_transpose_item(p.w_na, 512, 1024, (bf16_t*)(ws + WNA_OFF), nb * 32, nb * 32, kb * 64, nullptr, 1.f, scr, lane); }
        }
    }
    for (int r2_ = 0; r2_ < (P0REP == 2 ? 2 : 1); ++r2_)
    if (PART == 2) for (int tw = gw; tw < 64 * 4 * 2; tw += NGW) {
        const int twu = __builtin_amdgcn_readfirstlane(tw); const int c = (twu & 1) * 64 + lane, g = (twu >> 1) & 3, d0 = (twu >> 3) * 16;
        float ac[16], as[16];
#pragma unroll
        for (int q = 0; q < 16; ++q) { ac[q] = 0.f; as[q] = 0.f; }
        const float* wf = p.w_fn + (size_t)g * 128 * 1024 + d0;
#pragma unroll 2
        for (int cp = 0; cp < 128; ++cp) { const float tr = (float)((c * cp) & 127) * (1.0f / 128.0f); const float co = __builtin_amdgcn_cosf(tr), si = __builtin_amdgcn_sinf(tr);
            f32x4 w[4];
#pragma unroll
            for (int q = 0; q < 4; ++q) w[q] = *(const __attribute__((address_space(4))) f32x4*)(unsigned long long)(wf + (size_t)cp * 1024 + 4 * q);
#pragma unroll
            for (int q = 0; q < 16; ++q) { ac[q] += co * w[q >> 2][q & 3]; as[q] -= si * w[q >> 2][q & 3]; } }
        bf16_t* o = (bf16_t*)(ws + WFN_OFF) + (size_t)d0 * 1024 + g * 128 + c;
#pragma unroll
        for (int q = 0; q < 16; ++q) { o[(size_t)q * 1024] = (bf16_t)(cvt_pk_bf16(ac[q], 0.f) & 0xffffu); o[(size_t)q * 1024 + 512] = (bf16_t)(cvt_pk_bf16(as[q], 0.f) & 0xffffu); } }
    for (int r3_ = 0; r3_ < (P0REP == 3 ? 2 : 1); ++r3_)
    if (PART == 1) {
        constexpr int IP = (NP / 2) * (KPP / 8), IS = (NS / 2) * (KPS / 8);
        for (int it = gt; it < IP + IS; it += NGT) {
            int i, j, N, KP; bf16_t* cm; bf16_t* sm;
            if (it < IP) { i = it / (KPP / 8); j = it % (KPP / 8); N = NP; KP = KPP; cm = (bf16_t*)(ws + CP_OFF); sm = (bf16_t*)(ws + SP_OFF); }
            else { const int q = it - IP; i = q / (KPS / 8); j = q % (KPS / 8); N = NS; KP = KPS; cm = (bf16_t*)(ws + CS_OFF); sm = (bf16_t*)(ws + SSM_OFF); }
            const int np = i + 1; const float norm = rsqrtf(128.0f * (float)N), invN = 1.0f / (float)N;
            float cv[8], sv[8]; int mm; { const unsigned prod = (unsigned)np * (unsigned)(8 * j); unsigned q = (unsigned)((float)prod * invN); if (q > 0) --q; mm = (int)(prod - q * (unsigned)N); while (mm >= N) mm -= N; }
            float c_ = __builtin_amdgcn_cosf((float)mm * invN) * norm, s_ = __builtin_amdgcn_sinf((float)mm * invN) * norm;
            const float ct = __builtin_amdgcn_cosf((float)np * invN), st = __builtin_amdgcn_sinf((float)np * invN);
#pragma unroll
            for (int e = 0; e < 8; ++e) { cv[e] = c_; sv[e] = s_; const float c2 = c_ * ct - s_ * st; s_ = s_ * ct + c_ * st; c_ = c2; }
            u32x4 wc_, ws_; wc_.x = cvt_pk_bf16(cv[0], cv[1]); wc_.y = cvt_pk_bf16(cv[2], cv[3]); wc_.z = cvt_pk_bf16(cv[4], cv[5]); wc_.w = cvt_pk_bf16(cv[6], cv[7]);
            ws_.x = cvt_pk_bf16(sv[0], sv[1]); ws_.y = cvt_pk_bf16(sv[2], sv[3]); ws_.z = cvt_pk_bf16(sv[4], sv[5]); ws_.w = cvt_pk_bf16(sv[6], sv[7]);
            *(u32x4*)(cm + (size_t)i * KP + 8 * j) = wc_; *(u32x4*)(sm + (size_t)i * KP + 8 * j) = ws_;
        }
    }
    if (PART == 0) {
        constexpr int NCH = MT / 4;
        const bool uneven = (G == 256); const int nm = 24 * 8, nn = 256 * 8 - nm;
        for (int itx = 0; ; ++itx) {
            int chunk;
            if (!uneven) chunk = gw + itx * NGW;
            else if (bx >= 24) { const int wp = gw - nm; chunk = itx < 6 ? itx * nn + wp : (itx == 6 && wp < NCH - 6 * nn - 4 * nm ? 6 * nn + 4 * nm + wp : NCH); }
            else chunk = itx < 4 ? 6 * nn + gw * 4 + itx : NCH;
            if (chunk >= NCH) break;
            f32x4 v[4][4];
#pragma unroll
            for (int q = 0; q < 4; ++q) { const int g = chunk * 4 + q; const float* xr = g < 4 * TP ? p.xp + (size_t)g * 1024 : p.xs + (size_t)(g - 4 * TP) * 1024;
#pragma unroll
                for (int j = 0; j < 4; ++j) v[q][j] = ((const f32x4*)xr)[lane + 64 * j]; }
#pragma unroll
            for (int q = 0; q < 4; ++q) { const int g = chunk * 4 + q; float s = 0.f;
#pragma unroll
                for (int j = 0; j < 4; ++j) s += (v[q][j][0] * v[q][j][0] + v[q][j][1] * v[q][j][1]) + (v[q][j][2] * v[q][j][2] + v[q][j][3] * v[q][j][3]);
                const float rinv = rsqrtf(wave_sum(s) * (1.0f / 1024.0f) + RMS_EPS);
                u32x2* o = (u32x2*)((bf16_t*)(ws + XB_OFF) + (size_t)g * 1024);
#pragma unroll
                for (int j = 0; j < 4; ++j) { u32x2 w; w.x = cvt_pk_bf16(v[q][j][0] * rinv, v[q][j][1] * rinv); w.y = cvt_pk_bf16(v[q][j][2] * rinv, v[q][j][3] * rinv); o[lane + 64 * j] = w; } }
        }
    }
}

constexpr int A_KS = 0, A_VS = 73728, A_KM = 147456, A_VM = 149504, A_BS = 151552, A_MB = 155392;
__device__ __forceinline__ void attn_units(const Params& p, LAS unsigned char* lds, const int u_lo, const int u_hi) {
    const int tid = threadIdx.x, lane = tid & 63, wid = __builtin_amdgcn_readfirstlane(tid >> 6), G = gridDim.x, bx = blockIdx.x;
    const int li = lane & 15, g = lane >> 4;
    unsigned char* ws = p.ws;
    const bf16_t* Qb = (const bf16_t*)(ws + Q_OFF); const bf16_t* Kb = (const bf16_t*)(ws + K_OFF); const bf16_t* VT = (const bf16_t*)(ws + VT_OFF);
    bf16_t* att = (bf16_t*)(ws + ATT_OFF);
    int pb = -1, ph = -1, hiR = -1;
    const int sr = tid >> 3, sch = tid & 7;
    u32x4 pf[4]; int pfn = 0, pfR0 = 0;
    for (int un = u_lo; un < u_hi; ++un) {
        int b, h, rp, rows;
        if (un < 2048) { b = un >> 9; h = (un >> 6) & 7; rp = un & 63; rows = 128; } else { const int v = un - 2048; b = 4 + (v >> 8); h = (v >> 5) & 7; rp = v & 31; rows = 64; }
        const int gb = batch_base(b), T = rows * 64, r0 = 2 * rp;
        const int rsA = min(max(r0 - 4, 0), rows - 8), needHi = min(rsA + 8, rows - 1);
        if (b != pb || h != ph) {
            __syncthreads();
            { u32x4 kvv[9], vvv[9];
#pragma unroll
              for (int j = 0; j < 9; ++j) { const int R = min(rsA + j, needHi);
                kvv[j] = *(const u32x4*)(Kb + (size_t)(gb + R * 64 + sr) * 512 + h * 64 + sch * 8);
                vvv[j] = *(const u32x4*)(VT + (size_t)512 * gb + (size_t)(h * 64 + sr) * T + R * 64 + sch * 8); }
#pragma unroll
              for (int j = 0; j < 9; ++j) { const int sl = min(rsA + j, needHi) % 9;
                *(LAS u32x4*)(lds + A_KS + sl * 8192 + sr * 128 + ((sch ^ (sr & 7)) * 16)) = kvv[j];
                *(LAS u32x4*)(lds + A_VS + sl * 8192 + sr * 128 + ((sch ^ ((sr >> 1) & 7)) * 16)) = vvv[j]; } }
            if (tid < 128) { const int r = tid >> 3, ch = tid & 7; *(LAS u32x4*)(lds + A_KM + r * 128 + ((ch ^ (r & 7)) * 16)) = *(const u32x4*)((const bf16_t*)(ws + KMETA_OFF) + r * 512 + h * 64 + ch * 8); }
            else if (tid < 256) { const int q = tid - 128; *(LAS u32x4*)(lds + A_VM + q * 16) = *(const u32x4*)((const bf16_t*)(ws + VMETAT_OFF) + h * 64 * 16 + q * 8); }
            for (int i = tid; i < 15 * 64; i += 512) { const int ro = i >> 6, x = (i & 63) - 16; ((LAS float*)(lds + A_BS))[i] = (x >= 0 && x <= 30) ? p.rel_bias[(h * 15 + ro) * 31 + x] : 0.f; }
            if (tid < 16) ((LAS float*)(lds + A_MB))[tid] = p.meta_bias[h * 16 + tid];
            pb = b; ph = h; hiR = needHi;
        } else {
#pragma unroll
            for (int j = 0; j < 2; ++j) if (j < pfn) { const int sl = (pfR0 + j) % 9;
                *(LAS u32x4*)(lds + A_KS + sl * 8192 + sr * 128 + ((sch ^ (sr & 7)) * 16)) = pf[2 * j];
                *(LAS u32x4*)(lds + A_VS + sl * 8192 + sr * 128 + ((sch ^ ((sr >> 1) & 7)) * 16)) = pf[2 * j + 1]; }
            hiR = needHi;
        }
        __syncthreads();
        pfn = 0;
        if (un + 1 < u_hi) { const int un2 = un + 1; int b2, h2, rp2;
            if (un2 < 2048) { b2 = un2 >> 9; h2 = (un2 >> 6) & 7; rp2 = un2 & 63; } else { const int v = un2 - 2048; b2 = 4 + (v >> 8); h2 = (v >> 5) & 7; rp2 = v & 31; }
            if (b2 == b && h2 == h) { const int rsA2 = min(max(2 * rp2 - 4, 0), rows - 8), nh2 = min(rsA2 + 8, rows - 1); pfR0 = hiR + 1; pfn = nh2 - hiR;
#pragma unroll
                for (int j = 0; j < 2; ++j) if (j < pfn) { const int R = pfR0 + j;
                    pf[2 * j] = *(const u32x4*)(Kb + (size_t)(gb + R * 64 + sr) * 512 + h * 64 + sch * 8);
                    pf[2 * j + 1] = *(const u32x4*)(VT + (size_t)512 * gb + (size_t)(h * 64 + sr) * T + R * 64 + sch * 8); } } }
        const int r = r0 + (wid >> 2), c0 = 16 * (wid & 3), kc0 = min(max(c0 - 8, 0), 32);
        const int rs = min(max(r - 4, 0), rows - 8);
        int slot[8];
        { const int s0 = rs % 9;
#pragma unroll
          for (int w = 0; w < 8; ++w) slot[w] = (s0 + w >= 9) ? s0 + w - 9 : s0 + w; }
        const int c = c0 + li, cs = min(max(c - 8, 0), 48);
        const size_t qrow = (size_t)(gb + r * 64 + c);
        bf16x8 qf[2];
        qf[0] = *(const bf16x8*)(Qb + qrow * 512 + h * 64 + 8 * g); qf[1] = *(const bf16x8*)(Qb + qrow * 512 + h * 64 + 32 + 8 * g);
        f32x4 sa[8][2]; f32x4 sm_;
        {
            const int kr0 = kc0 + li;
#pragma unroll
            for (int w = 0; w < 8; ++w)
#pragma unroll
                for (int j = 0; j < 2; ++j) { const int kr = kr0 + 16 * j; const LAS unsigned char* rowp = lds + A_KS + slot[w] * 8192 + kr * 128;
                    const bf16x8 a0 = *(const LAS bf16x8*)(rowp + ((g ^ (kr & 7)) * 16)), a1 = *(const LAS bf16x8*)(rowp + (((g + 4) ^ (kr & 7)) * 16));
                    f32x4 z = (f32x4){0.f, 0.f, 0.f, 0.f};
                    z = __builtin_amdgcn_mfma_f32_16x16x32_bf16(a0, qf[0], z, 0, 0, 0); sa[w][j] = __builtin_amdgcn_mfma_f32_16x16x32_bf16(a1, qf[1], z, 0, 0, 0); }
            const LAS unsigned char* rowp = lds + A_KM + li * 128;
            const bf16x8 a0 = *(const LAS bf16x8*)(rowp + ((g ^ (li & 7)) * 16)), a1 = *(const LAS bf16x8*)(rowp + (((g + 4) ^ (li & 7)) * 16));
            f32x4 z = (f32x4){0.f, 0.f, 0.f, 0.f};
            z = __builtin_amdgcn_mfma_f32_16x16x32_bf16(a0, qf[0], z, 0, 0, 0); sm_ = __builtin_amdgcn_mfma_f32_16x16x32_bf16(a1, qf[1], z, 0, 0, 0);
        }
        const int dl = kc0 + 4 * g - cs;
        const LAS float* bsp = (const LAS float*)(lds + A_BS) + (rs - r + 7) * 64 + (kc0 + 4 * g - c + 31);
        float mx = -1e30f;
#pragma unroll
        for (int w = 0; w < 8; ++w)
#pragma unroll
            for (int j = 0; j < 2; ++j)
#pragma unroll
                for (int e = 0; e < 4; ++e) { const bool ok = (unsigned)(dl + 16 * j + e) < 16u; const float bv = bsp[w * 64 + 16 * j + e];
                    float sv = sa[w][j][e] + bv; sv = ok ? sv : -1e30f; sa[w][j][e] = sv; mx = fmaxf(mx, sv); }
#pragma unroll
        for (int e = 0; e < 4; ++e) { sm_[e] += ((const LAS float*)(lds + A_MB))[4 * g + e]; mx = fmaxf(mx, sm_[e]); }
        mx = fmaxf(mx, __shfl_xor(mx, 16)); mx = fmaxf(mx, __shfl_xor(mx, 32));
        const float mxl = mx * 1.44269504f; float sum = 0.f;
#pragma unroll
        for (int w = 0; w < 8; ++w)
#pragma unroll
            for (int j = 0; j < 2; ++j)
#pragma unroll
                for (int e = 0; e < 4; ++e) { const float pe = __builtin_amdgcn_exp2f(sa[w][j][e] * 1.44269504f - mxl); sa[w][j][e] = pe; sum += pe; }
#pragma unroll
        for (int e = 0; e < 4; ++e) { const float pe = __builtin_amdgcn_exp2f(sm_[e] * 1.44269504f - mxl); sm_[e] = pe; sum += pe; }
        sum += __shfl_xor(sum, 16); sum += __shfl_xor(sum, 32);
        const float rsum = 1.0f / sum;
        f32x4 o[4];
#pragma unroll
        for (int dt = 0; dt < 4; ++dt) o[dt] = (f32x4){0.f, 0.f, 0.f, 0.f};
        const int c8 = (kc0 >> 2) + g;
#pragma unroll
        for (int w = 0; w < 8; ++w) { u32x4 pw; pw.x = cvt_pk_bf16(sa[w][0][0], sa[w][0][1]); pw.y = cvt_pk_bf16(sa[w][0][2], sa[w][0][3]); pw.z = cvt_pk_bf16(sa[w][1][0], sa[w][1][1]); pw.w = cvt_pk_bf16(sa[w][1][2], sa[w][1][3]);
            const bf16x8 pbv = __builtin_bit_cast(bf16x8, pw);
#pragma unroll
            for (int dt = 0; dt < 4; ++dt) { const int d = 16 * dt + li, sw = 2 * ((d >> 1) & 7); const LAS unsigned char* rowp = lds + A_VS + slot[w] * 8192 + d * 128;
                const u32x2 lo = *(const LAS u32x2*)(rowp + ((c8 ^ sw) * 8)), hi = *(const LAS u32x2*)(rowp + (((c8 + 4) ^ sw) * 8));
                u32x4 av; av.x = lo.x; av.y = lo.y; av.z = hi.x; av.w = hi.y;
                o[dt] = __builtin_amdgcn_mfma_f32_16x16x32_bf16(__builtin_bit_cast(bf16x8, av), pbv, o[dt], 0, 0, 0); } }
        { u32x4 pw; pw.x = cvt_pk_bf16(sm_[0], sm_[1]); pw.y = cvt_pk_bf16(sm_[2], sm_[3]); pw.z = 0u; pw.w = 0u; const bf16x8 pbv = __builtin_bit_cast(bf16x8, pw);
#pragma unroll
            for (int dt = 0; dt < 4; ++dt) { const int d = 16 * dt + li; const u32x2 lo = *(const LAS u32x2*)(lds + A_VM + d * 32 + g * 8);
                u32x4 av; av.x = lo.x; av.y = lo.y; av.z = 0u; av.w = 0u;
                o[dt] = __builtin_amdgcn_mfma_f32_16x16x32_bf16(__builtin_bit_cast(bf16x8, av), pbv, o[dt], 0, 0, 0); } }
#pragma unroll
        for (int dt = 0; dt < 4; ++dt) { u32x2 w; w.x = cvt_pk_bf16(o[dt][0] * rsum, o[dt][1] * rsum); w.y = cvt_pk_bf16(o[dt][2] * rsum, o[dt][3] * rsum);
            *(u32x2*)(att + qrow * 512 + h * 64 + 16 * dt + 4 * g) = w; }
        __syncthreads();
    }
}
__device__ __forceinline__ void dft_prep(const Params& p) {
    const int tid = threadIdx.x, G = gridDim.x, bx = blockIdx.x; unsigned char* ws = p.ws;
    {
        const int gt = bx * 512 + tid, NGT = G * 512;
        constexpr int IPP = 4 * 512 * (KPP / 8), IPS = 4 * 512 * (KPS / 8);
        for (int it = gt; it < IPP + IPS; it += NGT) {
            int b, ch, j, N, KP; size_t ub, eb;
            if (it < IPP) { b = it / (512 * (KPP / 8)); const int q = it % (512 * (KPP / 8)); ch = q / (KPP / 8); j = q % (KPP / 8); N = NP; KP = KPP; ub = ((size_t)b * 512 + ch) * NP; eb = ((size_t)b * 512 + ch) * KPP; }
            else { const int v = it - IPP; b = v / (512 * (KPS / 8)); const int q = v % (512 * (KPS / 8)); ch = q / (KPS / 8); j = q % (KPS / 8); N = NS; KP = KPS;
                ub = (size_t)4 * 512 * NP + ((size_t)b * 512 + ch) * NS; eb = (size_t)4 * 512 * KPP + ((size_t)b * 512 + ch) * KPS; }
            (void)KP;
            const bf16_t* ut = (const bf16_t*)(ws + UT_OFF) + ub; const int HN = N / 2, k0 = 8 * j;
            float ev[8], ov[8];
            if (k0 < HN) { const u32x4 f = *(const u32x4*)(ut + k0); const u32x4 rv = *(const u32x4*)(ut + N - k0 - 8);
                const float fw[8] = {bf_lo(f.x), bf_hi(f.x), bf_lo(f.y), bf_hi(f.y), bf_lo(f.z), bf_hi(f.z), bf_lo(f.w), bf_hi(f.w)};
                const float rr[8] = {bf_lo(rv.x), bf_hi(rv.x), bf_lo(rv.y), bf_hi(rv.y), bf_lo(rv.z), bf_hi(rv.z), bf_lo(rv.w), bf_hi(rv.w)};
                const float r0v = (k0 > 0) ? __uint_as_float((unsigned)ut[N - k0] << 16) : 0.f;
#pragma unroll
                for (int e = 0; e < 8; ++e) { const float rvv = (e == 0) ? r0v : rr[8 - e]; ev[e] = fw[e] + rvv; ov[e] = fw[e] - rvv; }
                if (k0 == 0) { ev[0] = fw[0]; ov[0] = 0.f; } }
            else {
#pragma unroll
                for (int e = 0; e < 8; ++e) { ev[e] = 0.f; ov[e] = 0.f; }
                if (k0 == HN) ev[0] = __uint_as_float((unsigned)ut[HN] << 16); }
            u32x4 we, wo; we.x = cvt_pk_bf16(ev[0], ev[1]); we.y = cvt_pk_bf16(ev[2], ev[3]); we.z = cvt_pk_bf16(ev[4], ev[5]); we.w = cvt_pk_bf16(ev[6], ev[7]);
            wo.x = cvt_pk_bf16(ov[0], ov[1]); wo.y = cvt_pk_bf16(ov[2], ov[3]); wo.z = cvt_pk_bf16(ov[4], ov[5]); wo.w = cvt_pk_bf16(ov[6], ov[7]);
            *(u32x4*)((bf16_t*)(ws + UE_OFF) + eb + k0) = we; *(u32x4*)((bf16_t*)(ws + UO_OFF) + eb + k0) = wo;
        }
    }
}

#define XB_TMO      128
#define XB_XCNT(j)  (256  + 64 * (j))
#define XB_XSUB(j)  (1280 + 64 * (j))
#define XB_XGEN(j)  (2304 + 64 * (j))
#define XB_TOP      3328
#define XB_TOPGEN   3392
#define XCD_BAR_WORDS 3456
#define XB_SPIN_CAP (1u << 18)

__device__ __forceinline__ unsigned xb_ld(unsigned* p)              { return __hip_atomic_load(p, __ATOMIC_RELAXED, __HIP_MEMORY_SCOPE_AGENT); }
__device__ __forceinline__ unsigned xb_add(unsigned* p, unsigned v) { return __hip_atomic_fetch_add(p, v, __ATOMIC_RELAXED, __HIP_MEMORY_SCOPE_AGENT); }
__device__ __forceinline__ unsigned xb_xcc_id() { return (unsigned)__builtin_amdgcn_s_getreg((3 << 11) | 20) & 0xFu; }
#define XB_SPIN(cond, bar) do { unsigned _sp = 0; while (cond) { __builtin_amdgcn_s_sleep(1); \
    if ((++_sp & 255u) == 0u) { if (xb_ld(&(bar)[XB_TMO])) break; if (_sp > XB_SPIN_CAP) { atomicAdd(&(bar)[XB_TMO], 1u); break; } } } } while (0)

struct XcdBarrier {
    unsigned* bar; unsigned x;
    volatile LAS unsigned* st;
};

__device__ __forceinline__ XcdBarrier xcd_barrier_post(unsigned* bar, volatile LAS unsigned* st) {
    XcdBarrier b; b.bar = bar; b.x = xb_xcc_id(); b.st = st;
    if (threadIdx.x == 0) (void)xb_add(&bar[XB_XCNT(b.x)], 1u);
    return b;
}
__device__ __forceinline__ void xcd_barrier_complete(unsigned* bar, unsigned x, unsigned& nloc, unsigned& nx) {
    const unsigned G = gridDim.x * gridDim.y * gridDim.z;
    unsigned sum, cnt, mine, sp = 0u;
    for (;;) {
        sum = 0u; cnt = 0u; mine = 0u;
#pragma unroll
        for (unsigned j = 0; j < 16; ++j) { const unsigned c = xb_ld(&bar[XB_XCNT(j)]); sum += c; cnt += (c > 0u) ? 1u : 0u; mine = (j == x) ? c : mine; }
        if (sum == G) break;
        __builtin_amdgcn_s_sleep(1);
        if ((++sp & 255u) == 0u) { if (xb_ld(&bar[XB_TMO])) break; if (sp > XB_SPIN_CAP) { atomicAdd(&bar[XB_TMO], 1u); break; } }
    }
    nloc = mine > 0u ? mine : 1u; nx = cnt > 0u ? cnt : 1u;
}

__device__ __forceinline__ void xcd_barrier(const XcdBarrier& b) {
    asm volatile("s_waitcnt vmcnt(0)" ::: "memory");
    __syncthreads();
    if (threadIdx.x == 0) {
        unsigned* bar = b.bar;
        __builtin_amdgcn_s_waitcnt(0);
        unsigned nloc = b.st[0], nx = b.st[1];
        if (nloc == 0u) { xcd_barrier_complete(bar, b.x, nloc, nx); b.st[0] = nloc; b.st[1] = nx; }
        const unsigned old = xb_add(&bar[XB_XSUB(b.x)], 1u);
        const unsigned gen = old / nloc;
        if (old + 1u == (gen + 1u) * nloc) {
            __builtin_amdgcn_fence(__ATOMIC_RELEASE, "agent");
            asm volatile("s_waitcnt vmcnt(0)" ::: "memory");
            const unsigned og = xb_add(&bar[XB_TOP], 1u);
            const unsigned tg = og / nx;
            if (og + 1u == (tg + 1u) * nx) xb_add(&bar[XB_TOPGEN], 1u);
            else XB_SPIN(xb_ld(&bar[XB_TOPGEN]) == tg, bar);
            __builtin_amdgcn_fence(__ATOMIC_ACQUIRE, "agent");
            xb_add(&bar[XB_XGEN(b.x)], 1u);
            asm volatile("s_waitcnt vmcnt(0)" ::: "memory");
        } else {
            XB_SPIN(xb_ld(&bar[XB_XGEN(b.x)]) == gen, bar);
            __builtin_amdgcn_fence(__ATOMIC_ACQUIRE, "agent");
            asm volatile("s_waitcnt vmcnt(0)" ::: "memory");
        }
    }
    __syncthreads();
}


#ifndef STG_W6
#define STG_W6 0
#endif
__device__ __forceinline__ void phase_stagger(int w_ticks) {
    if (w_ticks > 0) { const int bx = blockIdx.x, rank = (bx & 7) * (gridDim.x >> 3) + (bx >> 3);
        const unsigned long long t1 = __builtin_amdgcn_s_memrealtime() + (unsigned long long)((long)w_ticks * rank / gridDim.x);
        while (__builtin_amdgcn_s_memrealtime() < t1) __builtin_amdgcn_s_sleep(8); }
}
__global__ void __launch_bounds__(512, 2) mega_fwd(Params p) {
    extern __shared__ __attribute__((aligned(16))) unsigned char lds_raw[];
    LAS unsigned char* lds = (LAS unsigned char*)lds_raw;
    const int lo = p.ph_lo, hi = p.ph_hi, G = gridDim.x, bx = blockIdx.x;
    unsigned char* ws = p.ws;
    unsigned long long tsa_ = 0, tsb_ = 0;
#define TSA(k) do { if (TS_PHASE == (k)) tsa_ = __builtin_amdgcn_s_memrealtime(); } while (0)
#define TSB(k) do { if (TS_PHASE == (k)) tsb_ = __builtin_amdgcn_s_memrealtime(); } while (0)
#define IN(k) (lo <= (k) && (k) < hi)
    volatile LAS unsigned* bst = (volatile LAS unsigned*)(lds + LDS_BYTES - 64);
    if (threadIdx.x < 2) bst[threadIdx.x] = 0u;
    __syncthreads();
    if (bx == 0) { for (int i = threadIdx.x; i < 4096; i += 512) __hip_atomic_store((unsigned*)ws + i, 0u, __ATOMIC_RELAXED, __HIP_MEMORY_SCOPE_AGENT); }
    if (hi - lo > 1) cg::this_grid().sync();
    XcdBarrier xbar = xcd_barrier_post((unsigned*)ws, bst);
#define SEAM(k) do { if (IN(k) && IN((k) + 1)) { xcd_barrier(xbar); } } while (0)
#define REPS(k) for (int rep_ = 0; rep_ < ((REP_PHASE == (k)) ? 2 : 1); ++rep_)
#define REPSYNC(k) do { if (REP_PHASE == (k) && rep_ == 0) cg::this_grid().sync(); } while (0)
    TSA(0);
    if (IN(0)) REPS(0) { p0_prologue<0>(p, lds, bx, G); __syncthreads(); REPSYNC(0); }
    SEAM(0); TSB(0);
    TSA(1);
    if (IN(1)) REPS(1) {
        { SchedRect<1> S{}; S.A0 = (const char*)(ws + XB_OFF); S.B0 = (const char*)(ws + WINA_OFF); S.pa0 = 2048; S.nt0 = 16; S.nM = MT / 256; S.nN = 12; S.G = G; S.c = bx;
          EpiP1a E{ws, p.out}; pg8::gemm_phase<false>(lds, S, E); }
        { SchedRect<1> S{}; S.A0 = (const char*)(ws + XB_OFF); S.B0 = (const char*)(ws + WINB_OFF); S.pa0 = 2048; S.nt0 = 16; S.nM = MT / 256; S.nN = 4; S.G = G; S.c = bx;
          EpiP1b E{ws}; pg8::gemm_phase<true>(lds, S, E); }
        REPSYNC(1);
    }
    SEAM(1); TSB(1);
    TSA(2);
    if (IN(2)) REPS(2) { p0_prologue<1>(p, lds, bx, G); dft_prep(p); __syncthreads(); REPSYNC(2); }
    SEAM(2); TSB(2);
    TSA(3);
    if (IN(3)) REPS(3) { SchedDft S{(const char*)ws, G, bx}; EpiDft E{ws}; pg8::gemm_phase<false>(lds, S, E);
        int a_lo, a_hi;
        if (G == 256) {
            if (bx < 16) { a_lo = bx * 6; a_hi = a_lo + 6; } else if (bx < 80) { a_lo = 96 + (bx - 16) * 13; a_hi = a_lo + 13; } else if (bx < 160) { a_lo = 928 + (bx - 80) * 12; a_hi = a_lo + 12; }
            else { p0_prologue<2>(p, lds, bx - 160, 96); if (bx < 224) { a_lo = 1888 + (bx - 160) * 10; a_hi = a_lo + 10; } else { a_lo = 2528 + (bx - 224) * 17; a_hi = a_lo + 17; } }
        } else { p0_prologue<2>(p, lds, bx, G); const int per = (3072 + G - 1) / G; a_lo = bx * per; a_hi = min(a_lo + per, 3072); }
        __syncthreads();
        attn_units(p, lds, a_lo, a_hi);
        __syncthreads();
        REPSYNC(3); }
    SEAM(3); TSB(3);
    TSA(4);
    if (IN(4)) REPS(4) {
        SchedMerge S{(const char*)ws, G, bx};
        EpiMerge E{ws, p.out}; pg8::gemm_phase<false>(lds, S, E); REPSYNC(4);
    }
    SEAM(4); TSB(4);
    TSA(5);
    if (IN(5)) {
        SchedRect<1> S{}; S.A0 = (const char*)(ws + MIX_OFF); S.B0 = (const char*)(ws + WOUT_OFF); S.pa0 = 2048; S.nt0 = 16; S.nM = MT / 256; S.nN = 4; S.G = G; S.c = bx;
        EpiRes5 E{p.xp, p.xs, (bf16_t*)(ws + X1B_OFF), (float*)(ws + SS1_OFF)}; pg8::gemm_phase<false>(lds, S, E);
    }
    SEAM(5); TSB(5);
    TSA(6);
    if (IN(6)) REPS(6) {
        phase_stagger(STG_W6);
        SchedRect<1> S{}; S.A0 = (const char*)(ws + X1B_OFF); S.B0 = (const char*)(ws + WUP_OFF); S.pa0 = 2048; S.nt0 = 16; S.nM = MT / 256; S.nN = 16; S.G = G; S.c = bx;
        EpiUp E{(bf16_t*)(ws + H_OFF), (const float*)(ws + SS1_OFF)}; pg8::gemm_phase<false>(lds, S, E); REPSYNC(6);
    }
    SEAM(6); TSB(6);
    TSA(7);
    if (IN(7)) {
        SchedRect<1> S{}; S.A0 = (const char*)(ws + H_OFF); S.B0 = (const char*)(ws + WDN_OFF); S.pa0 = 8192; S.nt0 = 64; S.nM = MT / 256; S.nN = 4; S.G = G; S.c = bx;
        if (G == 256) { EpiRes7F E{(const bf16_t*)(ws + X1B_OFF), (float*)(ws + SS2_OFF), (unsigned*)ws + 3584, p.g_final, p.out}; pg8::gemm_phase<false>(lds, S, E); }
        else { EpiRes7 E{(bf16_t*)(ws + X1B_OFF), (float*)(ws + SS2_OFF)}; pg8::gemm_phase<false>(lds, S, E); }
    }
    if (G != 256) SEAM(7);
    TSB(7);
    TSA(8);
    if (IN(8) && G != 256) {
        const int tid = threadIdx.x, lane = tid & 63, wid = tid >> 6; const float* ss2 = (const float*)(ws + SS2_OFF);
        f32x4 gf[2][2];
#pragma unroll
        for (int j = 0; j < 2; ++j) { gf[j][0] = *(const f32x4*)(p.g_final + 512 * j + lane * 8); gf[j][1] = *(const f32x4*)(p.g_final + 512 * j + lane * 8 + 4); }
        for (int g0 = bx * 8 + wid; g0 < MT; g0 += 2 * G * 8) {
            u32x4 v[2][2]; float rinv[2];
#pragma unroll
            for (int q = 0; q < 2; ++q) { const int g = g0 + q * G * 8; if (g < MT) { const bf16_t* xr = (const bf16_t*)(ws + X1B_OFF) + (size_t)g * 1024;
                    v[q][0] = *(const u32x4*)(xr + lane * 8); v[q][1] = *(const u32x4*)(xr + 512 + lane * 8); rinv[q] = rsqrtf(ss2[g] * (1.0f / 1024.0f) + RMS_EPS); } }
#pragma unroll
            for (int q = 0; q < 2; ++q) { const int g = g0 + q * G * 8; if (g < MT) { float* o = p.out + (size_t)g * 1024;
#pragma unroll
                    for (int j = 0; j < 2; ++j) { const u32x4 b = v[q][j]; f32x4 o0, o1;
                        o0[0] = bf_lo(b.x); o0[1] = bf_hi(b.x); o0[2] = bf_lo(b.y); o0[3] = bf_hi(b.y); o1[0] = bf_lo(b.z); o1[1] = bf_hi(b.z); o1[2] = bf_lo(b.w); o1[3] = bf_hi(b.w);
                        *(f32x4*)(o + 512 * j + lane * 8) = o0 * rinv[q] * gf[j][0]; *(f32x4*)(o + 512 * j + lane * 8 + 4) = o1 * rinv[q] * gf[j][1]; } } }
        }
    }
    TSB(8);
    if (TS_PHASE >= 0 && bx == 0) { const unsigned long long t1 = __builtin_amdgcn_s_memrealtime() + (tsb_ - tsa_); while (__builtin_amdgcn_s_memrealtime() < t1) __builtin_amdgcn_s_sleep(8); }
#undef IN
#undef SEAM
}

extern "C" void kernel_launch(void* const* d_in, const int* in_sizes, int n_in, void* d_out, int out_size, void* d_ws, size_t ws_size, hipStream_t stream) {
    static int grid = 0;
    if (grid == 0) {
        if (n_in != 14 || out_size != MT * D || ws_size < WS_NEED) { fprintf(stderr, "kernel_launch: unexpected shapes (n_in %d, out %d, ws %zu)\n", n_in, out_size, ws_size); grid = -1; return; }
        int dev = 0, cus = 0, per_cu = 0;
        hipGetDevice(&dev); hipDeviceGetAttribute(&cus, hipDeviceAttributeMultiprocessorCount, dev);
        if (hipFuncSetAttribute((const void*)mega_fwd, hipFuncAttributeMaxDynamicSharedMemorySize, LDS_BYTES) != hipSuccess) { fprintf(stderr, "kernel_launch: hipFuncSetAttribute failed\n"); grid = -1; return; }
        if (hipOccupancyMaxActiveBlocksPerMultiprocessor(&per_cu, (const void*)mega_fwd, 512, LDS_BYTES) != hipSuccess || per_cu < 1) per_cu = 1;
        (void)hipGetLastError();
        grid = cus * per_cu;
    }
    if (grid < 0) return;
    Params p{};
    p.xp = (const float*)d_in[0]; p.xs = (const float*)d_in[1]; p.meta = (const float*)d_in[2]; p.w_in = (const float*)d_in[3]; p.rel_bias = (const float*)d_in[4]; p.meta_bias = (const float*)d_in[5];
    p.w_na = (const float*)d_in[6]; p.w_fn = (const float*)d_in[7]; p.w_out = (const float*)d_in[8]; p.g_mix = (const float*)d_in[9]; p.g_mlp = (const float*)d_in[10]; p.w_up = (const float*)d_in[11];
    p.w_down = (const float*)d_in[12]; p.g_final = (const float*)d_in[13]; p.out = (float*)d_out; p.ws = (unsigned char*)d_ws;
#if MK_PER_PHASE
    for (int ph = 0; ph < 9; ++ph) { p.ph_lo = ph; p.ph_hi = ph + 1; hipLaunchKernelGGL(mega_fwd, dim3(grid), dim3(512), LDS_BYTES, stream, p); }
#else
    p.ph_lo = 0; p.ph_hi = 9;
    void* args[] = {&p};
    hipError_t e = hipLaunchCooperativeKernel((const void*)mega_fwd, dim3(grid), dim3(512), args, LDS_BYTES, stream);
    if (e != hipSuccess) fprintf(stderr, "cooperative launch failed: %s (grid %d)\n", hipGetErrorString(e), grid);
#endif
}
```
